# Optimizing an MI355X kernel written in HIP

```python
import math
import jax, jax.numpy as jnp
from jax import lax
import numpy as np

D_MODEL = 1024
BATCH = 2
SEQ = 16384
DEPTH = 2

GRID_W = 64
CTX_LEN = 256
HEAD_DIM = 64
N_MIXERS = 4
N_HEADS = D_MODEL // HEAD_DIM
GROUP_HEADS = N_HEADS // N_MIXERS
GROUP_W = GROUP_HEADS * HEAD_DIM
D_MIX = N_MIXERS * GROUP_W
CHUNK = 64
DN_CONV = 3
NA_KH = 8
NA_KW = 16
DF_HEAD_DIM = HEAD_DIM // 2
Q_BLOCK = 128
ROPE_BASE = 10000.0
D_FF = 2816
FFN_CONV = 3
EPS = 1e-6
DN_W = 4 * GROUP_W + 4 * GROUP_HEADS
NA_W = 3 * GROUP_W
DF_W = 3 * GROUP_W
HG_W = 5 * GROUP_W
P_IN = DN_W + NA_W + DF_W + HG_W

kernel_name = "hybrid_parallel_group_diffusion_block"


def _split(x, sizes, axis=-1):
    return jnp.split(x, np.cumsum(sizes)[:-1].tolist(), axis=axis)


def _rmsnorm(x, w):
    xf = x.astype(jnp.float32)
    y = xf * lax.rsqrt(jnp.mean(jnp.square(xf), axis=-1, keepdims=True) + EPS)
    return (y * w.astype(jnp.float32)).astype(x.dtype)


def _l2norm(x):
    xf = x.astype(jnp.float32)
    return (xf * lax.rsqrt(jnp.sum(jnp.square(xf), axis=-1, keepdims=True) + EPS)).astype(x.dtype)


def _dwconv(x, w):
    k, ch = w.shape
    return lax.conv_general_dilated(x, w[:, None, :].astype(x.dtype), window_strides=(1,),
                                    padding=[(k // 2, k // 2)], dimension_numbers=("NWC", "WIO", "NWC"),
                                    feature_group_count=ch)


def _heads(x, n):
    b, l, _ = x.shape
    return x.reshape(b, l, n, -1).transpose(0, 2, 1, 3)


def _merge(x):
    b, h, l, d = x.shape
    return x.transpose(0, 2, 1, 3).reshape(b, l, h * d)


def _rope_2d_tables(length, dh):
    t = jnp.arange(length)
    row = (t // GRID_W).astype(jnp.float32)
    col = (t % GRID_W).astype(jnp.float32)
    half = dh // 2
    inv = 1.0 / (ROPE_BASE ** (jnp.arange(0, half, 2, dtype=jnp.float32) / half))
    ang_r = row[:, None] * inv
    ang_c = col[:, None] * inv
    return jnp.cos(ang_r), jnp.sin(ang_r), jnp.cos(ang_c), jnp.sin(ang_c)


def _rotate(x, cos, sin):
    x1, x2 = jnp.split(x, 2, axis=-1)
    cos = cos.astype(x.dtype)
    sin = sin.astype(x.dtype)
    return jnp.concatenate([x1 * cos - x2 * sin, x2 * cos + x1 * sin], axis=-1)


def _rope_2d(x, cos_r, sin_r, cos_c, sin_c):
    xr, xc = jnp.split(x, 2, axis=-1)
    return jnp.concatenate([_rotate(xr, cos_r, sin_r), _rotate(xc, cos_c, sin_c)], axis=-1)


def _gated_delta_rule(q, k, v, beta, log_a, s0):
    f32 = jnp.float32
    b, h, length, dk = q.shape
    dv = v.shape[-1]
    n = length // CHUNK
    ch = lambda t: t.astype(f32).reshape(b, h, n, CHUNK, *t.shape[3:])
    q = ch(q) * (dk ** -0.5)
    k = ch(k)
    v = ch(v)
    beta = ch(beta)
    g = jnp.cumsum(ch(log_a), axis=-1)
    incl = jnp.tril(jnp.ones((CHUNK, CHUNK), bool))
    strict = jnp.tril(jnp.ones((CHUNK, CHUNK), bool), -1)
    gdiff = g[..., :, None] - g[..., None, :]
    decay = jnp.where(incl, jnp.exp(jnp.where(incl, gdiff, 0.0)), 0.0)
    kb = k * beta[..., None]
    a_mat = jnp.where(strict, jnp.einsum("bhncd,bhnsd->bhncs", kb, k) * decay, 0.0)
    eye = jnp.eye(CHUNK, dtype=f32)
    t_mat = lax.linalg.triangular_solve(a_mat + eye, jnp.broadcast_to(eye, a_mat.shape),
                                        left_side=True, lower=True, unit_diagonal=True)
    eg = jnp.exp(g)
    w = t_mat @ (kb * eg[..., None])
    u = t_mat @ (v * beta[..., None])
    attn = jnp.einsum("bhncd,bhnsd->bhncs", q, k) * decay
    qg = q * eg[..., None]
    kdec = k * jnp.exp(g[..., -1:] - g)[..., None]
    glast = jnp.exp(g[..., -1])

    def step(s, xs):
        qg_c, w_c, u_c, attn_c, kdec_c, gl_c = xs
        v_new = u_c - w_c @ s
        o = qg_c @ s + attn_c @ v_new
        s = s * gl_c[..., None, None] + jnp.swapaxes(kdec_c, -1, -2) @ v_new
        return s, o

    xs = tuple(jnp.moveaxis(t, 2, 0) for t in (qg, w, u, attn, kdec, glast))
    s_fin, o = lax.scan(step, s0.astype(f32), xs)
    return jnp.moveaxis(o, 0, 2).reshape(b, h, length, dv), s_fin


def _hgrn2_chunked(q, k, v, log_f, s0):
    f32 = jnp.float32
    b, h, length, dk = q.shape
    dv = v.shape[-1]
    n = length // CHUNK
    ch = lambda t: t.astype(f32).reshape(b, h, n, CHUNK, t.shape[-1])
    q = ch(q) * (dk ** -0.5)
    k = ch(k)
    v = ch(v)
    cum = jnp.cumsum(ch(log_f), axis=-2)
    qb = q * jnp.exp(cum)
    kend = k * jnp.exp(cum[..., -1:, :] - cum)
    dend = jnp.exp(cum[..., -1, :])
    incl = jnp.tril(jnp.ones((CHUNK, CHUNK), bool))[:, :, None]

    def step(s, xs):
        q_c, k_c, v_c, b_c, qb_c, ke_c, de_c = xs
        bd = b_c[..., :, None, :] - b_c[..., None, :, :]
        dec = jnp.where(incl, jnp.exp(jnp.where(incl, bd, 0.0)), 0.0)
        att = jnp.einsum("bhtd,bhsd,bhtsd->bhts", q_c, k_c, dec)
        o = qb_c @ s + att @ v_c
        s = s * de_c[..., None] + jnp.swapaxes(ke_c, -1, -2) @ v_c
        return s, o

    xs = tuple(jnp.moveaxis(t, 2, 0) for t in (q, k, v, cum, qb, kend, dend))
    s_fin, o = lax.scan(step, s0.astype(f32), xs)
    return jnp.moveaxis(o, 0, 2).reshape(b, h, length, dv), s_fin


def _flip(t, d):
    return jnp.flip(t, axis=2) if d == 1 else t


def _bidir_scan(scan_fn, ctx_dirs, lat_dirs, s0):
    o_ctx = 0.0
    o_lat = 0.0
    for d in range(2):
        oc, sc = scan_fn(*[_flip(t, d) for t in ctx_dirs[d]], s0)
        ox, _ = scan_fn(*[_flip(t, d) for t in lat_dirs[d]], sc)
        o_ctx = o_ctx + _flip(oc, d)
        o_lat = o_lat + _flip(ox, d)
    return o_lat, o_ctx


def _deltanet_mixer(p_lat, p_ctx, need_ctx, conv_w, a_log, dt_bias, norm_w):
    nh = GROUP_HEADS
    f32 = jnp.float32

    def prep(p):
        b, length, _ = p.shape
        qkv, gate, ba = _split(p, [3 * GROUP_W, GROUP_W, 4 * nh])
        q, k, v = _split(jax.nn.silu(_dwconv(qkv, conv_w)), [GROUP_W] * 3)
        q = _l2norm(_heads(q, nh))
        k = _l2norm(_heads(k, nh))
        v = _heads(v, nh)
        ba = ba.astype(f32).reshape(b, length, 4, nh).transpose(2, 0, 3, 1)
        dirs = []
        for d in range(2):
            beta = jax.nn.sigmoid(ba[d])
            log_a = -jnp.exp(a_log[d].astype(f32))[None, :, None] * jax.nn.softplus(
                ba[2 + d] + dt_bias[d].astype(f32)[None, :, None])
            dirs.append((q, k, v, beta, log_a))
        return dirs, gate

    lat_dirs, g_lat = prep(p_lat)
    ctx_dirs, g_ctx = prep(p_ctx)
    s0 = jnp.zeros((p_lat.shape[0], nh, HEAD_DIM, HEAD_DIM), jnp.float32)
    o_lat, o_ctx = _bidir_scan(_gated_delta_rule, ctx_dirs, lat_dirs, s0)
    post = lambda o, g: (_merge(_rmsnorm(o, norm_w)) * jax.nn.silu(g.astype(f32))).astype(p_lat.dtype)
    return post(o_lat, g_lat), (post(o_ctx, g_ctx) if need_ctx else None)


def _na_mixer(p_lat, p_ctx, need_ctx, rpb):
    nh = GROUP_HEADS
    d = HEAD_DIM
    scale = d ** -0.5
    q, k, v = [_heads(t, nh) for t in _split(p_lat, [GROUP_W] * 3)]
    qc, kc, vc = [_heads(t, nh) for t in _split(p_ctx, [GROUP_W] * 3)]
    b, h, length, _ = q.shape
    rows = length // GRID_W
    kh = min(NA_KH, rows)
    kw = min(NA_KW, GRID_W)
    grid = lambda t: t.reshape(b, h, rows, GRID_W, d)
    q = grid(q) * scale
    k = grid(k)
    v = grid(v)
    cols = np.arange(GRID_W)
    c_start = np.clip(cols - kw // 2, 0, GRID_W - kw)
    col_idx = c_start[:, None] + np.arange(kw)[None, :]
    col_bias_idx = col_idx - cols[:, None] + (NA_KW - 1)
    rpb_cols = rpb[:, :, col_bias_idx]

    def row_block(r):
        r_start = jnp.clip(r - kh // 2, 0, rows - kh)
        k_band = lax.dynamic_slice_in_dim(k, r_start, kh, axis=2)[:, :, :, col_idx, :]
        v_band = lax.dynamic_slice_in_dim(v, r_start, kh, axis=2)[:, :, :, col_idx, :]
        q_r = lax.dynamic_index_in_dim(q, r, axis=2, keepdims=False)
        row_bias_idx = r_start + jnp.arange(kh) - r + (NA_KH - 1)
        bias = jnp.take(rpb_cols, row_bias_idx, axis=1).transpose(0, 2, 1, 3)
        s_loc = jnp.einsum("bhwd,bhiwjd->bhwij", q_r, k_band) + bias[None]
        s_ctx = jnp.einsum("bhwd,bhmd->bhwm", q_r, kc)
        logits = jnp.concatenate([s_loc.reshape(b, h, GRID_W, kh * kw), s_ctx], axis=-1).astype(jnp.float32)
        prob = jax.nn.softmax(logits, axis=-1).astype(v.dtype)
        p_loc = prob[..., :kh * kw].reshape(b, h, GRID_W, kh, kw)
        p_ctx_r = prob[..., kh * kw:]
        return (jnp.einsum("bhwij,bhiwjd->bhwd", p_loc, v_band)
                + jnp.einsum("bhwm,bhmd->bhwd", p_ctx_r, vc))

    o = lax.map(row_block, jnp.arange(rows))
    o_lat = o.transpose(1, 0, 3, 2, 4).reshape(b, length, h * d)
    o_ctx = None
    if need_ctx:
        pc = jax.nn.softmax(jnp.einsum("bhmd,bhnd->bhmn", qc * scale, kc).astype(jnp.float32), axis=-1)
        o_ctx = _merge(jnp.einsum("bhmn,bhnd->bhmd", pc.astype(vc.dtype), vc))
    return o_lat, o_ctx


def _diff_mixer(p_lat, p_ctx, need_ctx, lam_p, norm_w, lam_init, rope):
    nh = GROUP_HEADS
    dh = DF_HEAD_DIM
    scale = dh ** -0.5

    def prep(p):
        b, length, _ = p.shape
        q, k, v = _split(p, [GROUP_W] * 3)
        q = q.reshape(b, length, nh, 2, dh).transpose(0, 2, 3, 1, 4)
        k = k.reshape(b, length, nh, 2, dh).transpose(0, 2, 3, 1, 4)
        return q, k, _heads(v, nh)

    q, k, v = prep(p_lat)
    qc, kc, vc = prep(p_ctx)
    q = _rope_2d(q, *rope) * scale
    k = _rope_2d(k, *rope)
    lp = lam_p.astype(jnp.float32)
    lam = jnp.exp(jnp.sum(lp[0] * lp[1])) - jnp.exp(jnp.sum(lp[2] * lp[3])) + lam_init

    def diff_attend(qb, kk, vv):
        s = jnp.einsum("bhjqd,bhjkd->bhjqk", qb, kk).astype(jnp.float32)
        pr = jax.nn.softmax(s, axis=-1)
        a = pr[:, :, 0] - lam * pr[:, :, 1]
        return jnp.einsum("bhqk,bhkd->bhqd", a.astype(vv.dtype), vv)

    k_all = jnp.concatenate([kc, k], axis=3)
    v_all = jnp.concatenate([vc, v], axis=2)
    b, h, _, length, _ = q.shape
    nb = length // Q_BLOCK
    q_blocks = jnp.moveaxis(q.reshape(b, h, 2, nb, Q_BLOCK, dh), 3, 0)
    o = lax.map(lambda qb: diff_attend(qb, k_all, v_all), q_blocks)
    o = jnp.moveaxis(o, 0, 2).reshape(b, h, length, 2 * dh)
    post = lambda t: _merge(_rmsnorm(t, norm_w) * (1.0 - lam_init))
    o_ctx = post(diff_attend(qc * scale, kc, vc)) if need_ctx else None
    return post(o), o_ctx


def _hgrn2_mixer(p_lat, p_ctx, need_ctx, lb, norm_w):
    nh = GROUP_HEADS
    f32 = jnp.float32

    def prep(p):
        q, i, f_fwd, f_bwd, gate = _split(p, [GROUP_W] * 5)
        q = _heads(q, nh)
        v = _heads(i, nh)
        dirs = []
        for d, f_raw in enumerate((f_fwd, f_bwd)):
            f = lb[d] + (1.0 - lb[d]) * jax.nn.sigmoid(f_raw.astype(f32))
            dirs.append((q, _heads(1.0 - f, nh), v, _heads(jnp.log(f), nh)))
        return dirs, gate

    lat_dirs, g_lat = prep(p_lat)
    ctx_dirs, g_ctx = prep(p_ctx)
    s0 = jnp.zeros((p_lat.shape[0], nh, HEAD_DIM, HEAD_DIM), jnp.float32)
    o_lat, o_ctx = _bidir_scan(_hgrn2_chunked, ctx_dirs, lat_dirs, s0)
    post = lambda o, g: (_merge(_rmsnorm(o, norm_w)) * jax.nn.silu(g.astype(f32))).astype(p_lat.dtype)
    return post(o_lat, g_lat), (post(o_ctx, g_ctx) if need_ctx else None)


def _token_mixers(p_lat, p_ctx, need_ctx, layer, rope, dn_conv_w, dn_a_log, dn_dt_bias, dn_norm_w,
                  na_rpb, df_lambda, df_norm_w, hg_lb, hg_norm_w):
    sizes = [DN_W, NA_W, DF_W, HG_W]
    dn_x, na_x, df_x, hg_x = _split(p_lat, sizes)
    dn_c, na_c, df_c, hg_c = _split(p_ctx, sizes)
    lam_init = 0.8 - 0.6 * math.exp(-0.3 * layer)
    outs = [
        _deltanet_mixer(dn_x, dn_c, need_ctx, dn_conv_w, dn_a_log, dn_dt_bias, dn_norm_w),
        _na_mixer(na_x, na_c, need_ctx, na_rpb),
        _diff_mixer(df_x, df_c, need_ctx, df_lambda, df_norm_w, lam_init, rope),
        _hgrn2_mixer(hg_x, hg_c, need_ctx, hg_lb, hg_norm_w),
    ]
    y_lat = jnp.concatenate([o[0].astype(p_lat.dtype) for o in outs], axis=-1)
    y_ctx = jnp.concatenate([o[1].astype(p_ctx.dtype) for o in outs], axis=-1) if need_ctx else None
    return y_lat, y_ctx


def _conv_ffn(h, w_up, conv_w, w_down):
    gate, val = jnp.split(h @ w_up, 2, axis=-1)
    return (jax.nn.silu(_dwconv(gate, conv_w)) * val) @ w_down


def _modulate(t, w, shift, scale):
    return _rmsnorm(t, w) * (1.0 + scale) + shift


def setup_inputs(seed: int = 0) -> dict:
    key = jax.random.key(seed)
    ks = jax.random.split(key, 24)
    f32 = jnp.float32
    nrm = lambda k, shape, s: jax.random.normal(k, shape, f32) * s
    gain = lambda k, shape: 1.0 + 0.02 * jax.random.normal(k, shape, f32)
    dt = jnp.exp(jax.random.uniform(ks[10], (DEPTH, 2, GROUP_HEADS), f32, math.log(1e-3), math.log(1e-1)))
    return {
        "x": nrm(ks[0], (BATCH, SEQ, D_MODEL), 1.0),
        "c": nrm(ks[1], (BATCH, D_MODEL), 1.0),
        "ctx": nrm(ks[2], (BATCH, CTX_LEN, D_MODEL), 1.0),
        "c_ctx": nrm(ks[3], (D_MODEL,), 1.0),
        "w_ada": nrm(ks[4], (DEPTH, D_MODEL, 6 * D_MODEL), 0.5 * D_MODEL ** -0.5),
        "b_ada": nrm(ks[5], (DEPTH, 6 * D_MODEL), 0.02),
        "norm1_w": gain(ks[6], (DEPTH, D_MODEL)),
        "norm2_w": gain(ks[7], (DEPTH, D_MODEL)),
        "w_in": nrm(ks[8], (DEPTH, D_MODEL, P_IN), D_MODEL ** -0.5),
        "dn_conv_w": nrm(ks[9], (DEPTH, DN_CONV, 3 * GROUP_W), DN_CONV ** -0.5),
        "dn_a_log": jnp.log(jax.random.uniform(ks[11], (DEPTH, 2, GROUP_HEADS), f32, 1.0, 16.0)),
        "dn_dt_bias": dt + jnp.log(-jnp.expm1(-dt)),
        "dn_norm_w": gain(ks[12], (DEPTH, HEAD_DIM)),
        "na_rpb": nrm(ks[13], (DEPTH, GROUP_HEADS, 2 * NA_KH - 1, 2 * NA_KW - 1), 0.02),
        "df_lambda": nrm(ks[14], (DEPTH, 4, DF_HEAD_DIM), 0.1),
        "df_norm_w": gain(ks[15], (DEPTH, 2 * DF_HEAD_DIM)),
        "hg_lb_raw": nrm(ks[16], (DEPTH, 2, GROUP_W), 0.1),
        "hg_norm_w": gain(ks[17], (DEPTH, HEAD_DIM)),
        "w_out": nrm(ks[18], (DEPTH, D_MIX, D_MODEL), D_MIX ** -0.5),
        "w_up": nrm(ks[19], (DEPTH, D_MODEL, 2 * D_FF), D_MODEL ** -0.5),
        "ffn_conv_w": nrm(ks[20], (DEPTH, FFN_CONV, D_FF), FFN_CONV ** -0.5),
        "w_down": nrm(ks[21], (DEPTH, D_FF, D_MODEL), D_FF ** -0.5),
        "final_norm_w": gain(ks[22], (D_MODEL,)),
    }


def reference(x, c, ctx, c_ctx, w_ada, b_ada, norm1_w, norm2_w, w_in, dn_conv_w, dn_a_log, dn_dt_bias,
              dn_norm_w, na_rpb, df_lambda, df_norm_w, hg_lb_raw, hg_norm_w, w_out, w_up, ffn_conv_w,
              w_down, final_norm_w):
    length = x.shape[1]
    rope = _rope_2d_tables(length, DF_HEAD_DIM)
    lb_all = jnp.cumsum(jax.nn.softmax(hg_lb_raw.astype(jnp.float32), axis=0), axis=0)
    lb_all = lb_all - lb_all[0]
    silu_c = jax.nn.silu(c)
    silu_cc = jax.nn.silu(c_ctx)
    h_ctx = ctx
    for l in range(DEPTH):
        need_ctx = l < DEPTH - 1
        mx = jnp.split((silu_c @ w_ada[l] + b_ada[l])[:, None, :], 6, axis=-1)
        mc = jnp.split(silu_cc @ w_ada[l] + b_ada[l], 6, axis=-1)
        p_lat = _modulate(x, norm1_w[l], mx[0], mx[1]) @ w_in[l]
        p_ctx = _modulate(h_ctx, norm1_w[l], mc[0], mc[1]) @ w_in[l]
        y_lat, y_ctx = _token_mixers(p_lat, p_ctx, need_ctx, l, rope, dn_conv_w[l], dn_a_log[l],
                                     dn_dt_bias[l], dn_norm_w[l], na_rpb[l], df_lambda[l], df_norm_w[l],
                                     lb_all[l], hg_norm_w[l])
        x = x + mx[2] * (y_lat @ w_out[l])
        x = x + mx[5] * _conv_ffn(_modulate(x, norm2_w[l], mx[3], mx[4]), w_up[l], ffn_conv_w[l], w_down[l])
        if need_ctx:
            h_ctx = h_ctx + mc[2] * (y_ctx @ w_out[l])
            h_ctx = h_ctx + mc[5] * _conv_ffn(_modulate(h_ctx, norm2_w[l], mc[3], mc[4]),
                                              w_up[l], ffn_conv_w[l], w_down[l])
    return _rmsnorm(x, final_norm_w)
```

```cpp
#include <hip/hip_runtime.h>
#include <hip/hip_cooperative_groups.h>
#include <cstdio>
#include <cstdint>
#include <cmath>
namespace cg = cooperative_groups;
#define EXP_UP2 0
#define EXP_IN2 0
#define EXP_SCAN2 0
#define EXP_DF2 0

typedef unsigned short bf16_t;
typedef short bf16x8 __attribute__((ext_vector_type(8)));
typedef float f32x4 __attribute__((ext_vector_type(4)));
#define DEV __device__ __forceinline__

constexpr int R_ = 33280, LAT_ = 32768, D_ = 1024, PN_ = 3968, PIN_ = 3856, DFF_ = 2816;
constexpr int C_DNQ = 0, C_DNK = 256, C_DNV = 512, C_DNG = 768, C_DNBA = 1024, C_NAQ = 1040, C_NAK = 1296, C_NAV = 1552,
              C_DFQ = 1808, C_DFK = 2064, C_DFV = 2320, C_HGQ = 2576, C_HGI = 2832, C_HGFF = 3088, C_HGFB = 3344, C_HGG = 3600;
constexpr int LDT = 72;
constexpr float EPS_ = 1e-6f;
constexpr float LOG2E = 1.4426950408889634f;

constexpr size_t OFF_CTRL = 0;
constexpr size_t OFF_MOD = 4096;
constexpr size_t OFF_HCTX = OFF_MOD + 2 * 3 * 6144 * 4;
constexpr size_t OFF_WB = OFF_HCTX + 512 * 1024 * 4;
constexpr size_t WB_IN = 0, WB_OUT = (size_t)PN_ * 1024 * 2, WB_UP = WB_OUT + 1024 * 1024 * 2, WB_DOWN = WB_UP + (size_t)5632 * 1024 * 2,
                 WB_LAYER = WB_DOWN + (size_t)1024 * 2816 * 2;
constexpr size_t OFF_XY = OFF_WB + 2 * WB_LAYER;
constexpr size_t OFF_P = OFF_XY + (size_t)R_ * 1024 * 2;
constexpr size_t OFF_DNK = OFF_P + (size_t)R_ * PN_ * 2;
constexpr size_t SZ_CH = (size_t)2 * 520 * 4 * 64 * 64 * 2;
constexpr size_t OFF_DNW = OFF_DNK + (size_t)R_ * 256 * 2;
constexpr size_t OFF_DNUT = OFF_DNW + SZ_CH;
constexpr size_t OFF_HGATT = OFF_DNUT + SZ_CH;
constexpr size_t OFF_DNG = OFF_HGATT + SZ_CH;
constexpr size_t OFF_HGDE = OFF_DNG + (size_t)2 * 520 * 4 * 64 * 4;
constexpr size_t OFF_BAR = OFF_HGDE + (size_t)2 * 520 * 4 * 64 * 4;
constexpr size_t OFF_VTG = OFF_BAR + 16384;
constexpr size_t OFF_PART = OFF_VTG + (size_t)8 * 64 * 16640 * 2;
constexpr size_t WS_NEED = OFF_PART + (size_t)256 * 64 * 132 * 4;
static_assert(WS_NEED <= (size_t)536870912, "workspace map exceeds 512 MiB");

struct Params {
  const float *x, *c, *ctx, *c_ctx, *w_ada, *b_ada, *norm1_w, *norm2_w, *w_in, *dn_conv_w, *dn_a_log, *dn_dt_bias, *dn_norm_w, *na_rpb,
      *df_lambda, *df_norm_w, *hg_lb_raw, *hg_norm_w, *w_out, *w_up, *ffn_conv_w, *w_down, *final_norm_w;
  float* out; char* ws;
  float lam_init[2]; int debug; int pad;
};

DEV float bf2f(bf16_t h) { return __uint_as_float((unsigned)h << 16); }
typedef __bf16 bf16x2_t __attribute__((ext_vector_type(2)));
typedef float f32x2_t __attribute__((ext_vector_type(2)));
DEV unsigned pack2(float lo, float hi) { f32x2_t f = {lo, hi}; bf16x2_t b = __builtin_convertvector(f, bf16x2_t); return __builtin_bit_cast(unsigned, b); }
DEV bf16_t f2bf(float f) { return (bf16_t)(pack2(f, f) & 0xffffu); }
DEV float lo_bf(unsigned u) { return __uint_as_float(u << 16); }
DEV float hi_bf(unsigned u) { return __uint_as_float(u & 0xffff0000u); }
DEV float sigmoidf_(float x) { return __builtin_amdgcn_rcpf(1.0f + __builtin_amdgcn_exp2f(-LOG2E * x)); }
DEV float siluf_(float x) { return x * __builtin_amdgcn_rcpf(1.0f + __builtin_amdgcn_exp2f(-LOG2E * x)); }
DEV f32x4 mfma16(bf16x8 a, bf16x8 b, f32x4 c) { return __builtin_amdgcn_mfma_f32_16x16x32_bf16(a, b, c, 0, 0, 0); }

DEV int tid_opaque() { int t = threadIdx.x; asm volatile("" : "+v"(t)); return t; }
DEV int bid_opaque() { int t = blockIdx.x; asm volatile("" : "+s"(t)); return t; }
DEV int grp_of(int r) { return r < LAT_ ? (r >> 14) : 2; }
DEV bool seq_first(int r) { return r < LAT_ ? ((r & 16383) == 0) : (((r - LAT_) & 255) == 0); }
DEV bool seq_last(int r) { return r < LAT_ ? ((r & 16383) == 16383) : (((r - LAT_) & 255) == 255); }

DEV void transpose_tile(const float* __restrict__ src, bf16_t* __restrict__ dst, int K, int N, int k0, int n0, int drow0, float* lds) {
  const int tx = tid_opaque() & 63, ty = tid_opaque() >> 6;
#pragma unroll 4
  for (int i = 0; i < 16; ++i) { const int k = ty + 4 * i; lds[k * 65 + tx] = (n0 + tx < N) ? src[(size_t)(k0 + k) * N + n0 + tx] : 0.f; }
  __syncthreads();
#pragma unroll 4
  for (int i = 0; i < 16; ++i) { const int n = ty + 4 * i; dst[(size_t)(drow0 + n) * K + k0 + tx] = f2bf(lds[tx * 65 + n]); }
  __syncthreads();
}

DEV void phase0(const Params& p, char* ldsc) {
  float* lds = (float*)ldsc;
  const int tid = tid_opaque();
  if (bid_opaque() == 0) ((unsigned*)(p.ws + OFF_CTRL))[tid] = 0u;
  constexpr int T_IN = 16 * 62, T_OUT = 256, T_UP = 16 * 88, T_DOWN = 44 * 16, T_L = T_IN + T_OUT + T_UP + T_DOWN;
  const int nitems = 2 * T_L + 192;
  for (int it = bid_opaque(); it < nitems; it += gridDim.x) {
    if (it < 2 * T_L) {
      const int l = it / T_L; int t = it % T_L;
      char* wb = p.ws + OFF_WB + (size_t)l * WB_LAYER;
      if (t < T_IN) { transpose_tile(p.w_in + (size_t)l * 1024 * PIN_, (bf16_t*)(wb + WB_IN), 1024, PIN_, (t % 16) * 64, (t / 16) * 64, (t / 16) * 64, lds); continue; }
      t -= T_IN;
      if (t < T_OUT) { transpose_tile(p.w_out + (size_t)l * 1024 * 1024, (bf16_t*)(wb + WB_OUT), 1024, 1024, (t % 16) * 64, (t / 16) * 64, (t / 16) * 64, lds); continue; }
      t -= T_OUT;
      if (t < T_UP) { const int nt = t / 16; const int drow = nt < 44 ? nt * 128 : (nt - 44) * 128 + 64;
        transpose_tile(p.w_up + (size_t)l * 1024 * 5632, (bf16_t*)(wb + WB_UP), 1024, 5632, (t % 16) * 64, nt * 64, drow, lds); continue; }
      t -= T_UP;
      transpose_tile(p.w_down + (size_t)l * 2816 * 1024, (bf16_t*)(wb + WB_DOWN), 2816, 1024, (t % 44) * 64, (t / 44) * 64, (t / 44) * 64, lds);
    } else {
      const int a = it - 2 * T_L, l = a / 96, cb = a % 96;
      float* sS = lds;
      float* sP = lds + 3072;
      for (int i = tid; i < 3072; i += 256) { const int g = i >> 10, k = i & 1023; const float v = g < 2 ? p.c[g * 1024 + k] : p.c_ctx[k]; sS[i] = siluf_(v); }
      __syncthreads();
      const int col = cb * 64 + (tid & 63), kq = tid >> 6;
      const float* w = p.w_ada + (size_t)l * 1024 * 6144 + col;
      float a0 = 0.f, a1 = 0.f, a2 = 0.f;
#pragma unroll 8
      for (int k = kq * 256; k < kq * 256 + 256; ++k) { const float wv = w[(size_t)k * 6144]; a0 += sS[k] * wv; a1 += sS[1024 + k] * wv; a2 += sS[2048 + k] * wv; }
      sP[(kq * 3 + 0) * 64 + (tid & 63)] = a0; sP[(kq * 3 + 1) * 64 + (tid & 63)] = a1; sP[(kq * 3 + 2) * 64 + (tid & 63)] = a2;
      __syncthreads();
      if (tid < 192) { const int g = tid >> 6, cc = tid & 63; const float s = sP[(0 * 3 + g) * 64 + cc] + sP[(1 * 3 + g) * 64 + cc] + sP[(2 * 3 + g) * 64 + cc] + sP[(3 * 3 + g) * 64 + cc];
        ((float*)(p.ws + OFF_MOD))[(l * 3 + g) * 6144 + cb * 64 + cc] = s + p.b_ada[l * 6144 + cb * 64 + cc]; }
      __syncthreads();
    }
  }
}

DEV const float* xrow_ptr(const Params& p, int r, bool from_input) {
  if (r < LAT_) return (from_input ? p.x : p.out) + (size_t)r * 1024;
  return (from_input ? p.ctx : (const float*)(p.ws + OFF_HCTX)) + (size_t)(r - LAT_) * 1024;
}
DEV void norm_phase(const Params& p, int l, int which) {
  const int lane = tid_opaque() & 63, gw = bid_opaque() * 4 + (tid_opaque() >> 6), nw = gridDim.x * 4;
  const float* nwt = (which == 0 ? p.norm1_w : p.norm2_w) + l * 1024;
  bf16_t* xn = (bf16_t*)(p.ws + OFF_XY);
  for (int r = gw; r < R_; r += nw) {
    const float4* xr = (const float4*)xrow_ptr(p, r, l == 0 && which == 0);
    const float* mod = (const float*)(p.ws + OFF_MOD) + (l * 3 + grp_of(r)) * 6144 + which * 3 * 1024;
    float4 v[4]; float ss = 0.f;
#pragma unroll
    for (int i = 0; i < 4; ++i) { v[i] = xr[lane + 64 * i]; ss += v[i].x * v[i].x + v[i].y * v[i].y + v[i].z * v[i].z + v[i].w * v[i].w; }
#pragma unroll
    for (int o = 32; o > 0; o >>= 1) ss += __shfl_xor(ss, o);
    const float rs = rsqrtf(ss * (1.0f / 1024.0f) + EPS_);
#pragma unroll
    for (int i = 0; i < 4; ++i) {
      const int c = (lane + 64 * i) * 4;
      const float4 w4 = *(const float4*)(nwt + c), sh = *(const float4*)(mod + c), sc = *(const float4*)(mod + 1024 + c);
      const float y0 = v[i].x * rs * w4.x * (1.f + sc.x) + sh.x, y1 = v[i].y * rs * w4.y * (1.f + sc.y) + sh.y;
      const float y2 = v[i].z * rs * w4.z * (1.f + sc.z) + sh.z, y3 = v[i].w * rs * w4.w * (1.f + sc.w) + sh.w;
      uint2 o; o.x = pack2(y0, y1); o.y = pack2(y2, y3);
      *(uint2*)(xn + (size_t)r * 1024 + c) = o;
    }
  }
}

struct EpiArgs { int l; int gi; bool first; };
template <int EPI>
DEV void gemm_tile(const Params& p, const bf16_t* __restrict__ A, const bf16_t* __restrict__ Bt, int K, int arow0, int brow0, int tn, const EpiArgs& e, char* ldsc) {
  bf16_t* As = (bf16_t*)ldsc;
  bf16_t* Bs = As + 2 * 128 * 64;
  const int tid = tid_opaque(), lane = tid & 63, wid = __builtin_amdgcn_readfirstlane(tid >> 6), fr = lane & 15, fq = lane >> 4, wm = wid >> 1, wn = wid & 1;
  const int lr = tid >> 3, lc = (((tid & 7) ^ (lr & 7)) * 8);
  size_t ao0, ao1, ao2, ao3;
  { int r0 = arow0 + lr, r1 = r0 + 32, r2 = r0 + 64, r3 = r0 + 96;
    r0 = r0 < 0 ? 0 : (r0 > R_ - 1 ? R_ - 1 : r0); r1 = r1 < 0 ? 0 : (r1 > R_ - 1 ? R_ - 1 : r1); r2 = r2 < 0 ? 0 : (r2 > R_ - 1 ? R_ - 1 : r2); r3 = r3 < 0 ? 0 : (r3 > R_ - 1 ? R_ - 1 : r3);
    ao0 = (size_t)r0 * K + lc; ao1 = (size_t)r1 * K + lc; ao2 = (size_t)r2 * K + lc; ao3 = (size_t)r3 * K + lc; }
  const bf16_t* bp0 = Bt + (size_t)(brow0 + lr) * K + lc;
  const size_t bstep = (size_t)32 * K;
  f32x4 acc[4][4];
#pragma unroll
  for (int a = 0; a < 4; ++a)
#pragma unroll
    for (int b = 0; b < 4; ++b) acc[a][b] = (f32x4){0.f, 0.f, 0.f, 0.f};
  const int nk = K >> 6;
  char* ldsA = (char*)As + wid * 1024; char* ldsB = (char*)Bs + wid * 1024;
#define GEMM_GLDS(kt_, buf_) do { const int ko_ = (kt_) * 64; char* la_ = ldsA + (buf_) * 16384; char* lb_ = ldsB + (buf_) * 16384; \
    __builtin_amdgcn_global_load_lds((const unsigned*)(A + ao0 + ko_), (unsigned*)(la_), 16, 0, 0); \
    __builtin_amdgcn_global_load_lds((const unsigned*)(A + ao1 + ko_), (unsigned*)(la_ + 4096), 16, 0, 0); \
    __builtin_amdgcn_global_load_lds((const unsigned*)(A + ao2 + ko_), (unsigned*)(la_ + 8192), 16, 0, 0); \
    __builtin_amdgcn_global_load_lds((const unsigned*)(A + ao3 + ko_), (unsigned*)(la_ + 12288), 16, 0, 0); \
    __builtin_amdgcn_global_load_lds((const unsigned*)(bp0 + ko_), (unsigned*)(lb_), 16, 0, 0); \
    __builtin_amdgcn_global_load_lds((const unsigned*)(bp0 + bstep + ko_), (unsigned*)(lb_ + 4096), 16, 0, 0); \
    __builtin_amdgcn_global_load_lds((const unsigned*)(bp0 + 2 * bstep + ko_), (unsigned*)(lb_ + 8192), 16, 0, 0); \
    __builtin_amdgcn_global_load_lds((const unsigned*)(bp0 + 3 * bstep + ko_), (unsigned*)(lb_ + 12288), 16, 0, 0); } while (0)
  GEMM_GLDS(0, 0);
  for (int kt = 0; kt < nk; ++kt) {
   {
    const int buf = kt & 1;
    asm volatile("s_waitcnt vmcnt(0)" ::: "memory");
    __syncthreads();
    if (kt + 1 < nk) GEMM_GLDS(kt + 1, buf ^ 1);
    __builtin_amdgcn_sched_barrier(0);
    const bf16_t* as = As + buf * 128 * 64; const bf16_t* bs = Bs + buf * 128 * 64;
#pragma unroll
    for (int ks = 0; ks < 2; ++ks) {
      bf16x8 af[4], bfr[4];
#pragma unroll
      for (int i = 0; i < 4; ++i) { af[i] = *(const bf16x8*)&as[(wm * 64 + i * 16 + fr) * 64 + (((ks * 4 + fq) ^ (fr & 7)) * 8)]; bfr[i] = *(const bf16x8*)&bs[(wn * 64 + i * 16 + fr) * 64 + (((ks * 4 + fq) ^ (fr & 7)) * 8)]; }
#pragma unroll
      for (int ni = 0; ni < 4; ++ni)
#pragma unroll
        for (int mi = 0; mi < 4; ++mi) acc[ni][mi] = mfma16(bfr[ni], af[mi], acc[ni][mi]);
    }
   }
  }
  __syncthreads();
  if (EPI == 0) {
    bf16_t* P = (bf16_t*)(p.ws + OFF_P);
#pragma unroll
    for (int mi = 0; mi < 4; ++mi) { const size_t row = (size_t)(arow0 + wm * 64 + mi * 16 + fr);
#pragma unroll
      for (int ni = 0; ni < 4; ++ni) { uint2 o; o.x = pack2(acc[ni][mi][0], acc[ni][mi][1]); o.y = pack2(acc[ni][mi][2], acc[ni][mi][3]);
        *(uint2*)(P + row * PN_ + brow0 + wn * 64 + ni * 16 + fq * 4) = o; } }
  } else if (EPI == 1) {
#pragma unroll
    for (int mi = 0; mi < 4; ++mi) { const int row = arow0 + wm * 64 + mi * 16 + fr;
      const float* xin = xrow_ptr(p, row, e.first);
      float* xout = row < LAT_ ? p.out + (size_t)row * 1024 : (float*)(p.ws + OFF_HCTX) + (size_t)(row - LAT_) * 1024;
      const float* gate = (const float*)(p.ws + OFF_MOD) + (e.l * 3 + grp_of(row)) * 6144 + e.gi * 1024;
#pragma unroll
      for (int ni = 0; ni < 4; ++ni) { const int col = brow0 + wn * 64 + ni * 16 + fq * 4;
        const float4 xi = *(const float4*)(xin + col), g = *(const float4*)(gate + col);
        float4 o; o.x = xi.x + g.x * acc[ni][mi][0]; o.y = xi.y + g.y * acc[ni][mi][1]; o.z = xi.z + g.z * acc[ni][mi][2]; o.w = xi.w + g.w * acc[ni][mi][3];
        *(float4*)(xout + col) = o; } }
  } else {
    constexpr int GS = 68;
    float* G = (float*)ldsc;
    float* Vb = (float*)(ldsc + 128 * GS * 4);
    if (wn == 0) {
#pragma unroll
      for (int mi = 0; mi < 4; ++mi)
#pragma unroll
        for (int ni = 0; ni < 4; ++ni) *(f32x4*)&G[(wm * 64 + mi * 16 + fr) * GS + ni * 16 + fq * 4] = acc[ni][mi];
    } else {
#pragma unroll
      for (int mi = 2; mi < 4; ++mi)
#pragma unroll
        for (int ni = 0; ni < 4; ++ni) *(f32x4*)&Vb[(wm * 64 + mi * 16 + fr) * GS + ni * 16 + fq * 4] = acc[ni][mi];
    }
    __syncthreads();
    {
      bf16_t* H = (bf16_t*)(p.ws + OFF_P);
      const float* cw = p.ffn_conv_w + (size_t)e.l * 3 * DFF_ + tn * 64;
#pragma unroll
      for (int mi2 = 0; mi2 < 2; ++mi2) { const int mi = wn == 1 ? mi2 : mi2 + 2; const int m = wm * 64 + mi * 16 + fr, gr = arow0 + m;
        const bool valid = (m >= 1) && (m <= 126) && (gr >= 0) && (gr < R_);
        if (valid) { const bool hasp = !seq_first(gr), hasn = !seq_last(gr);
#pragma unroll
          for (int ni = 0; ni < 4; ++ni) { const int c0 = ni * 16 + fq * 4;
            const f32x4 w0 = *(const f32x4*)(cw + c0), w1 = *(const f32x4*)(cw + DFF_ + c0), w2 = *(const f32x4*)(cw + 2 * DFF_ + c0);
            const f32x4 z4 = {0.f, 0.f, 0.f, 0.f};
            const f32x4 g1 = *(const f32x4*)&G[m * GS + c0];
            const f32x4 g0 = hasp ? *(const f32x4*)&G[(m - 1) * GS + c0] : z4;
            const f32x4 g2 = hasn ? *(const f32x4*)&G[(m + 1) * GS + c0] : z4;
            const f32x4 cv = w1 * g1 + w0 * g0 + w2 * g2;
            f32x4 vv; if (wn == 1) vv = acc[ni][mi2]; else vv = *(const f32x4*)&Vb[m * GS + c0];
            uint2 o; o.x = pack2(siluf_(cv[0]) * vv[0], siluf_(cv[1]) * vv[1]); o.y = pack2(siluf_(cv[2]) * vv[2], siluf_(cv[3]) * vv[3]);
            *(uint2*)(H + (size_t)gr * DFF_ + tn * 64 + c0) = o; } } }
    }
    __syncthreads();
  }
}

DEV unsigned xcc_id() { return (unsigned)__builtin_amdgcn_s_getreg((3 << 11) | 20) & 7u; }
template <int EPI>
DEV void gemm_phase(const Params& p, const bf16_t* A, const bf16_t* Bt, int K, int ntm, int ntn, const EpiArgs& e, char* lds, int gidx) {
  __shared__ int s_q;
  unsigned* ctr = (unsigned*)(p.ws + OFF_CTRL) + 8 + gidx * 8;
  const int x0 = (int)xcc_id(), nig = 8 * ntn;
  for (int xo = 0; xo < 8; ++xo) {
    const int xcd = (x0 + xo) & 7, cnt = (ntm - xcd + 7) >> 3, total = cnt * ntn;
    for (;;) {
      if (tid_opaque() == 0) s_q = (int)atomicAdd(ctr + xcd, 1u);
      __syncthreads();
      const int q = s_q;
      __syncthreads();
      if (q >= total) break;
      const int grp = q / nig, rem = q - grp * nig, fm = grp * 8, gsz = (cnt - fm) < 8 ? (cnt - fm) : 8;
      const int tm = xcd + 8 * (fm + rem % gsz), tn = rem / gsz;
      const int arow0 = (EPI == 2) ? tm * 126 - 1 : tm * 128;
      gemm_tile<EPI>(p, A, Bt, K, arow0, tn * 128, tn, e, lds);
    }
  }
}

DEV float wave_incl_scan(float v, int lane) {
#pragma unroll
  for (int o = 1; o < 64; o <<= 1) { const float t = __shfl_up(v, o); if (lane >= o) v += t; }
  return v;
}
DEV void dn_prep_item(const Params& p, int l, int cg, int h, char* ldsc) {
  bf16_t* sIn = (bf16_t*)ldsc;
  float* sKK = (float*)ldsc;
  float* sQ = (float*)(ldsc + 25344);
  float* sK = (float*)(ldsc + 41984);
  float* sV = (float*)(ldsc + 58624);
  float* sBeta = (float*)(ldsc + 75264);
  float* sG = sBeta + 128;
  const int tid = tid_opaque(), lane = tid & 63, wid = tid >> 6;
  const bf16_t* P = (const bf16_t*)(p.ws + OFF_P);
  const int row0 = cg * 64;
  const bool hasp = !seq_first(row0), hasn = !seq_last(row0 + 63);
  for (int c = tid; c < 66 * 24; c += 256) {
    const int j = c / 24, cc = c % 24, part = cc >> 3, off = (cc & 7) * 8;
    uint4 v = {0u, 0u, 0u, 0u};
    const bool ok = (j == 0) ? hasp : (j == 65 ? hasn : true);
    if (ok) v = *(const uint4*)(P + (size_t)(row0 - 1 + j) * PN_ + part * 256 + h * 64 + off);
    *(uint4*)&sIn[j * 192 + part * 64 + off] = v;
  }
  __syncthreads();
  {
    const float* cw = p.dn_conv_w + (size_t)l * 3 * 768;
    for (int idx = tid; idx < 64 * 192; idx += 256) {
      const int t = idx / 192, ch = idx % 192, part = ch >> 6, d = ch & 63, wc = part * 256 + h * 64 + d;
      const float v = cw[wc] * bf2f(sIn[t * 192 + ch]) + cw[768 + wc] * bf2f(sIn[(t + 1) * 192 + ch]) + cw[1536 + wc] * bf2f(sIn[(t + 2) * 192 + ch]);
      float* dst = part == 0 ? sQ : (part == 1 ? sK : sV);
      dst[t * 65 + d] = siluf_(v);
    }
  }
  __syncthreads();
  {
    bf16_t* Y = (bf16_t*)(p.ws + OFF_XY); bf16_t* DK = (bf16_t*)(p.ws + OFF_DNK);
    for (int i = 0; i < 16; ++i) {
      const int t = wid * 16 + i;
      float q = sQ[t * 65 + lane], k = sK[t * 65 + lane];
      float sq = q * q, sk = k * k;
#pragma unroll
      for (int o = 32; o > 0; o >>= 1) { sq += __shfl_xor(sq, o); sk += __shfl_xor(sk, o); }
      q *= rsqrtf(sq + EPS_); k *= rsqrtf(sk + EPS_);
      sK[t * 65 + lane] = k;
      Y[(size_t)(row0 + t) * 1024 + h * 64 + lane] = f2bf(q * 0.125f);
      DK[(size_t)(row0 + t) * 256 + h * 64 + lane] = f2bf(k);
    }
    if (wid < 2) {
      const int dir = wid, t = dir ? 63 - lane : lane;
      const bf16_t* ba = P + (size_t)(row0 + t) * PN_ + C_DNBA;
      const float beta = sigmoidf_(bf2f(ba[dir * 4 + h]));
      const float xr = bf2f(ba[(2 + dir) * 4 + h]) + p.dn_dt_bias[l * 8 + dir * 4 + h];
      const float sp = fmaxf(xr, 0.f) + log1pf(__expf(-fabsf(xr)));
      const float la = -__expf(p.dn_a_log[l * 8 + dir * 4 + h]) * sp;
      const float g = wave_incl_scan(la, lane);
      sBeta[dir * 64 + lane] = beta; sG[dir * 64 + lane] = g;
      ((float*)(p.ws + OFF_DNG))[((size_t)(dir * 520 + cg) * 4 + h) * 64 + lane] = g;
    }
  }
  __syncthreads();
  const int dir = wid >> 1, role = wid & 1;
  float x[64];
  {
    const int t_l = dir ? 63 - lane : lane;
    const float bsc = sBeta[dir * 64 + lane] * (role == 0 ? __expf(sG[dir * 64 + lane]) : 1.f);
    const float* srcm = role == 0 ? sK : sV;
#pragma unroll
    for (int c = 0; c < 64; ++c) x[c] = srcm[t_l * 65 + c] * bsc;
  }
  {
    const int ti = tid >> 4, si = tid & 15;
    float a[4][4];
#pragma unroll
    for (int i = 0; i < 4; ++i)
#pragma unroll
      for (int j = 0; j < 4; ++j) a[i][j] = 0.f;
#pragma unroll 2
    for (int d = 0; d < 64; ++d) {
      float kt[4], ks[4];
#pragma unroll
      for (int i = 0; i < 4; ++i) { kt[i] = sK[(ti * 4 + i) * 65 + d]; ks[i] = sK[(si * 4 + i) * 65 + d]; }
#pragma unroll
      for (int i = 0; i < 4; ++i)
#pragma unroll
        for (int j = 0; j < 4; ++j) a[i][j] += kt[i] * ks[j];
    }
#pragma unroll
    for (int i = 0; i < 4; ++i)
#pragma unroll
      for (int j = 0; j < 4; ++j) sKK[(ti * 4 + i) * 65 + si * 4 + j] = a[i][j];
  }
  __syncthreads();
  {
    float* sA0 = sQ; float* sA1 = sK;
    for (int idx = tid; idx < 2 * 4096; idx += 256) {
      const int dd = idx >> 12, i = (idx >> 6) & 63, j = idx & 63;
      const int ti = dd ? 63 - i : i, tj = dd ? 63 - j : j;
      float v = 0.f;
      if (j < i) v = sBeta[dd * 64 + i] * sKK[ti * 65 + tj] * __expf(sG[dd * 64 + i] - sG[dd * 64 + j]);
      (dd ? sA1 : sA0)[i * 65 + j] = v;
    }
  }
  __syncthreads();
  {
    const float* sA = dir ? sK : sQ;
#pragma unroll 1
    for (int j = 0; j < 63; ++j) {
      float a = sA[lane * 65 + j]; a = lane > j ? a : 0.f;
#pragma unroll
      for (int c = 0; c < 64; ++c) { const float xj = __int_as_float(__builtin_amdgcn_readlane(__float_as_int(x[c]), j)); x[c] -= a * xj; }
    }
    const size_t base = ((size_t)(dir * 520 + cg) * 4 + h) * 4096;
    if (role == 0) {
      bf16_t* W = (bf16_t*)(p.ws + OFF_DNW) + base + lane * 64;
#pragma unroll
      for (int i = 0; i < 8; ++i) { uint4 o; o.x = pack2(x[i * 8], x[i * 8 + 1]); o.y = pack2(x[i * 8 + 2], x[i * 8 + 3]); o.z = pack2(x[i * 8 + 4], x[i * 8 + 5]); o.w = pack2(x[i * 8 + 6], x[i * 8 + 7]);
        *(uint4*)(W + i * 8) = o; }
    } else {
      bf16_t* UT = (bf16_t*)(p.ws + OFF_DNUT) + base;
#pragma unroll
      for (int c = 0; c < 64; ++c) UT[c * 64 + lane] = f2bf(x[c]);
    }
  }
  __syncthreads();
}

DEV void hg_prep_item(const Params& p, int l, int cg, int h, char* ldsc) {
  float* sQ = (float*)ldsc;
  float* sK = (float*)(ldsc + 16640);
  float* sC = (float*)(ldsc + 33280);
  float* sT = (float*)(ldsc + 49920);
  const int tid = tid_opaque(), d = tid & 63, part = tid >> 6;
  bf16_t* P = (bf16_t*)(p.ws + OFF_P); bf16_t* Y = (bf16_t*)(p.ws + OFF_XY);
  const int row0 = cg * 64;
#pragma unroll 4
  for (int i = 0; i < 16; ++i) { const int t = part * 16 + i; sQ[t * 65 + d] = 0.125f * bf2f(P[(size_t)(row0 + t) * PN_ + C_HGQ + h * 64 + d]); }
  for (int dir = 0; dir < 2; ++dir) {
    float lbv = 0.f;
    if (l == 1) { const float r0 = p.hg_lb_raw[dir * 256 + h * 64 + d], r1 = p.hg_lb_raw[512 + dir * 256 + h * 64 + d]; lbv = 1.0f / (1.0f + __expf(r0 - r1)); }
    const int fcol = (dir ? C_HGFB : C_HGFF) + h * 64 + d;
    float kk[16], cc[16]; float run = 0.f;
#pragma unroll
    for (int i = 0; i < 16; ++i) {
      const int tau = part * 16 + i, t = dir ? 63 - tau : tau;
      const float raw = bf2f(P[(size_t)(row0 + t) * PN_ + fcol]);
      const float k = (1.f - lbv) * sigmoidf_(-raw);
      kk[i] = k; run += log1pf(-k); cc[i] = run;
    }
    sT[part * 64 + d] = run;
    __syncthreads();
    float offs = 0.f;
    for (int q = 0; q < part; ++q) offs += sT[q * 64 + d];
    const float clast = sT[d] + sT[64 + d] + sT[128 + d] + sT[192 + d];
#pragma unroll
    for (int i = 0; i < 16; ++i) {
      const int tau = part * 16 + i, t = dir ? 63 - tau : tau;
      const float c = cc[i] + offs;
      sK[tau * 65 + d] = kk[i]; sC[tau * 65 + d] = c * LOG2E;
      const float qb = sQ[t * 65 + d] * __expf(c), ke = kk[i] * __expf(clast - c);
      if (dir == 0) P[(size_t)(row0 + t) * PN_ + C_HGQ + h * 64 + d] = f2bf(qb); else Y[(size_t)(row0 + t) * 1024 + 768 + h * 64 + d] = f2bf(qb);
      P[(size_t)(row0 + t) * PN_ + fcol] = f2bf(ke);
    }
    if (part == 0) ((float*)(p.ws + OFF_HGDE))[((size_t)(dir * 520 + cg) * 4 + h) * 64 + d] = __expf(clast);
    __syncthreads();
    {
      const int ti = tid >> 4, si = tid & 15;
      float a[4][4];
#pragma unroll
      for (int i = 0; i < 4; ++i)
#pragma unroll
        for (int j = 0; j < 4; ++j) a[i][j] = 0.f;
      if (si < ti) {
#pragma unroll 2
        for (int dd = 0; dd < 64; ++dd) {
          float qa[4], ca[4], kb[4], cb[4];
#pragma unroll
          for (int i = 0; i < 4; ++i) { const int tau = ti * 4 + i, t = dir ? 63 - tau : tau; qa[i] = sQ[t * 65 + dd]; ca[i] = sC[tau * 65 + dd]; kb[i] = sK[(si * 4 + i) * 65 + dd]; cb[i] = sC[(si * 4 + i) * 65 + dd]; }
          const float cr = ca[0];
          float qe[4], ke[4];
          qe[0] = qa[0];
#pragma unroll
          for (int i = 1; i < 4; ++i) qe[i] = qa[i] * __builtin_amdgcn_exp2f(ca[i] - cr);
#pragma unroll
          for (int j = 0; j < 4; ++j) ke[j] = kb[j] * __builtin_amdgcn_exp2f(cr - cb[j]);
#pragma unroll
          for (int i = 0; i < 4; ++i)
#pragma unroll
            for (int j = 0; j < 4; ++j) a[i][j] += qe[i] * ke[j];
        }
      }
      bf16_t* ATT = (bf16_t*)(p.ws + OFF_HGATT) + ((size_t)(dir * 520 + cg) * 4 + h) * 4096;
      if (si != ti) {
#pragma unroll
        for (int i = 0; i < 4; ++i) { const int tau = ti * 4 + i;
          uint2 o; o.x = pack2(a[i][0], a[i][1]); o.y = pack2(a[i][2], a[i][3]);
          *(uint2*)(ATT + tau * 64 + si * 4) = o; }
      }
      {
        const int dtile = tid >> 4, i = (tid >> 2) & 3, j = tid & 3, tau = dtile * 4 + i, sg = dtile * 4 + j, t = dir ? 63 - tau : tau;
        float s = 0.f;
        if (sg <= tau) {
#pragma unroll 4
          for (int dd = 0; dd < 64; ++dd) s += sQ[t * 65 + dd] * sK[sg * 65 + dd] * __builtin_amdgcn_exp2f(fminf(sC[tau * 65 + dd] - sC[sg * 65 + dd], 0.f));
        }
        ATT[tau * 64 + sg] = f2bf(s);
      }
    }
    __syncthreads();
  }
}

DEV void rope_rows(const Params& p, int rb) {
  bf16_t* P = (bf16_t*)(p.ws + OFF_P);
  const int tid = tid_opaque(), r = rb * 16 + (tid >> 4), v = tid & 15;
  const int tpos = r & 16383, grow = tpos >> 6, gcol = tpos & 63;
  bf16_t* ptr = P + (size_t)r * PN_ + (v < 8 ? C_DFQ : C_DFK) + (v & 7) * 32;
  uint4 u[4];
#pragma unroll
  for (int i = 0; i < 4; ++i) u[i] = *(const uint4*)(ptr + i * 8);
  float xv[32];
#pragma unroll
  for (int i = 0; i < 4; ++i) { xv[i * 8 + 0] = lo_bf(u[i].x); xv[i * 8 + 1] = hi_bf(u[i].x); xv[i * 8 + 2] = lo_bf(u[i].y); xv[i * 8 + 3] = hi_bf(u[i].y);
    xv[i * 8 + 4] = lo_bf(u[i].z); xv[i * 8 + 5] = hi_bf(u[i].z); xv[i * 8 + 6] = lo_bf(u[i].w); xv[i * 8 + 7] = hi_bf(u[i].w); }
  const float inv[8] = {1.0f, 0.31622776601683794f, 0.1f, 0.031622776601683794f, 0.01f, 0.0031622776601683794f, 0.001f, 0.00031622776601683794f};
  float yv[32];
#pragma unroll
  for (int i = 0; i < 8; ++i) {
    float ar = (float)grow * inv[i] * 0.15915494309189535f, ac = (float)gcol * inv[i] * 0.15915494309189535f;
    ar -= floorf(ar); ac -= floorf(ac);
    const float cr = __builtin_amdgcn_cosf(ar), sr = __builtin_amdgcn_sinf(ar), cc = __builtin_amdgcn_cosf(ac), sc = __builtin_amdgcn_sinf(ac);
    yv[i] = xv[i] * cr - xv[i + 8] * sr; yv[i + 8] = xv[i + 8] * cr + xv[i] * sr;
    yv[16 + i] = xv[16 + i] * cc - xv[24 + i] * sc; yv[24 + i] = xv[24 + i] * cc + xv[16 + i] * sc;
  }
#pragma unroll
  for (int i = 0; i < 4; ++i) { uint4 o; o.x = pack2(yv[i * 8], yv[i * 8 + 1]); o.y = pack2(yv[i * 8 + 2], yv[i * 8 + 3]); o.z = pack2(yv[i * 8 + 4], yv[i * 8 + 5]); o.w = pack2(yv[i * 8 + 6], yv[i * 8 + 7]);
    *(uint4*)(ptr + i * 8) = o; }
}

DEV void vt_prep_item(const Params& p, int bh, int t, char* ldsc);
DEV void prep_phase(const Params& p, int l, char* lds) {
  const int nitems = 4160 + 2048 + 2080;
  for (int it = bid_opaque(); it < nitems; it += gridDim.x) {
    const int lo = l;
    if (it < 2080) dn_prep_item(p, lo, it >> 2, it & 3, lds);
    else if (it < 4160) hg_prep_item(p, lo, (it - 2080) >> 2, (it - 2080) & 3, lds);
    else if (it < 6208) rope_rows(p, it - 4160);
    else vt_prep_item(p, (it - 6208) / 260, (it - 6208) % 260, lds);
  }
}

DEV void post_phase(const Params& p, int l) {
  const int lane = tid_opaque() & 63, gw = bid_opaque() * 4 + (tid_opaque() >> 6), nw = gridDim.x * 4;
  bf16_t* P = (bf16_t*)(p.ws + OFF_P); bf16_t* Y = (bf16_t*)(p.ws + OFF_XY);
  {
    const float* lp = p.df_lambda + l * 128;
    float la = lane < 32 ? lp[lane] * lp[32 + lane] : 0.f, lc = lane < 32 ? lp[64 + lane] * lp[96 + lane] : 0.f;
#pragma unroll
    for (int o = 32; o > 0; o >>= 1) { la += __shfl_xor(la, o); lc += __shfl_xor(lc, o); }
    const float lam = __expf(la) - __expf(lc) + p.lam_init[l];
    const float nwv = p.df_norm_w[l * 64 + lane] * (1.0f - p.lam_init[l]);
    for (int rr = gw; rr < 128 * 64; rr += nw) {
      const int j = rr >> 6, row = rr & 63, a = 1920 + j, bb = a >> 10, hh = (a >> 8) & 3, qt = a & 255;
      const float* pa = (const float*)(p.ws + OFF_PART) + ((size_t)(2 * j) * 64 + row) * 132;
      const float* pb = pa + (size_t)64 * 132;
      const float m1 = fmaxf(pa[128], pb[128]), m2 = fmaxf(pa[130], pb[130]);
      const float wa1 = __builtin_amdgcn_exp2f(pa[128] - m1), wb1 = __builtin_amdgcn_exp2f(pb[128] - m1);
      const float wa2 = __builtin_amdgcn_exp2f(pa[130] - m2), wb2 = __builtin_amdgcn_exp2f(pb[130] - m2);
      const float L1 = pa[129] * wa1 + pb[129] * wb1, L2 = pa[131] * wa2 + pb[131] * wb2;
      const float o1 = pa[lane] * wa1 + pb[lane] * wb1, o2 = pa[64 + lane] * wa2 + pb[64 + lane] * wb2;
      const float o = o1 / L1 - lam * o2 / L2;
      float ss = o * o;
#pragma unroll
      for (int s = 32; s > 0; s >>= 1) ss += __shfl_xor(ss, s);
      const float y = o * rsqrtf(ss * (1.0f / 64.0f) + EPS_) * nwv;
      Y[(size_t)(bb * 16384 + qt * 64 + row) * 1024 + 512 + hh * 64 + lane] = f2bf(y);
    }
  }
  for (int it = gw; it < 2 * R_; it += nw) {
    const int r = it >> 1, mix = it & 1;
    const int c = lane * 4;
    uint2 uf, ub, ug;
    if (mix == 0) { uf = *(const uint2*)(P + (size_t)r * PN_ + C_DNQ + c); ub = *(const uint2*)(P + (size_t)r * PN_ + C_DNK + c); ug = *(const uint2*)(P + (size_t)r * PN_ + C_DNG + c); }
    else { uf = *(const uint2*)(P + (size_t)r * PN_ + C_HGQ + c); ub = *(const uint2*)(Y + (size_t)r * 1024 + 768 + c); ug = *(const uint2*)(P + (size_t)r * PN_ + C_HGG + c); }
    float o[4] = {lo_bf(uf.x) + lo_bf(ub.x), hi_bf(uf.x) + hi_bf(ub.x), lo_bf(uf.y) + lo_bf(ub.y), hi_bf(uf.y) + hi_bf(ub.y)};
    const float g[4] = {lo_bf(ug.x), hi_bf(ug.x), lo_bf(ug.y), hi_bf(ug.y)};
    float ss = o[0] * o[0] + o[1] * o[1] + o[2] * o[2] + o[3] * o[3];
#pragma unroll
    for (int s = 8; s > 0; s >>= 1) ss += __shfl_xor(ss, s);
    const float rs = rsqrtf(ss * (1.0f / 64.0f) + EPS_);
    const float* nw_ = (mix == 0 ? p.dn_norm_w : p.hg_norm_w) + l * 64 + (c & 63);
    float y[4];
#pragma unroll
    for (int i = 0; i < 4; ++i) y[i] = o[i] * rs * nw_[i] * siluf_(g[i]);
    uint2 ov; ov.x = pack2(y[0], y[1]); ov.y = pack2(y[2], y[3]);
    *(uint2*)(Y + (size_t)r * 1024 + (mix == 0 ? 0 : 768) + c) = ov;
  }
}

DEV bf16x8 pack8(const f32x4& a, const f32x4& b) {
  union { bf16x8 v; unsigned u[4]; } r;
  r.u[0] = pack2(a[0], a[1]); r.u[1] = pack2(a[2], a[3]); r.u[2] = pack2(b[0], b[1]); r.u[3] = pack2(b[2], b[3]);
  return r.v;
}
DEV void vt_tr_store(bf16_t* vt, int off, int key, const uint4& v) {
  vt[(off + 0) * LDT + key] = (bf16_t)(v.x & 0xffffu); vt[(off + 1) * LDT + key] = (bf16_t)(v.x >> 16);
  vt[(off + 2) * LDT + key] = (bf16_t)(v.y & 0xffffu); vt[(off + 3) * LDT + key] = (bf16_t)(v.y >> 16);
  vt[(off + 4) * LDT + key] = (bf16_t)(v.z & 0xffffu); vt[(off + 5) * LDT + key] = (bf16_t)(v.z >> 16);
  vt[(off + 6) * LDT + key] = (bf16_t)(v.w & 0xffffu); vt[(off + 7) * LDT + key] = (bf16_t)(v.w >> 16);
}
DEV void vt_prep_item(const Params& p, int bh, int t, char* ldsc) {
  bf16_t* sT = (bf16_t*)ldsc;
  const int tid = tid_opaque(), b = bh >> 2, h = bh & 3;
  const bf16_t* P = (const bf16_t*)(p.ws + OFF_P);
  const int trow = t < 4 ? LAT_ + b * 256 + t * 64 : b * 16384 + (t - 4) * 64;
  const int lkey = tid >> 3, loff = (tid & 7) * 8;
  const int lkp = lkey < 16 ? ((lkey >> 2) * 8 + (lkey & 3)) : (((lkey - 16) >> 2) * 8 + 4 + (lkey & 3));
  const uint4 v0 = *(const uint4*)(P + (size_t)(trow + lkey) * PN_ + C_DFV + h * 64 + loff);
  const uint4 v1 = *(const uint4*)(P + (size_t)(trow + lkey + 32) * PN_ + C_DFV + h * 64 + loff);
  vt_tr_store(sT, loff, lkp, v0); vt_tr_store(sT, loff, lkp + 32, v1);
  __syncthreads();
  bf16_t* dst = (bf16_t*)(p.ws + OFF_VTG) + ((size_t)bh * 64) * 16640 + (size_t)t * 64;
#pragma unroll
  for (int i = 0; i < 2; ++i) { const int dv = (tid >> 3) + 32 * i; *(uint4*)(dst + (size_t)dv * 16640 + loff) = *(const uint4*)&sT[dv * LDT + loff]; }
  __syncthreads();
}

template <int MODE>
DEV void attn_item(const Params& p, int l, int kind, int b, int h, int qt, char* ldsc, int part = -1, int pslot = 0) {
  bf16_t* Ks = (bf16_t*)ldsc;
  bf16_t* VT = Ks + 2 * 64 * LDT;
  float* sRpb = (float*)(ldsc + 4 * 64 * LDT * 2);
  const int tid = tid_opaque(), lane = tid & 63, wid = tid >> 6, fr = lane & 15, fq = lane >> 4;
  const bf16_t* P = (const bf16_t*)(p.ws + OFF_P);
  bf16_t* Y = (bf16_t*)(p.ws + OFF_XY);
  const int qcol = (MODE == 0 ? C_DFQ : C_NAQ) + h * 64, kcol = (MODE == 0 ? C_DFK : C_NAK) + h * 64, vcol = (MODE == 0 ? C_DFV : C_NAV) + h * 64;
  const int qrow0 = kind == 0 ? b * 16384 + qt * 64 : LAT_ + b * 256 + qt * 64;
  int nprim = 0, prim_row0 = 0, r_start = 0;
  if (kind == 0) { if (MODE == 0) { nprim = 256; prim_row0 = b * 16384; } else { r_start = qt - 4; r_start = r_start < 0 ? 0 : (r_start > 248 ? 248 : r_start); nprim = 8; prim_row0 = b * 16384 + r_start * 64; } }
  const int ntiles = nprim + 4, ctx_row0 = LAT_ + b * 256;
  const int t0 = part < 0 ? 0 : part * (ntiles >> 1), t1 = part < 0 ? ntiles : t0 + (ntiles >> 1);
  float lam = 0.f;
  if (MODE == 0) {
    const float* lp = p.df_lambda + l * 128;
    float a = lane < 32 ? lp[lane] * lp[32 + lane] : 0.f, c = lane < 32 ? lp[64 + lane] * lp[96 + lane] : 0.f;
#pragma unroll
    for (int o = 32; o > 0; o >>= 1) { a += __shfl_xor(a, o); c += __shfl_xor(c, o); }
    lam = __expf(a) - __expf(c) + p.lam_init[l];
  } else {
    for (int i = tid; i < 465; i += 256) sRpb[i] = p.na_rpb[(size_t)(l * 4 + h) * 465 + i];
  }
  const int qrow = qrow0 + wid * 16 + fr;
  const bf16x8 q0 = *(const bf16x8*)(P + (size_t)qrow * PN_ + qcol + fq * 8);
  const bf16x8 q1 = *(const bf16x8*)(P + (size_t)qrow * PN_ + qcol + 32 + fq * 8);
  f32x4 O1[4], O2[4];
#pragma unroll
  for (int i = 0; i < 4; ++i) { O1[i] = (f32x4){0.f, 0.f, 0.f, 0.f}; O2[i] = (f32x4){0.f, 0.f, 0.f, 0.f}; }
  float m1 = -INFINITY, m2 = -INFINITY;
  f32x4 L1 = {0.f, 0.f, 0.f, 0.f}, L2 = {0.f, 0.f, 0.f, 0.f};
  const float sc = (MODE == 0 ? 0.17677669529663687f : 0.125f) * LOG2E;
  const int lkey = tid >> 3, loff = (tid & 7) * 8;
  const bf16_t* vtg = (const bf16_t*)(p.ws + OFF_VTG) + (size_t)(b * 4 + h) * 64 * 16640;
  const int lkp = lkey < 16 ? ((lkey >> 2) * 8 + (lkey & 3)) : (((lkey - 16) >> 2) * 8 + 4 + (lkey & 3));
  uint4 rk0A, rk1A, rv0A, rv1A, rk0B, rk1B, rv0B, rv1B;
#define ATT_GLOAD(it_, S) do { const int trow_ = (it_) < nprim ? prim_row0 + (it_) * 64 : ctx_row0 + ((it_) - nprim) * 64; \
    const bf16_t* s0_ = P + (size_t)(trow_ + lkey) * PN_; const bf16_t* s1_ = P + (size_t)(trow_ + lkey + 32) * PN_; \
    rk0##S = *(const uint4*)(s0_ + kcol + loff); rk1##S = *(const uint4*)(s1_ + kcol + loff); \
    if (MODE == 0) { const int kt_ = (it_) < nprim ? 4 + (it_) : (it_) - nprim; const bf16_t* v_ = vtg + (size_t)lkey * 16640 + kt_ * 64 + loff; \
      rv0##S = *(const uint4*)(v_); rv1##S = *(const uint4*)(v_ + (size_t)32 * 16640); } \
    else { rv0##S = *(const uint4*)(s0_ + vcol + loff); rv1##S = *(const uint4*)(s1_ + vcol + loff); } } while (0)
#define ATT_LSTORE(buf_, S) do { bf16_t* ks_ = Ks + (buf_) * 64 * LDT; bf16_t* vt_ = VT + (buf_) * 64 * LDT; \
    *(uint4*)&ks_[lkey * LDT + loff] = rk0##S; *(uint4*)&ks_[(lkey + 32) * LDT + loff] = rk1##S; \
    if (MODE == 0) { *(uint4*)&vt_[lkey * LDT + loff] = rv0##S; *(uint4*)&vt_[(lkey + 32) * LDT + loff] = rv1##S; } \
    else { vt_tr_store(vt_, loff, lkp, rv0##S); vt_tr_store(vt_, loff, lkp + 32, rv1##S); } } while (0)
  ATT_GLOAD(t0, A); __builtin_amdgcn_sched_barrier(0); ATT_GLOAD(t0 + 1, B); __builtin_amdgcn_sched_barrier(0);
  for (int it0 = t0; it0 < t1; it0 += 2) {
#pragma unroll
   for (int half = 0; half < 2; ++half) {
    const int it = it0 + half, buf = half;
    if (half == 0) ATT_LSTORE(0, A); else ATT_LSTORE(1, B);
    __syncthreads();
    { const int itn = (it + 2 < t1) ? it + 2 : t1 - 1; if (half == 0) ATT_GLOAD(itn, A); else ATT_GLOAD(itn, B); }
    __builtin_amdgcn_sched_barrier(0);
    const bf16_t* ks = Ks + buf * 64 * LDT; const bf16_t* vt = VT + buf * 64 * LDT;
    f32x4 s1[4], s2[4];
#pragma unroll
    for (int kt = 0; kt < 4; ++kt) {
      const bf16x8 k0 = *(const bf16x8*)&ks[(kt * 16 + fr) * LDT + fq * 8], k1 = *(const bf16x8*)&ks[(kt * 16 + fr) * LDT + 32 + fq * 8];
      const f32x4 z = {0.f, 0.f, 0.f, 0.f};
      if (MODE == 0) { s1[kt] = mfma16(k0, q0, z); s2[kt] = mfma16(k1, q1, z); }
      else { s1[kt] = mfma16(k1, q1, mfma16(k0, q0, z)); }
    }
    float pre = sc;
    if (MODE == 1 && kind == 0 && it < nprim) {
      const int w = wid * 16 + fr; int cs = w - 8; cs = cs < 0 ? 0 : (cs > 48 ? 48 : cs);
      const float* rp = sRpb + (r_start + it - qt + 7) * 31 + 15 - w;
#pragma unroll
      for (int kt = 0; kt < 4; ++kt)
#pragma unroll
        for (int r = 0; r < 4; ++r) { const int kj = kt * 16 + fq * 4 + r; const bool ok = (kj >= cs) && (kj < cs + 16);
          s1[kt][r] = ok ? s1[kt][r] * sc + rp[ok ? kj : w] * LOG2E : -INFINITY; }
      pre = 1.0f;
    }
    {
      float lm = fmaxf(fmaxf(s1[0][0], s1[0][1]), s1[0][2]);
      lm = fmaxf(fmaxf(lm, s1[0][3]), s1[1][0]); lm = fmaxf(fmaxf(lm, s1[1][1]), s1[1][2]); lm = fmaxf(fmaxf(lm, s1[1][3]), s1[2][0]); lm = fmaxf(fmaxf(lm, s1[2][1]), s1[2][2]);
      lm = fmaxf(fmaxf(lm, s1[2][3]), s1[3][0]); lm = fmaxf(fmaxf(lm, s1[3][1]), s1[3][2]); lm = fmaxf(lm, s1[3][3]);
      lm *= pre;
      if (__any(lm > m1 + 8.0f)) {
        float mx = fmaxf(lm, __shfl_xor(lm, 16)); mx = fmaxf(mx, __shfl_xor(mx, 32));
        const float mn = fmaxf(m1, mx), al = __builtin_amdgcn_exp2f(m1 - mn); m1 = mn;
#pragma unroll
        for (int dt = 0; dt < 4; ++dt) O1[dt] = O1[dt] * al;
        L1 = L1 * al;
      }
      { const f32x2_t pv = {pre, pre}, nm = {-m1, -m1};
#pragma unroll
        for (int kt = 0; kt < 4; ++kt) {
          const f32x2_t a = __builtin_elementwise_fma((f32x2_t){s1[kt][0], s1[kt][1]}, pv, nm), b = __builtin_elementwise_fma((f32x2_t){s1[kt][2], s1[kt][3]}, pv, nm);
          s1[kt][0] = __builtin_amdgcn_exp2f(a.x); s1[kt][1] = __builtin_amdgcn_exp2f(a.y); s1[kt][2] = __builtin_amdgcn_exp2f(b.x); s1[kt][3] = __builtin_amdgcn_exp2f(b.y); } }
    }
    if (MODE == 0) {
      float lm = fmaxf(fmaxf(s2[0][0], s2[0][1]), s2[0][2]);
      lm = fmaxf(fmaxf(lm, s2[0][3]), s2[1][0]); lm = fmaxf(fmaxf(lm, s2[1][1]), s2[1][2]); lm = fmaxf(fmaxf(lm, s2[1][3]), s2[2][0]); lm = fmaxf(fmaxf(lm, s2[2][1]), s2[2][2]);
      lm = fmaxf(fmaxf(lm, s2[2][3]), s2[3][0]); lm = fmaxf(fmaxf(lm, s2[3][1]), s2[3][2]); lm = fmaxf(lm, s2[3][3]);
      lm *= sc;
      if (__any(lm > m2 + 8.0f)) {
        float mx = fmaxf(lm, __shfl_xor(lm, 16)); mx = fmaxf(mx, __shfl_xor(mx, 32));
        const float mn = fmaxf(m2, mx), al = __builtin_amdgcn_exp2f(m2 - mn); m2 = mn;
#pragma unroll
        for (int dt = 0; dt < 4; ++dt) O2[dt] = O2[dt] * al;
        L2 = L2 * al;
      }
      { const f32x2_t pv = {sc, sc}, nm = {-m2, -m2};
#pragma unroll
        for (int kt = 0; kt < 4; ++kt) {
          const f32x2_t a = __builtin_elementwise_fma((f32x2_t){s2[kt][0], s2[kt][1]}, pv, nm), b = __builtin_elementwise_fma((f32x2_t){s2[kt][2], s2[kt][3]}, pv, nm);
          s2[kt][0] = __builtin_amdgcn_exp2f(a.x); s2[kt][1] = __builtin_amdgcn_exp2f(a.y); s2[kt][2] = __builtin_amdgcn_exp2f(b.x); s2[kt][3] = __builtin_amdgcn_exp2f(b.y); } }
    }
    union { bf16x8 v; unsigned u[4]; } ones; ones.u[0] = ones.u[1] = ones.u[2] = ones.u[3] = 0x3f803f80u;
#pragma unroll
    for (int kk = 0; kk < 2; ++kk) {
      const bf16x8 pb1 = pack8(s1[2 * kk], s1[2 * kk + 1]);
      bf16x8 pb2 = pb1; if (MODE == 0) pb2 = pack8(s2[2 * kk], s2[2 * kk + 1]);
      L1 = mfma16(ones.v, pb1, L1);
      if (MODE == 0) L2 = mfma16(ones.v, pb2, L2);
#pragma unroll
      for (int dt = 0; dt < 4; ++dt) {
        const bf16x8 vfv = *(const bf16x8*)&vt[(dt * 16 + fr) * LDT + 32 * kk + fq * 8];
        O1[dt] = mfma16(vfv, pb1, O1[dt]);
        if (MODE == 0) O2[dt] = mfma16(vfv, pb2, O2[dt]);
      }
    }
   }
  }
  if (MODE == 0 && part >= 0) {
    float* pr = (float*)(p.ws + OFF_PART) + ((size_t)pslot * 64 + wid * 16 + fr) * 132;
#pragma unroll
    for (int dt = 0; dt < 4; ++dt) { *(f32x4*)(pr + dt * 16 + fq * 4) = O1[dt]; *(f32x4*)(pr + 64 + dt * 16 + fq * 4) = O2[dt]; }
    if (fq == 0) { *(f32x4*)(pr + 128) = (f32x4){m1, L1[0], m2, L2[0]}; }
    __syncthreads();
    return;
  }
  const float i1 = 1.0f / L1[0];
  float o[4][4];
  if (MODE == 0) {
    const float i2 = lam / L2[0];
    float ss = 0.f;
#pragma unroll
    for (int dt = 0; dt < 4; ++dt)
#pragma unroll
      for (int r = 0; r < 4; ++r) { o[dt][r] = O1[dt][r] * i1 - O2[dt][r] * i2; ss += o[dt][r] * o[dt][r]; }
    ss += __shfl_xor(ss, 16); ss += __shfl_xor(ss, 32);
    const float rs = rsqrtf(ss * (1.0f / 64.0f) + EPS_) * (1.0f - p.lam_init[l]);
#pragma unroll
    for (int dt = 0; dt < 4; ++dt)
#pragma unroll
      for (int r = 0; r < 4; ++r) o[dt][r] *= rs * p.df_norm_w[l * 64 + dt * 16 + fq * 4 + r];
  } else {
#pragma unroll
    for (int dt = 0; dt < 4; ++dt)
#pragma unroll
      for (int r = 0; r < 4; ++r) o[dt][r] = O1[dt][r] * i1;
  }
  bf16_t* yr = Y + (size_t)qrow * 1024 + (MODE == 0 ? 512 : 256) + h * 64 + fq * 4;
#pragma unroll
  for (int dt = 0; dt < 4; ++dt) { uint2 ov; ov.x = pack2(o[dt][0], o[dt][1]); ov.y = pack2(o[dt][2], o[dt][3]); *(uint2*)(yr + dt * 16) = ov; }
  __syncthreads();
}

struct DnIn { bf16x8 qa[2], ka[2], wa[2], qb[4][2]; uint2 ut[4]; f32x4 gr; float gc[4]; float gl; };
DEV int chain_cg(int b, int dir, int step) {
  if (step < 4) return 512 + b * 4 + (dir ? 3 - step : step);
  const int ci = step - 4; return b * 256 + (dir ? 255 - ci : ci);
}
DEV void dn_load(const Params& p, DnIn& in, int cg, int h, int dir, int wid, int fr, int fq) {
  const bf16_t* Yq = (const bf16_t*)(p.ws + OFF_XY); const bf16_t* DK = (const bf16_t*)(p.ws + OFF_DNK);
  const size_t base = ((size_t)(dir * 520 + cg) * 4 + h);
  const bf16_t* W = (const bf16_t*)(p.ws + OFF_DNW) + base * 4096; const bf16_t* UT = (const bf16_t*)(p.ws + OFF_DNUT) + base * 4096;
  const float* G = (const float*)(p.ws + OFF_DNG) + base * 64;
  const int tau = wid * 16 + fr, row = cg * 64 + (dir ? 63 - tau : tau);
#pragma unroll
  for (int ks = 0; ks < 2; ++ks) {
    in.qa[ks] = *(const bf16x8*)(Yq + (size_t)row * 1024 + h * 64 + ks * 32 + fq * 8);
    in.ka[ks] = *(const bf16x8*)(DK + (size_t)row * 256 + h * 64 + ks * 32 + fq * 8);
    in.wa[ks] = *(const bf16x8*)(W + tau * 64 + ks * 32 + fq * 8);
  }
#pragma unroll
  for (int n = 0; n < 4; ++n) {
    const int t2 = n * 16 + fr, row2 = cg * 64 + (dir ? 63 - t2 : t2);
#pragma unroll
    for (int ks = 0; ks < 2; ++ks) in.qb[n][ks] = *(const bf16x8*)(Yq + (size_t)row2 * 1024 + h * 64 + ks * 32 + fq * 8);
    in.ut[n] = *(const uint2*)(UT + (n * 16 + fr) * 64 + wid * 16 + fq * 4);
    in.gc[n] = G[n * 16 + fr];
  }
  in.gr = *(const f32x4*)(G + wid * 16 + fq * 4);
  in.gl = G[63];
}
DEV void dn_scan_chain(const Params& p, int l, int chain, char* ldsc) {
  bf16_t* ST = (bf16_t*)ldsc; bf16_t* sAt = ST + 64 * LDT; bf16_t* sVT = sAt + 64 * LDT; bf16_t* sVT2 = sVT + 64 * LDT; bf16_t* sKT = sVT2 + 64 * LDT;
  const int tid = tid_opaque(), lane = tid & 63, wid = tid >> 6, fr = lane & 15, fq = lane >> 4;
  const int b = chain >> 3, h = (chain >> 1) & 3, dir = chain & 1;
  bf16_t* P = (bf16_t*)(p.ws + OFF_P);
  const int ocol = (dir ? C_DNK : C_DNQ) + h * 64;
  f32x4 S[4];
#pragma unroll
  for (int n = 0; n < 4; ++n) { S[n] = (f32x4){0.f, 0.f, 0.f, 0.f}; *(uint2*)&ST[(n * 16 + fr) * LDT + wid * 16 + fq * 4] = (uint2){0u, 0u}; }
  DnIn cur; dn_load(p, cur, chain_cg(b, dir, 0), h, dir, wid, fr, fq);
  __syncthreads();
  for (int step = 0; step < 260; ++step) {
    const int cg = chain_cg(b, dir, step);
    DnIn nxt; dn_load(p, nxt, chain_cg(b, dir, step + 1 < 260 ? step + 1 : step), h, dir, wid, fr, fq);
    __builtin_amdgcn_sched_barrier(0);
    const f32x4 z = {0.f, 0.f, 0.f, 0.f};
#pragma unroll
    for (int n = 0; n < 4; ++n) {
      f32x4 a = mfma16(cur.ka[0], cur.qb[n][0], z); a = mfma16(cur.ka[1], cur.qb[n][1], a);
      float v[4];
#pragma unroll
      for (int r = 0; r < 4; ++r) { const int s = wid * 16 + fq * 4 + r, t = n * 16 + fr; v[r] = (s <= t) ? a[r] * __expf(cur.gc[n] - cur.gr[r]) : 0.f; }
      uint2 o; o.x = pack2(v[0], v[1]); o.y = pack2(v[2], v[3]);
      *(uint2*)&sAt[(n * 16 + fr) * LDT + wid * 16 + fq * 4] = o;
    }
    f32x4 o1[4];
#pragma unroll
    for (int n = 0; n < 4; ++n) {
      f32x4 ws = z, qs = z;
#pragma unroll
      for (int ks = 0; ks < 2; ++ks) { const bf16x8 bst = *(const bf16x8*)&ST[(n * 16 + fr) * LDT + ks * 32 + fq * 8]; ws = mfma16(cur.wa[ks], bst, ws); qs = mfma16(cur.qa[ks], bst, qs); }
      const float u[4] = {lo_bf(cur.ut[n].x), hi_bf(cur.ut[n].x), lo_bf(cur.ut[n].y), hi_bf(cur.ut[n].y)};
      float vn[4], vn2[4];
#pragma unroll
      for (int r = 0; r < 4; ++r) { vn[r] = u[r] - ws[r]; vn2[r] = vn[r] * __expf(cur.gl - cur.gr[r]); o1[n][r] = qs[r] * __expf(cur.gr[r]); }
      uint2 a, c; a.x = pack2(vn[0], vn[1]); a.y = pack2(vn[2], vn[3]); c.x = pack2(vn2[0], vn2[1]); c.y = pack2(vn2[2], vn2[3]);
      *(uint2*)&sVT[(n * 16 + fr) * LDT + wid * 16 + fq * 4] = a;
      *(uint2*)&sVT2[(n * 16 + fr) * LDT + wid * 16 + fq * 4] = c;
    }
#pragma unroll
    for (int ks = 0; ks < 2; ++ks)
#pragma unroll
      for (int e = 0; e < 8; ++e) sKT[(ks * 32 + fq * 8 + e) * LDT + wid * 16 + fr] = (bf16_t)cur.ka[ks][e];
    __syncthreads();
    const float egl = __expf(cur.gl);
#pragma unroll
    for (int n = 0; n < 4; ++n) {
      f32x4 av = o1[n], kv = z;
#pragma unroll
      for (int ks = 0; ks < 2; ++ks) {
        const bf16x8 aa = *(const bf16x8*)&sAt[(wid * 16 + fr) * LDT + ks * 32 + fq * 8];
        const bf16x8 ak = *(const bf16x8*)&sKT[(wid * 16 + fr) * LDT + ks * 32 + fq * 8];
        const bf16x8 b1 = *(const bf16x8*)&sVT[(n * 16 + fr) * LDT + ks * 32 + fq * 8];
        const bf16x8 b2 = *(const bf16x8*)&sVT2[(n * 16 + fr) * LDT + ks * 32 + fq * 8];
        av = mfma16(aa, b1, av); kv = mfma16(ak, b2, kv);
      }
#pragma unroll
      for (int r = 0; r < 4; ++r) { const int tau = wid * 16 + fq * 4 + r, row = cg * 64 + (dir ? 63 - tau : tau);
        P[(size_t)row * PN_ + ocol + n * 16 + fr] = f2bf(av[r]); S[n][r] = S[n][r] * egl + kv[r]; }
    }
    __syncthreads();
#pragma unroll
    for (int n = 0; n < 4; ++n) { uint2 o; o.x = pack2(S[n][0], S[n][1]); o.y = pack2(S[n][2], S[n][3]); *(uint2*)&ST[(n * 16 + fr) * LDT + wid * 16 + fq * 4] = o; }
    __syncthreads();
    __builtin_amdgcn_sched_barrier(0);
    cur = nxt;
  }
}

struct HgIn { bf16x8 qa[2], aa[2], ka[2]; uint4 v[2]; f32x4 de; };
DEV void hg_load(const Params& p, HgIn& in, int cg, int h, int dir, int tid) {
  const int lane = tid & 63, wid = tid >> 6, fr = lane & 15, fq = lane >> 4;
  const bf16_t* P = (const bf16_t*)(p.ws + OFF_P); const bf16_t* Y = (const bf16_t*)(p.ws + OFF_XY);
  const size_t base = ((size_t)(dir * 520 + cg) * 4 + h);
  const bf16_t* ATT = (const bf16_t*)(p.ws + OFF_HGATT) + base * 4096;
  const float* DE = (const float*)(p.ws + OFF_HGDE) + base * 64;
  const int tau = wid * 16 + fr, row = cg * 64 + (dir ? 63 - tau : tau);
#pragma unroll
  for (int ks = 0; ks < 2; ++ks) {
    in.qa[ks] = dir ? *(const bf16x8*)(Y + (size_t)row * 1024 + 768 + h * 64 + ks * 32 + fq * 8) : *(const bf16x8*)(P + (size_t)row * PN_ + C_HGQ + h * 64 + ks * 32 + fq * 8);
    in.aa[ks] = *(const bf16x8*)(ATT + tau * 64 + ks * 32 + fq * 8);
    in.ka[ks] = *(const bf16x8*)(P + (size_t)row * PN_ + (dir ? C_HGFB : C_HGFF) + h * 64 + ks * 32 + fq * 8);
  }
#pragma unroll
  for (int i = 0; i < 2; ++i) { const int t2 = (tid >> 3) + 32 * i, row2 = cg * 64 + (dir ? 63 - t2 : t2); in.v[i] = *(const uint4*)(P + (size_t)row2 * PN_ + C_HGI + h * 64 + (tid & 7) * 8); }
  in.de = *(const f32x4*)(DE + wid * 16 + fq * 4);
}
DEV void hg_stage(const HgIn& in, bf16_t* kt, bf16_t* vt, int tid) {
  const int lane = tid & 63, wid = tid >> 6, fr = lane & 15, fq = lane >> 4;
#pragma unroll
  for (int ks = 0; ks < 2; ++ks)
#pragma unroll
    for (int e = 0; e < 8; ++e) kt[(ks * 32 + fq * 8 + e) * LDT + wid * 16 + fr] = (bf16_t)in.ka[ks][e];
  vt_tr_store(vt, (tid & 7) * 8, (tid >> 3), in.v[0]); vt_tr_store(vt, (tid & 7) * 8, (tid >> 3) + 32, in.v[1]);
}
DEV void hg_scan_chain(const Params& p, int l, int chain, char* ldsc) {
  bf16_t* ST = (bf16_t*)ldsc; bf16_t* sVT = ST + 2 * 64 * LDT; bf16_t* sKT = sVT + 2 * 64 * LDT;
  const int tid = tid_opaque(), lane = tid & 63, wid = tid >> 6, fr = lane & 15, fq = lane >> 4;
  const int b = chain >> 3, h = (chain >> 1) & 3, dir = chain & 1;
  bf16_t* P = (bf16_t*)(p.ws + OFF_P); bf16_t* Y = (bf16_t*)(p.ws + OFF_XY);
  f32x4 S[4];
#pragma unroll
  for (int n = 0; n < 4; ++n) { S[n] = (f32x4){0.f, 0.f, 0.f, 0.f}; *(uint2*)&ST[(n * 16 + fr) * LDT + wid * 16 + fq * 4] = (uint2){0u, 0u}; }
  HgIn cur; hg_load(p, cur, chain_cg(b, dir, 0), h, dir, tid);
  hg_stage(cur, sKT, sVT, tid);
  __syncthreads();
  for (int step = 0; step < 260; ++step) {
    const int cg = chain_cg(b, dir, step), bufc = step & 1;
    HgIn nxt; hg_load(p, nxt, chain_cg(b, dir, step + 1 < 260 ? step + 1 : step), h, dir, tid);
    __builtin_amdgcn_sched_barrier(0);
    const bf16_t* st = ST + bufc * 64 * LDT; const bf16_t* vt = sVT + bufc * 64 * LDT; const bf16_t* kt = sKT + bufc * 64 * LDT;
    bf16_t* st2 = ST + (bufc ^ 1) * 64 * LDT;
    const f32x4 z = {0.f, 0.f, 0.f, 0.f};
#pragma unroll
    for (int n = 0; n < 4; ++n) {
      f32x4 o = z, kv = z;
#pragma unroll
      for (int ks = 0; ks < 2; ++ks) {
        const bf16x8 bs = *(const bf16x8*)&st[(n * 16 + fr) * LDT + ks * 32 + fq * 8];
        const bf16x8 bv = *(const bf16x8*)&vt[(n * 16 + fr) * LDT + ks * 32 + fq * 8];
        const bf16x8 ak = *(const bf16x8*)&kt[(wid * 16 + fr) * LDT + ks * 32 + fq * 8];
        o = mfma16(cur.qa[ks], bs, o); o = mfma16(cur.aa[ks], bv, o); kv = mfma16(ak, bv, kv);
      }
#pragma unroll
      for (int r = 0; r < 4; ++r) { const int tau = wid * 16 + fq * 4 + r, row = cg * 64 + (dir ? 63 - tau : tau);
        if (dir) Y[(size_t)row * 1024 + 768 + h * 64 + n * 16 + fr] = f2bf(o[r]); else P[(size_t)row * PN_ + C_HGQ + h * 64 + n * 16 + fr] = f2bf(o[r]);
        S[n][r] = S[n][r] * cur.de[r] + kv[r]; }
      uint2 ov; ov.x = pack2(S[n][0], S[n][1]); ov.y = pack2(S[n][2], S[n][3]);
      *(uint2*)&st2[(n * 16 + fr) * LDT + wid * 16 + fq * 4] = ov;
    }
    hg_stage(nxt, sKT + (bufc ^ 1) * 64 * LDT, sVT + (bufc ^ 1) * 64 * LDT, tid);
    __syncthreads();
    __builtin_amdgcn_sched_barrier(0);
    cur = nxt;
  }
}

DEV void mixer_phase(const Params& p, int l, char* lds) {
  __shared__ int s_item;
  unsigned* ctr = (unsigned*)(p.ws + OFF_CTRL) + l;
  const int n_scan = 32, n_df = 1920 + 256, n_na = 2048, n_ctx = (l == 0) ? 64 : 0;
  const int total = n_scan + n_df + n_na + n_ctx;
  for (;;) {
    if (tid_opaque() == 0) s_item = (int)atomicAdd(ctr, 1u);
    __syncthreads();
    const int it = s_item;
    __syncthreads();
    if (it >= total) break;
    const int lo = l;
    if (it < 16) { dn_scan_chain(p, lo, it, lds);
#if EXP_SCAN2
      __syncthreads(); dn_scan_chain(p, lo, it, lds);
#endif
    }
    else if (it < 32) hg_scan_chain(p, lo, it - 16, lds);
    else if (it < 32 + 1920) { const int a = it - 32; attn_item<0>(p, lo, 0, a >> 10, (a >> 8) & 3, a & 255, lds); }
    else if (it < 32 + n_df) { const int s = it - 32 - 1920, a = 1920 + (s >> 1); attn_item<0>(p, lo, 0, a >> 10, (a >> 8) & 3, a & 255, lds, s & 1, s); }
    else if (it < 32 + n_df + n_na) { const int a = it - 32 - n_df; attn_item<1>(p, lo, 0, a >> 10, (a >> 8) & 3, a & 255, lds); }
    else { const int a = it - 32 - n_df - n_na; const int md = a >> 5, bb = (a >> 4) & 1, hh = (a >> 2) & 3, qt = a & 3;
      if (md == 0) attn_item<0>(p, lo, 1, bb, hh, qt, lds); else attn_item<1>(p, lo, 1, bb, hh, qt, lds); }
  }
}

DEV void final_phase(const Params& p) {
  const int lane = tid_opaque() & 63, gw = bid_opaque() * 4 + (tid_opaque() >> 6), nw = gridDim.x * 4;
  for (int r = gw; r < LAT_; r += nw) {
    float4* xr = (float4*)(p.out + (size_t)r * 1024);
    float4 v[4]; float ss = 0.f;
#pragma unroll
    for (int i = 0; i < 4; ++i) { v[i] = xr[lane + 64 * i]; ss += v[i].x * v[i].x + v[i].y * v[i].y + v[i].z * v[i].z + v[i].w * v[i].w; }
#pragma unroll
    for (int o = 32; o > 0; o >>= 1) ss += __shfl_xor(ss, o);
    const float rs = rsqrtf(ss * (1.0f / 1024.0f) + EPS_);
#pragma unroll
    for (int i = 0; i < 4; ++i) { const float4 w4 = *(const float4*)(p.final_norm_w + (lane + 64 * i) * 4);
      float4 o4 = {v[i].x * rs * w4.x, v[i].y * rs * w4.y, v[i].z * rs * w4.z, v[i].w * rs * w4.w}; xr[lane + 64 * i] = o4; }
  }
}


#define XB_TMO      128
#define XB_XCNT(j)  (256  + 64 * (j))
#define XB_XSUB(j)  (1280 + 64 * (j))
#define XB_XGEN(j)  (2304 + 64 * (j))
#define XB_TOP      3328
#define XB_TOPGEN   3392
#define XB_SPIN_CAP (1u << 22)
#define LAS __attribute__((address_space(3)))
DEV unsigned xb_ld(unsigned* p)              { return __hip_atomic_load(p, __ATOMIC_RELAXED, __HIP_MEMORY_SCOPE_AGENT); }
DEV unsigned xb_add(unsigned* p, unsigned v) { return __hip_atomic_fetch_add(p, v, __ATOMIC_RELAXED, __HIP_MEMORY_SCOPE_AGENT); }
DEV unsigned xb_xcc_id() { return (unsigned)__builtin_amdgcn_s_getreg((3 << 11) | 20) & 0xFu; }
#define XB_SPIN(cond, bar) do { unsigned _sp = 0; while (cond) { __builtin_amdgcn_s_sleep(1); \
    if ((++_sp & 255u) == 0u) { if (xb_ld(&(bar)[XB_TMO])) break; if (_sp > XB_SPIN_CAP) { atomicAdd(&(bar)[XB_TMO], 1u); break; } } } } while (0)
struct XcdBarrier { unsigned* bar; unsigned x; volatile LAS unsigned* st; };
DEV XcdBarrier xcd_barrier_post(unsigned* bar, volatile LAS unsigned* st) {
  XcdBarrier b; b.bar = bar; b.x = xb_xcc_id(); b.st = st;
  if (threadIdx.x == 0) (void)xb_add(&bar[XB_XCNT(b.x)], 1u);
  return b;
}
DEV void xcd_barrier_complete(unsigned* bar, unsigned x, unsigned& nloc, unsigned& nx) {
  const unsigned G = gridDim.x * gridDim.y * gridDim.z;
  unsigned sum, cnt, mine, sp = 0u;
  for (;;) {
    sum = 0u; cnt = 0u; mine = 0u;
#pragma unroll
    for (unsigned j = 0; j < 16; ++j) { const unsigned c = xb_ld(&bar[XB_XCNT(j)]); sum += c; cnt += (c > 0u) ? 1u : 0u; mine = (j == x) ? c : mine; }
    if (sum == G) break;
    __builtin_amdgcn_s_sleep(1);
    if ((++sp & 255u) == 0u) { if (xb_ld(&bar[XB_TMO])) break; if (sp > XB_SPIN_CAP) { atomicAdd(&bar[XB_TMO], 1u); break; } }
  }
  nloc = mine > 0u ? mine : 1u; nx = cnt > 0u ? cnt : 1u;
}
DEV void xcd_barrier(const XcdBarrier& b) {
  asm volatile("s_waitcnt vmcnt(0)" ::: "memory");
  __syncthreads();
  if (threadIdx.x == 0) {
    unsigned* bar = b.bar;
    __builtin_amdgcn_s_waitcnt(0);
    unsigned nloc = b.st[0], nx = b.st[1];
    if (nloc == 0u) { xcd_barrier_complete(bar, b.x, nloc, nx); b.st[0] = nloc; b.st[1] = nx; }
    const unsigned old = xb_add(&bar[XB_XSUB(b.x)], 1u);
    const unsigned gen = old / nloc;
    if (old + 1u == (gen + 1u) * nloc) {
      __builtin_amdgcn_fence(__ATOMIC_RELEASE, "agent");
      asm volatile("s_waitcnt vmcnt(0)" ::: "memory");
      const unsigned og = xb_add(&bar[XB_TOP], 1u);
      const unsigned tg = og / nx;
      if (og + 1u == (tg + 1u) * nx) xb_add(&bar[XB_TOPGEN], 1u);
      else XB_SPIN(xb_ld(&bar[XB_TOPGEN]) == tg, bar);
      __builtin_amdgcn_fence(__ATOMIC_ACQUIRE, "agent");
      xb_add(&bar[XB_XGEN(b.x)], 1u);
      asm volatile("s_waitcnt vmcnt(0)" ::: "memory");
    } else {
      XB_SPIN(xb_ld(&bar[XB_XGEN(b.x)]) == gen, bar);
      __builtin_amdgcn_fence(__ATOMIC_ACQUIRE, "agent");
      asm volatile("s_waitcnt vmcnt(0)" ::: "memory");
    }
  }
  __syncthreads();
}

constexpr int LDS_BYTES = 76800;
__global__ void __launch_bounds__(256, 2) mega(Params p) {
  extern __shared__ __attribute__((aligned(16))) char lds[];
  cg::grid_group grid = cg::this_grid();
  __shared__ uint4 xb_words;
  if (threadIdx.x == 0) xb_words = make_uint4(0u, 0u, 0u, 0u);
  __syncthreads();
  const XcdBarrier xb = xcd_barrier_post((unsigned*)(p.ws + OFF_BAR), (volatile LAS unsigned*)&xb_words);
  phase0(p, lds);
  grid.sync();
  for (int l = 0; l < 2; ++l) {
    const char* wb = p.ws + OFF_WB + (size_t)l * WB_LAYER;
    const bf16_t* XY = (const bf16_t*)(p.ws + OFF_XY);
    norm_phase(p, l, 0);
    xcd_barrier(xb);
    { EpiArgs e{l, 0, false}; gemm_phase<0>(p, XY, (const bf16_t*)(wb + WB_IN), 1024, 260, 31, e, lds, l * 4 + 0); }
    xcd_barrier(xb);
#if EXP_IN2
    { EpiArgs e{l, 0, false}; gemm_phase<0>(p, XY, (const bf16_t*)(wb + WB_IN), 1024, 260, 31, e, lds, 8 + l); }
    xcd_barrier(xb);
#endif
    prep_phase(p, l, lds);
    xcd_barrier(xb);
    mixer_phase(p, l, lds);
    xcd_barrier(xb);
    post_phase(p, l);
    xcd_barrier(xb);
    { EpiArgs e{l, 2, l == 0}; gemm_phase<1>(p, XY, (const bf16_t*)(wb + WB_OUT), 1024, 260, 8, e, lds, l * 4 + 1); }
    xcd_barrier(xb);
    norm_phase(p, l, 1);
    xcd_barrier(xb);
    { EpiArgs e{l, 0, false}; gemm_phase<2>(p, XY, (const bf16_t*)(wb + WB_UP), 1024, 265, 44, e, lds, l * 4 + 2); }
    xcd_barrier(xb);
#if EXP_UP2
    { EpiArgs e{l, 0, false}; gemm_phase<2>(p, XY, (const bf16_t*)(wb + WB_UP), 1024, 265, 44, e, lds, l * 4 + 2); }
    xcd_barrier(xb);
#endif
    { EpiArgs e{l, 5, false}; gemm_phase<1>(p, (const bf16_t*)(p.ws + OFF_P), (const bf16_t*)(wb + WB_DOWN), 2816, 260, 8, e, lds, l * 4 + 3); }
    xcd_barrier(xb);
  }
  final_phase(p);
}

extern "C" void kernel_launch(void* const* d_in, const int* in_sizes, int n_in, void* d_out, int out_size, void* d_ws, size_t ws_size, hipStream_t stream) {
  static int grid_blocks = 0;
  if (!grid_blocks) {
    int dev = 0, cus = 0, per_cu = 0;
    hipGetDevice(&dev);
    hipDeviceGetAttribute(&cus, hipDeviceAttributeMultiprocessorCount, dev);
    hipFuncSetAttribute((const void*)mega, hipFuncAttributeMaxDynamicSharedMemorySize, LDS_BYTES);
    hipOccupancyMaxActiveBlocksPerMultiprocessor(&per_cu, mega, 256, LDS_BYTES);
    if (per_cu > 2) per_cu = 2;
    if (per_cu < 1) per_cu = 1;
    grid_blocks = cus * per_cu;
  }
  Params p{};
  const float** f = (const float**)&p;
  for (int i = 0; i < 23; ++i) f[i] = (const float*)d_in[i];
  p.out = (float*)d_out; p.ws = (char*)d_ws;
  p.lam_init[0] = (float)(0.8 - 0.6 * exp(-0.3 * 0.0)); p.lam_init[1] = (float)(0.8 - 0.6 * exp(-0.3 * 1.0));
  p.debug = 0; p.pad = 0;
  if (ws_size < WS_NEED) fprintf(stderr, "workspace too small: %zu < %zu\n", ws_size, (size_t)WS_NEED);
  (void)hipMemsetAsync((char*)d_ws + OFF_BAR, 0, 16384, stream);
  void* args[] = {&p};
  hipError_t e = hipLaunchCooperativeKernel((void*)mega, dim3(grid_blocks), dim3(256), args, LDS_BYTES, stream);
  if (e != hipSuccess) fprintf(stderr, "cooperative launch failed: %s (grid %d)\n", hipGetErrorString(e), grid_blocks);
}
```

```cpp
#include <hip/hip_runtime.h>
#include <hip/hip_cooperative_groups.h>
#include <cstdio>
#include <cstdint>
#include <cmath>
namespace cg = cooperative_groups;
#define EXP_UP2 0
#define EXP_IN2 0
#define EXP_SCAN2 0
#define EXP_DF2 0

typedef unsigned short bf16_t;
typedef short bf16x8 __attribute__((ext_vector_type(8)));
typedef float f32x4 __attribute__((ext_vector_type(4)));
#define DEV __device__ __forceinline__

constexpr int R_ = 33280, LAT_ = 32768, D_ = 1024, PN_ = 3968, PIN_ = 3856, DFF_ = 2816;
constexpr int C_DNQ = 0, C_DNK = 256, C_DNV = 512, C_DNG = 768, C_DNBA = 1024, C_NAQ = 1040, C_NAK = 1296, C_NAV = 1552,
              C_DFQ = 1808, C_DFK = 2064, C_DFV = 2320, C_HGQ = 2576, C_HGI = 2832, C_HGFF = 3088, C_HGFB = 3344, C_HGG = 3600;
constexpr int LDT = 72;
constexpr float EPS_ = 1e-6f;
constexpr float LOG2E = 1.4426950408889634f;

constexpr size_t OFF_CTRL = 0;
constexpr size_t OFF_MOD = 4096;
constexpr size_t OFF_HCTX = OFF_MOD + 2 * 3 * 6144 * 4;
constexpr size_t OFF_WB = OFF_HCTX + 512 * 1024 * 4;
constexpr size_t WB_IN = 0, WB_OUT = (size_t)PN_ * 1024 * 2, WB_UP = WB_OUT + 1024 * 1024 * 2, WB_DOWN = WB_UP + (size_t)5632 * 1024 * 2,
                 WB_LAYER = WB_DOWN + (size_t)1024 * 2816 * 2;
constexpr size_t OFF_XY = OFF_WB + 2 * WB_LAYER;
constexpr size_t OFF_P = OFF_XY + (size_t)R_ * 1024 * 2;
constexpr size_t OFF_DNK = OFF_P + (size_t)R_ * PN_ * 2;
constexpr size_t SZ_CH = (size_t)2 * 520 * 4 * 64 * 64 * 2;
constexpr size_t OFF_DNW = OFF_DNK + (size_t)R_ * 256 * 2;
constexpr size_t OFF_DNUT = OFF_DNW + SZ_CH;
constexpr size_t OFF_HGATT = OFF_DNUT + SZ_CH;
constexpr size_t OFF_DNG = OFF_HGATT + SZ_CH;
constexpr size_t OFF_HGDE = OFF_DNG + (size_t)2 * 520 * 4 * 64 * 4;
constexpr size_t OFF_BAR = OFF_HGDE + (size_t)2 * 520 * 4 * 64 * 4;
constexpr size_t OFF_VTG = OFF_BAR + 16384;
constexpr size_t WS_NEED = OFF_VTG + (size_t)8 * 64 * 16640 * 2;

struct Params {
  const float *x, *c, *ctx, *c_ctx, *w_ada, *b_ada, *norm1_w, *norm2_w, *w_in, *dn_conv_w, *dn_a_log, *dn_dt_bias, *dn_norm_w, *na_rpb,
      *df_lambda, *df_norm_w, *hg_lb_raw, *hg_norm_w, *w_out, *w_up, *ffn_conv_w, *w_down, *final_norm_w;
  float* out; char* ws;
  float lam_init[2]; int debug; int pad;
};

DEV float bf2f(bf16_t h) { return __uint_as_float((unsigned)h << 16); }
typedef __bf16 bf16x2_t __attribute__((ext_vector_type(2)));
typedef float f32x2_t __attribute__((ext_vector_type(2)));
DEV unsigned pack2(float lo, float hi) { f32x2_t f = {lo, hi}; bf16x2_t b = __builtin_convertvector(f, bf16x2_t); return __builtin_bit_cast(unsigned, b); }
DEV bf16_t f2bf(float f) { return (bf16_t)(pack2(f, f) & 0xffffu); }
DEV float lo_bf(unsigned u) { return __uint_as_float(u << 16); }
DEV float hi_bf(unsigned u) { return __uint_as_float(u & 0xffff0000u); }
DEV float sigmoidf_(float x) { return __builtin_amdgcn_rcpf(1.0f + __builtin_amdgcn_exp2f(-LOG2E * x)); }
DEV float siluf_(float x) { return x * __builtin_amdgcn_rcpf(1.0f + __builtin_amdgcn_exp2f(-LOG2E * x)); }
DEV f32x4 mfma16(bf16x8 a, bf16x8 b, f32x4 c) { return __builtin_amdgcn_mfma_f32_16x16x32_bf16(a, b, c, 0, 0, 0); }

DEV int tid_opaque() { int t = threadIdx.x; asm volatile("" : "+v"(t)); return t; }
DEV int bid_opaque() { int t = blockIdx.x; asm volatile("" : "+s"(t)); return t; }
DEV int grp_of(int r) { return r < LAT_ ? (r >> 14) : 2; }
DEV bool seq_first(int r) { return r < LAT_ ? ((r & 16383) == 0) : (((r - LAT_) & 255) == 0); }
DEV bool seq_last(int r) { return r < LAT_ ? ((r & 16383) == 16383) : (((r - LAT_) & 255) == 255); }

DEV void transpose_tile(const float* __restrict__ src, bf16_t* __restrict__ dst, int K, int N, int k0, int n0, int drow0, float* lds) {
  const int tx = tid_opaque() & 63, ty = tid_opaque() >> 6;
#pragma unroll 4
  for (int i = 0; i < 16; ++i) { const int k = ty + 4 * i; lds[k * 65 + tx] = (n0 + tx < N) ? src[(size_t)(k0 + k) * N + n0 + tx] : 0.f; }
  __syncthreads();
#pragma unroll 4
  for (int i = 0; i < 16; ++i) { const int n = ty + 4 * i; dst[(size_t)(drow0 + n) * K + k0 + tx] = f2bf(lds[tx * 65 + n]); }
  __syncthreads();
}

DEV void phase0(const Params& p, char* ldsc) {
  float* lds = (float*)ldsc;
  const int tid = tid_opaque();
  if (bid_opaque() == 0) ((unsigned*)(p.ws + OFF_CTRL))[tid] = 0u;
  constexpr int T_IN = 16 * 62, T_OUT = 256, T_UP = 16 * 88, T_DOWN = 44 * 16, T_L = T_IN + T_OUT + T_UP + T_DOWN;
  const int nitems = 2 * T_L + 192;
  for (int it = bid_opaque(); it < nitems; it += gridDim.x) {
    if (it < 2 * T_L) {
      const int l = it / T_L; int t = it % T_L;
      char* wb = p.ws + OFF_WB + (size_t)l * WB_LAYER;
      if (t < T_IN) { transpose_tile(p.w_in + (size_t)l * 1024 * PIN_, (bf16_t*)(wb + WB_IN), 1024, PIN_, (t % 16) * 64, (t / 16) * 64, (t / 16) * 64, lds); continue; }
      t -= T_IN;
      if (t < T_OUT) { transpose_tile(p.w_out + (size_t)l * 1024 * 1024, (bf16_t*)(wb + WB_OUT), 1024, 1024, (t % 16) * 64, (t / 16) * 64, (t / 16) * 64, lds); continue; }
      t -= T_OUT;
      if (t < T_UP) { const int nt = t / 16; const int drow = nt < 44 ? nt * 128 : (nt - 44) * 128 + 64;
        transpose_tile(p.w_up + (size_t)l * 1024 * 5632, (bf16_t*)(wb + WB_UP), 1024, 5632, (t % 16) * 64, nt * 64, drow, lds); continue; }
      t -= T_UP;
      transpose_tile(p.w_down + (size_t)l * 2816 * 1024, (bf16_t*)(wb + WB_DOWN), 2816, 1024, (t % 44) * 64, (t / 44) * 64, (t / 44) * 64, lds);
    } else {
      const int a = it - 2 * T_L, l = a / 96, cb = a % 96;
      float* sS = lds;
      float* sP = lds + 3072;
      for (int i = tid; i < 3072; i += 256) { const int g = i >> 10, k = i & 1023; const float v = g < 2 ? p.c[g * 1024 + k] : p.c_ctx[k]; sS[i] = siluf_(v); }
      __syncthreads();
      const int col = cb * 64 + (tid & 63), kq = tid >> 6;
      const float* w = p.w_ada + (size_t)l * 1024 * 6144 + col;
      float a0 = 0.f, a1 = 0.f, a2 = 0.f;
#pragma unroll 8
      for (int k = kq * 256; k < kq * 256 + 256; ++k) { const float wv = w[(size_t)k * 6144]; a0 += sS[k] * wv; a1 += sS[1024 + k] * wv; a2 += sS[2048 + k] * wv; }
      sP[(kq * 3 + 0) * 64 + (tid & 63)] = a0; sP[(kq * 3 + 1) * 64 + (tid & 63)] = a1; sP[(kq * 3 + 2) * 64 + (tid & 63)] = a2;
      __syncthreads();
      if (tid < 192) { const int g = tid >> 6, cc = tid & 63; const float s = sP[(0 * 3 + g) * 64 + cc] + sP[(1 * 3 + g) * 64 + cc] + sP[(2 * 3 + g) * 64 + cc] + sP[(3 * 3 + g) * 64 + cc];
        ((float*)(p.ws + OFF_MOD))[(l * 3 + g) * 6144 + cb * 64 + cc] = s + p.b_ada[l * 6144 + cb * 64 + cc]; }
      __syncthreads();
    }
  }
}

DEV const float* xrow_ptr(const Params& p, int r, bool from_input) {
  if (r < LAT_) return (from_input ? p.x : p.out) + (size_t)r * 1024;
  return (from_input ? p.ctx : (const float*)(p.ws + OFF_HCTX)) + (size_t)(r - LAT_) * 1024;
}
DEV void norm_phase(const Params& p, int l, int which) {
  const int lane = tid_opaque() & 63, gw = bid_opaque() * 4 + (tid_opaque() >> 6), nw = gridDim.x * 4;
  const float* nwt = (which == 0 ? p.norm1_w : p.norm2_w) + l * 1024;
  bf16_t* xn = (bf16_t*)(p.ws + OFF_XY);
  for (int r = gw; r < R_; r += nw) {
    const float4* xr = (const float4*)xrow_ptr(p, r, l == 0 && which == 0);
    const float* mod = (const float*)(p.ws + OFF_MOD) + (l * 3 + grp_of(r)) * 6144 + which * 3 * 1024;
    float4 v[4]; float ss = 0.f;
#pragma unroll
    for (int i = 0; i < 4; ++i) { v[i] = xr[lane + 64 * i]; ss += v[i].x * v[i].x + v[i].y * v[i].y + v[i].z * v[i].z + v[i].w * v[i].w; }
#pragma unroll
    for (int o = 32; o > 0; o >>= 1) ss += __shfl_xor(ss, o);
    const float rs = rsqrtf(ss * (1.0f / 1024.0f) + EPS_);
#pragma unroll
    for (int i = 0; i < 4; ++i) {
      const int c = (lane + 64 * i) * 4;
      const float4 w4 = *(const float4*)(nwt + c), sh = *(const float4*)(mod + c), sc = *(const float4*)(mod + 1024 + c);
      const float y0 = v[i].x * rs * w4.x * (1.f + sc.x) + sh.x, y1 = v[i].y * rs * w4.y * (1.f + sc.y) + sh.y;
      const float y2 = v[i].z * rs * w4.z * (1.f + sc.z) + sh.z, y3 = v[i].w * rs * w4.w * (1.f + sc.w) + sh.w;
      uint2 o; o.x = pack2(y0, y1); o.y = pack2(y2, y3);
      *(uint2*)(xn + (size_t)r * 1024 + c) = o;
    }
  }
}

struct EpiArgs { int l; int gi; bool first; };
template <int EPI>
DEV void gemm_tile(const Params& p, const bf16_t* __restrict__ A, const bf16_t* __restrict__ Bt, int K, int arow0, int brow0, int tn, const EpiArgs& e, char* ldsc) {
  bf16_t* As = (bf16_t*)ldsc;
  bf16_t* Bs = As + 2 * 128 * 64;
  const int tid = tid_opaque(), lane = tid & 63, wid = __builtin_amdgcn_readfirstlane(tid >> 6), fr = lane & 15, fq = lane >> 4, wm = wid >> 1, wn = wid & 1;
  const int lr = tid >> 3, lc = (((tid & 7) ^ (lr & 7)) * 8);
  size_t ao0, ao1, ao2, ao3;
  { int r0 = arow0 + lr, r1 = r0 + 32, r2 = r0 + 64, r3 = r0 + 96;
    r0 = r0 < 0 ? 0 : (r0 > R_ - 1 ? R_ - 1 : r0); r1 = r1 < 0 ? 0 : (r1 > R_ - 1 ? R_ - 1 : r1); r2 = r2 < 0 ? 0 : (r2 > R_ - 1 ? R_ - 1 : r2); r3 = r3 < 0 ? 0 : (r3 > R_ - 1 ? R_ - 1 : r3);
    ao0 = (size_t)r0 * K + lc; ao1 = (size_t)r1 * K + lc; ao2 = (size_t)r2 * K + lc; ao3 = (size_t)r3 * K + lc; }
  const bf16_t* bp0 = Bt + (size_t)(brow0 + lr) * K + lc;
  const size_t bstep = (size_t)32 * K;
  f32x4 acc[4][4];
#pragma unroll
  for (int a = 0; a < 4; ++a)
#pragma unroll
    for (int b = 0; b < 4; ++b) acc[a][b] = (f32x4){0.f, 0.f, 0.f, 0.f};
  const int nk = K >> 6;
  char* ldsA = (char*)As + wid * 1024; char* ldsB = (char*)Bs + wid * 1024;
#define GEMM_GLDS(kt_, buf_) do { const int ko_ = (kt_) * 64; char* la_ = ldsA + (buf_) * 16384; char* lb_ = ldsB + (buf_) * 16384; \
    __builtin_amdgcn_global_load_lds((const unsigned*)(A + ao0 + ko_), (unsigned*)(la_), 16, 0, 0); \
    __builtin_amdgcn_global_load_lds((const unsigned*)(A + ao1 + ko_), (unsigned*)(la_ + 4096), 16, 0, 0); \
    __builtin_amdgcn_global_load_lds((const unsigned*)(A + ao2 + ko_), (unsigned*)(la_ + 8192), 16, 0, 0); \
    __builtin_amdgcn_global_load_lds((const unsigned*)(A + ao3 + ko_), (unsigned*)(la_ + 12288), 16, 0, 0); \
    __builtin_amdgcn_global_load_lds((const unsigned*)(bp0 + ko_), (unsigned*)(lb_), 16, 0, 0); \
    __builtin_amdgcn_global_load_lds((const unsigned*)(bp0 + bstep + ko_), (unsigned*)(lb_ + 4096), 16, 0, 0); \
    __builtin_amdgcn_global_load_lds((const unsigned*)(bp0 + 2 * bstep + ko_), (unsigned*)(lb_ + 8192), 16, 0, 0); \
    __builtin_amdgcn_global_load_lds((const unsigned*)(bp0 + 3 * bstep + ko_), (unsigned*)(lb_ + 12288), 16, 0, 0); } while (0)
  GEMM_GLDS(0, 0);
  for (int kt = 0; kt < nk; ++kt) {
   {
    const int buf = kt & 1;
    asm volatile("s_waitcnt vmcnt(0)" ::: "memory");
    __syncthreads();
    if (kt + 1 < nk) GEMM_GLDS(kt + 1, buf ^ 1);
    __builtin_amdgcn_sched_barrier(0);
    const bf16_t* as = As + buf * 128 * 64; const bf16_t* bs = Bs + buf * 128 * 64;
#pragma unroll
    for (int ks = 0; ks < 2; ++ks) {
      bf16x8 af[4], bfr[4];
#pragma unroll
      for (int i = 0; i < 4; ++i) { af[i] = *(const bf16x8*)&as[(wm * 64 + i * 16 + fr) * 64 + (((ks * 4 + fq) ^ (fr & 7)) * 8)]; bfr[i] = *(const bf16x8*)&bs[(wn * 64 + i * 16 + fr) * 64 + (((ks * 4 + fq) ^ (fr & 7)) * 8)]; }
#pragma unroll
      for (int ni = 0; ni < 4; ++ni)
#pragma unroll
        for (int mi = 0; mi < 4; ++mi) acc[ni][mi] = mfma16(bfr[ni], af[mi], acc[ni][mi]);
    }
   }
  }
  __syncthreads();
  if (EPI == 0) {
    bf16_t* P = (bf16_t*)(p.ws + OFF_P);
#pragma unroll
    for (int mi = 0; mi < 4; ++mi) { const size_t row = (size_t)(arow0 + wm * 64 + mi * 16 + fr);
#pragma unroll
      for (int ni = 0; ni < 4; ++ni) { uint2 o; o.x = pack2(acc[ni][mi][0], acc[ni][mi][1]); o.y = pack2(acc[ni][mi][2], acc[ni][mi][3]);
        *(uint2*)(P + row * PN_ + brow0 + wn * 64 + ni * 16 + fq * 4) = o; } }
  } else if (EPI == 1) {
#pragma unroll
    for (int mi = 0; mi < 4; ++mi) { const int row = arow0 + wm * 64 + mi * 16 + fr;
      const float* xin = xrow_ptr(p, row, e.first);
      float* xout = row < LAT_ ? p.out + (size_t)row * 1024 : (float*)(p.ws + OFF_HCTX) + (size_t)(row - LAT_) * 1024;
      const float* gate = (const float*)(p.ws + OFF_MOD) + (e.l * 3 + grp_of(row)) * 6144 + e.gi * 1024;
#pragma unroll
      for (int ni = 0; ni < 4; ++ni) { const int col = brow0 + wn * 64 + ni * 16 + fq * 4;
        const float4 xi = *(const float4*)(xin + col), g = *(const float4*)(gate + col);
        float4 o; o.x = xi.x + g.x * acc[ni][mi][0]; o.y = xi.y + g.y * acc[ni][mi][1]; o.z = xi.z + g.z * acc[ni][mi][2]; o.w = xi.w + g.w * acc[ni][mi][3];
        *(float4*)(xout + col) = o; } }
  } else {
    constexpr int GS = 68;
    float* G = (float*)ldsc;
    float* Vb = (float*)(ldsc + 128 * GS * 4);
    if (wn == 0) {
#pragma unroll
      for (int mi = 0; mi < 4; ++mi)
#pragma unroll
        for (int ni = 0; ni < 4; ++ni) *(f32x4*)&G[(wm * 64 + mi * 16 + fr) * GS + ni * 16 + fq * 4] = acc[ni][mi];
    } else {
#pragma unroll
      for (int mi = 2; mi < 4; ++mi)
#pragma unroll
        for (int ni = 0; ni < 4; ++ni) *(f32x4*)&Vb[(wm * 64 + mi * 16 + fr) * GS + ni * 16 + fq * 4] = acc[ni][mi];
    }
    __syncthreads();
    {
      bf16_t* H = (bf16_t*)(p.ws + OFF_P);
      const float* cw = p.ffn_conv_w + (size_t)e.l * 3 * DFF_ + tn * 64;
#pragma unroll
      for (int mi2 = 0; mi2 < 2; ++mi2) { const int mi = wn == 1 ? mi2 : mi2 + 2; const int m = wm * 64 + mi * 16 + fr, gr = arow0 + m;
        const bool valid = (m >= 1) && (m <= 126) && (gr >= 0) && (gr < R_);
        if (valid) { const bool hasp = !seq_first(gr), hasn = !seq_last(gr);
#pragma unroll
          for (int ni = 0; ni < 4; ++ni) { const int c0 = ni * 16 + fq * 4;
            const f32x4 w0 = *(const f32x4*)(cw + c0), w1 = *(const f32x4*)(cw + DFF_ + c0), w2 = *(const f32x4*)(cw + 2 * DFF_ + c0);
            const f32x4 z4 = {0.f, 0.f, 0.f, 0.f};
            const f32x4 g1 = *(const f32x4*)&G[m * GS + c0];
            const f32x4 g0 = hasp ? *(const f32x4*)&G[(m - 1) * GS + c0] : z4;
            const f32x4 g2 = hasn ? *(const f32x4*)&G[(m + 1) * GS + c0] : z4;
            const f32x4 cv = w1 * g1 + w0 * g0 + w2 * g2;
            f32x4 vv; if (wn == 1) vv = acc[ni][mi2]; else vv = *(const f32x4*)&Vb[m * GS + c0];
            uint2 o; o.x = pack2(siluf_(cv[0]) * vv[0], siluf_(cv[1]) * vv[1]); o.y = pack2(siluf_(cv[2]) * vv[2], siluf_(cv[3]) * vv[3]);
            *(uint2*)(H + (size_t)gr * DFF_ + tn * 64 + c0) = o; } } }
    }
    __syncthreads();
  }
}

DEV unsigned xcc_id() { return (unsigned)__builtin_amdgcn_s_getreg((3 << 11) | 20) & 7u; }
template <int EPI>
DEV void gemm_phase(const Params& p, const bf16_t* A, const bf16_t* Bt, int K, int ntm, int ntn, const EpiArgs& e, char* lds, int gidx) {
  __shared__ int s_q;
  unsigned* ctr = (unsigned*)(p.ws + OFF_CTRL) + 8 + gidx * 8;
  const int x0 = (int)xcc_id(), nig = 8 * ntn;
  for (int xo = 0; xo < 8; ++xo) {
    const int xcd = (x0 + xo) & 7, cnt = (ntm - xcd + 7) >> 3, total = cnt * ntn;
    for (;;) {
      if (tid_opaque() == 0) s_q = (int)atomicAdd(ctr + xcd, 1u);
      __syncthreads();
      const int q = s_q;
      __syncthreads();
      if (q >= total) break;
      const int grp = q / nig, rem = q - grp * nig, fm = grp * 8, gsz = (cnt - fm) < 8 ? (cnt - fm) : 8;
      const int tm = xcd + 8 * (fm + rem % gsz), tn = rem / gsz;
      const int arow0 = (EPI == 2) ? tm * 126 - 1 : tm * 128;
      gemm_tile<EPI>(p, A, Bt, K, arow0, tn * 128, tn, e, lds);
    }
  }
}

DEV float wave_incl_scan(float v, int lane) {
#pragma unroll
  for (int o = 1; o < 64; o <<= 1) { const float t = __shfl_up(v, o); if (lane >= o) v += t; }
  return v;
}
DEV void dn_prep_item(const Params& p, int l, int cg, int h, char* ldsc) {
  bf16_t* sIn = (bf16_t*)ldsc;
  float* sKK = (float*)ldsc;
  float* sQ = (float*)(ldsc + 25344);
  float* sK = (float*)(ldsc + 41984);
  float* sV = (float*)(ldsc + 58624);
  float* sBeta = (float*)(ldsc + 75264);
  float* sG = sBeta + 128;
  const int tid = tid_opaque(), lane = tid & 63, wid = tid >> 6;
  const bf16_t* P = (const bf16_t*)(p.ws + OFF_P);
  const int row0 = cg * 64;
  const bool hasp = !seq_first(row0), hasn = !seq_last(row0 + 63);
  for (int c = tid; c < 66 * 24; c += 256) {
    const int j = c / 24, cc = c % 24, part = cc >> 3, off = (cc & 7) * 8;
    uint4 v = {0u, 0u, 0u, 0u};
    const bool ok = (j == 0) ? hasp : (j == 65 ? hasn : true);
    if (ok) v = *(const uint4*)(P + (size_t)(row0 - 1 + j) * PN_ + part * 256 + h * 64 + off);
    *(uint4*)&sIn[j * 192 + part * 64 + off] = v;
  }
  __syncthreads();
  {
    const float* cw = p.dn_conv_w + (size_t)l * 3 * 768;
    for (int idx = tid; idx < 64 * 192; idx += 256) {
      const int t = idx / 192, ch = idx % 192, part = ch >> 6, d = ch & 63, wc = part * 256 + h * 64 + d;
      const float v = cw[wc] * bf2f(sIn[t * 192 + ch]) + cw[768 + wc] * bf2f(sIn[(t + 1) * 192 + ch]) + cw[1536 + wc] * bf2f(sIn[(t + 2) * 192 + ch]);
      float* dst = part == 0 ? sQ : (part == 1 ? sK : sV);
      dst[t * 65 + d] = siluf_(v);
    }
  }
  __syncthreads();
  {
    bf16_t* Y = (bf16_t*)(p.ws + OFF_XY); bf16_t* DK = (bf16_t*)(p.ws + OFF_DNK);
    for (int i = 0; i < 16; ++i) {
      const int t = wid * 16 + i;
      float q = sQ[t * 65 + lane], k = sK[t * 65 + lane];
      float sq = q * q, sk = k * k;
#pragma unroll
      for (int o = 32; o > 0; o >>= 1) { sq += __shfl_xor(sq, o); sk += __shfl_xor(sk, o); }
      q *= rsqrtf(sq + EPS_); k *= rsqrtf(sk + EPS_);
      sK[t * 65 + lane] = k;
      Y[(size_t)(row0 + t) * 1024 + h * 64 + lane] = f2bf(q * 0.125f);
      DK[(size_t)(row0 + t) * 256 + h * 64 + lane] = f2bf(k);
    }
    if (wid < 2) {
      const int dir = wid, t = dir ? 63 - lane : lane;
      const bf16_t* ba = P + (size_t)(row0 + t) * PN_ + C_DNBA;
      const float beta = sigmoidf_(bf2f(ba[dir * 4 + h]));
      const float xr = bf2f(ba[(2 + dir) * 4 + h]) + p.dn_dt_bias[l * 8 + dir * 4 + h];
      const float sp = fmaxf(xr, 0.f) + log1pf(__expf(-fabsf(xr)));
      const float la = -__expf(p.dn_a_log[l * 8 + dir * 4 + h]) * sp;
      const float g = wave_incl_scan(la, lane);
      sBeta[dir * 64 + lane] = beta; sG[dir * 64 + lane] = g;
      ((float*)(p.ws + OFF_DNG))[((size_t)(dir * 520 + cg) * 4 + h) * 64 + lane] = g;
    }
  }
  __syncthreads();
  const int dir = wid >> 1, role = wid & 1;
  float x[64];
  {
    const int t_l = dir ? 63 - lane : lane;
    const float bsc = sBeta[dir * 64 + lane] * (role == 0 ? __expf(sG[dir * 64 + lane]) : 1.f);
    const float* srcm = role == 0 ? sK : sV;
#pragma unroll
    for (int c = 0; c < 64; ++c) x[c] = srcm[t_l * 65 + c] * bsc;
  }
  {
    const int ti = tid >> 4, si = tid & 15;
    float a[4][4];
#pragma unroll
    for (int i = 0; i < 4; ++i)
#pragma unroll
      for (int j = 0; j < 4; ++j) a[i][j] = 0.f;
#pragma unroll 2
    for (int d = 0; d < 64; ++d) {
      float kt[4], ks[4];
#pragma unroll
      for (int i = 0; i < 4; ++i) { kt[i] = sK[(ti * 4 + i) * 65 + d]; ks[i] = sK[(si * 4 + i) * 65 + d]; }
#pragma unroll
      for (int i = 0; i < 4; ++i)
#pragma unroll
        for (int j = 0; j < 4; ++j) a[i][j] += kt[i] * ks[j];
    }
#pragma unroll
    for (int i = 0; i < 4; ++i)
#pragma unroll
      for (int j = 0; j < 4; ++j) sKK[(ti * 4 + i) * 65 + si * 4 + j] = a[i][j];
  }
  __syncthreads();
  {
    float* sA0 = sQ; float* sA1 = sK;
    for (int idx = tid; idx < 2 * 4096; idx += 256) {
      const int dd = idx >> 12, i = (idx >> 6) & 63, j = idx & 63;
      const int ti = dd ? 63 - i : i, tj = dd ? 63 - j : j;
      float v = 0.f;
      if (j < i) v = sBeta[dd * 64 + i] * sKK[ti * 65 + tj] * __expf(sG[dd * 64 + i] - sG[dd * 64 + j]);
      (dd ? sA1 : sA0)[i * 65 + j] = v;
    }
  }
  __syncthreads();
  {
    const float* sA = dir ? sK : sQ;
#pragma unroll 1
    for (int j = 0; j < 63; ++j) {
      float a = sA[lane * 65 + j]; a = lane > j ? a : 0.f;
#pragma unroll
      for (int c = 0; c < 64; ++c) { const float xj = __int_as_float(__builtin_amdgcn_readlane(__float_as_int(x[c]), j)); x[c] -= a * xj; }
    }
    const size_t base = ((size_t)(dir * 520 + cg) * 4 + h) * 4096;
    if (role == 0) {
      bf16_t* W = (bf16_t*)(p.ws + OFF_DNW) + base + lane * 64;
#pragma unroll
      for (int i = 0; i < 8; ++i) { uint4 o; o.x = pack2(x[i * 8], x[i * 8 + 1]); o.y = pack2(x[i * 8 + 2], x[i * 8 + 3]); o.z = pack2(x[i * 8 + 4], x[i * 8 + 5]); o.w = pack2(x[i * 8 + 6], x[i * 8 + 7]);
        *(uint4*)(W + i * 8) = o; }
    } else {
      bf16_t* UT = (bf16_t*)(p.ws + OFF_DNUT) + base;
#pragma unroll
      for (int c = 0; c < 64; ++c) UT[c * 64 + lane] = f2bf(x[c]);
    }
  }
  __syncthreads();
}

DEV void hg_prep_item(const Params& p, int l, int cg, int h, char* ldsc) {
  float* sQ = (float*)ldsc;
  float* sK = (float*)(ldsc + 16640);
  float* sC = (float*)(ldsc + 33280);
  float* sT = (float*)(ldsc + 49920);
  const int tid = tid_opaque(), d = tid & 63, part = tid >> 6;
  bf16_t* P = (bf16_t*)(p.ws + OFF_P); bf16_t* Y = (bf16_t*)(p.ws + OFF_XY);
  const int row0 = cg * 64;
#pragma unroll 4
  for (int i = 0; i < 16; ++i) { const int t = part * 16 + i; sQ[t * 65 + d] = 0.125f * bf2f(P[(size_t)(row0 + t) * PN_ + C_HGQ + h * 64 + d]); }
  for (int dir = 0; dir < 2; ++dir) {
    float lbv = 0.f;
    if (l == 1) { const float r0 = p.hg_lb_raw[dir * 256 + h * 64 + d], r1 = p.hg_lb_raw[512 + dir * 256 + h * 64 + d]; lbv = 1.0f / (1.0f + __expf(r0 - r1)); }
    const int fcol = (dir ? C_HGFB : C_HGFF) + h * 64 + d;
    float kk[16], cc[16]; float run = 0.f;
#pragma unroll
    for (int i = 0; i < 16; ++i) {
      const int tau = part * 16 + i, t = dir ? 63 - tau : tau;
      const float raw = bf2f(P[(size_t)(row0 + t) * PN_ + fcol]);
      const float k = (1.f - lbv) * sigmoidf_(-raw);
      kk[i] = k; run += log1pf(-k); cc[i] = run;
    }
    sT[part * 64 + d] = run;
    __syncthreads();
    float offs = 0.f;
    for (int q = 0; q < part; ++q) offs += sT[q * 64 + d];
    const float clast = sT[d] + sT[64 + d] + sT[128 + d] + sT[192 + d];
#pragma unroll
    for (int i = 0; i < 16; ++i) {
      const int tau = part * 16 + i, t = dir ? 63 - tau : tau;
      const float c = cc[i] + offs;
      sK[tau * 65 + d] = kk[i]; sC[tau * 65 + d] = c * LOG2E;
      const float qb = sQ[t * 65 + d] * __expf(c), ke = kk[i] * __expf(clast - c);
      if (dir == 0) P[(size_t)(row0 + t) * PN_ + C_HGQ + h * 64 + d] = f2bf(qb); else Y[(size_t)(row0 + t) * 1024 + 768 + h * 64 + d] = f2bf(qb);
      P[(size_t)(row0 + t) * PN_ + fcol] = f2bf(ke);
    }
    if (part == 0) ((float*)(p.ws + OFF_HGDE))[((size_t)(dir * 520 + cg) * 4 + h) * 64 + d] = __expf(clast);
    __syncthreads();
    {
      const int ti = tid >> 4, si = tid & 15;
      float a[4][4];
#pragma unroll
      for (int i = 0; i < 4; ++i)
#pragma unroll
        for (int j = 0; j < 4; ++j) a[i][j] = 0.f;
      if (si < ti) {
#pragma unroll 2
        for (int dd = 0; dd < 64; ++dd) {
          float qa[4], ca[4], kb[4], cb[4];
#pragma unroll
          for (int i = 0; i < 4; ++i) { const int tau = ti * 4 + i, t = dir ? 63 - tau : tau; qa[i] = sQ[t * 65 + dd]; ca[i] = sC[tau * 65 + dd]; kb[i] = sK[(si * 4 + i) * 65 + dd]; cb[i] = sC[(si * 4 + i) * 65 + dd]; }
          const float cr = ca[0];
          float qe[4], ke[4];
          qe[0] = qa[0];
#pragma unroll
          for (int i = 1; i < 4; ++i) qe[i] = qa[i] * __builtin_amdgcn_exp2f(ca[i] - cr);
#pragma unroll
          for (int j = 0; j < 4; ++j) ke[j] = kb[j] * __builtin_amdgcn_exp2f(cr - cb[j]);
#pragma unroll
          for (int i = 0; i < 4; ++i)
#pragma unroll
            for (int j = 0; j < 4; ++j) a[i][j] += qe[i] * ke[j];
        }
      }
      bf16_t* ATT = (bf16_t*)(p.ws + OFF_HGATT) + ((size_t)(dir * 520 + cg) * 4 + h) * 4096;
      if (si != ti) {
#pragma unroll
        for (int i = 0; i < 4; ++i) { const int tau = ti * 4 + i;
          uint2 o; o.x = pack2(a[i][0], a[i][1]); o.y = pack2(a[i][2], a[i][3]);
          *(uint2*)(ATT + tau * 64 + si * 4) = o; }
      }
      {
        const int dtile = tid >> 4, i = (tid >> 2) & 3, j = tid & 3, tau = dtile * 4 + i, sg = dtile * 4 + j, t = dir ? 63 - tau : tau;
        float s = 0.f;
        if (sg <= tau) {
#pragma unroll 4
          for (int dd = 0; dd < 64; ++dd) s += sQ[t * 65 + dd] * sK[sg * 65 + dd] * __builtin_amdgcn_exp2f(fminf(sC[tau * 65 + dd] - sC[sg * 65 + dd], 0.f));
        }
        ATT[tau * 64 + sg] = f2bf(s);
      }
    }
    __syncthreads();
  }
}

DEV void rope_rows(const Params& p, int rb) {
  bf16_t* P = (bf16_t*)(p.ws + OFF_P);
  const int tid = tid_opaque(), r = rb * 16 + (tid >> 4), v = tid & 15;
  const int tpos = r & 16383, grow = tpos >> 6, gcol = tpos & 63;
  bf16_t* ptr = P + (size_t)r * PN_ + (v < 8 ? C_DFQ : C_DFK) + (v & 7) * 32;
  uint4 u[4];
#pragma unroll
  for (int i = 0; i < 4; ++i) u[i] = *(const uint4*)(ptr + i * 8);
  float xv[32];
#pragma unroll
  for (int i = 0; i < 4; ++i) { xv[i * 8 + 0] = lo_bf(u[i].x); xv[i * 8 + 1] = hi_bf(u[i].x); xv[i * 8 + 2] = lo_bf(u[i].y); xv[i * 8 + 3] = hi_bf(u[i].y);
    xv[i * 8 + 4] = lo_bf(u[i].z); xv[i * 8 + 5] = hi_bf(u[i].z); xv[i * 8 + 6] = lo_bf(u[i].w); xv[i * 8 + 7] = hi_bf(u[i].w); }
  const float inv[8] = {1.0f, 0.31622776601683794f, 0.1f, 0.031622776601683794f, 0.01f, 0.0031622776601683794f, 0.001f, 0.00031622776601683794f};
  float yv[32];
#pragma unroll
  for (int i = 0; i < 8; ++i) {
    float ar = (float)grow * inv[i] * 0.15915494309189535f, ac = (float)gcol * inv[i] * 0.15915494309189535f;
    ar -= floorf(ar); ac -= floorf(ac);
    const float cr = __builtin_amdgcn_cosf(ar), sr = __builtin_amdgcn_sinf(ar), cc = __builtin_amdgcn_cosf(ac), sc = __builtin_amdgcn_sinf(ac);
    yv[i] = xv[i] * cr - xv[i + 8] * sr; yv[i + 8] = xv[i + 8] * cr + xv[i] * sr;
    yv[16 + i] = xv[16 + i] * cc - xv[24 + i] * sc; yv[24 + i] = xv[24 + i] * cc + xv[16 + i] * sc;
  }
#pragma unroll
  for (int i = 0; i < 4; ++i) { uint4 o; o.x = pack2(yv[i * 8], yv[i * 8 + 1]); o.y = pack2(yv[i * 8 + 2], yv[i * 8 + 3]); o.z = pack2(yv[i * 8 + 4], yv[i * 8 + 5]); o.w = pack2(yv[i * 8 + 6], yv[i * 8 + 7]);
    *(uint4*)(ptr + i * 8) = o; }
}

DEV void vt_prep_item(const Params& p, int bh, int t, char* ldsc);
DEV void prep_phase(const Params& p, int l, char* lds) {
  __shared__ int s_pq;
  unsigned* ctr = (unsigned*)(p.ws + OFF_CTRL) + 4 + l;
  const int nitems = 4160 + 2048 + 2080;
  for (;;) {
    if (tid_opaque() == 0) s_pq = (int)atomicAdd(ctr, 1u);
    __syncthreads();
    const int it = s_pq;
    __syncthreads();
    if (it >= nitems) break;
    const int lo = l;
    if (it < 2080) dn_prep_item(p, lo, it >> 2, it & 3, lds);
    else if (it < 4160) hg_prep_item(p, lo, (it - 2080) >> 2, (it - 2080) & 3, lds);
    else if (it < 6208) rope_rows(p, it - 4160);
    else vt_prep_item(p, (it - 6208) / 260, (it - 6208) % 260, lds);
  }
}

DEV void post_phase(const Params& p, int l) {
  const int lane = tid_opaque() & 63, gw = bid_opaque() * 4 + (tid_opaque() >> 6), nw = gridDim.x * 4;
  bf16_t* P = (bf16_t*)(p.ws + OFF_P); bf16_t* Y = (bf16_t*)(p.ws + OFF_XY);
  for (int it = gw; it < 2 * R_; it += nw) {
    const int r = it >> 1, mix = it & 1;
    const int c = lane * 4;
    uint2 uf, ub, ug;
    if (mix == 0) { uf = *(const uint2*)(P + (size_t)r * PN_ + C_DNQ + c); ub = *(const uint2*)(P + (size_t)r * PN_ + C_DNK + c); ug = *(const uint2*)(P + (size_t)r * PN_ + C_DNG + c); }
    else { uf = *(const uint2*)(P + (size_t)r * PN_ + C_HGQ + c); ub = *(const uint2*)(Y + (size_t)r * 1024 + 768 + c); ug = *(const uint2*)(P + (size_t)r * PN_ + C_HGG + c); }
    float o[4] = {lo_bf(uf.x) + lo_bf(ub.x), hi_bf(uf.x) + hi_bf(ub.x), lo_bf(uf.y) + lo_bf(ub.y), hi_bf(uf.y) + hi_bf(ub.y)};
    const float g[4] = {lo_bf(ug.x), hi_bf(ug.x), lo_bf(ug.y), hi_bf(ug.y)};
    float ss = o[0] * o[0] + o[1] * o[1] + o[2] * o[2] + o[3] * o[3];
#pragma unroll
    for (int s = 8; s > 0; s >>= 1) ss += __shfl_xor(ss, s);
    const float rs = rsqrtf(ss * (1.0f / 64.0f) + EPS_);
    const float* nw_ = (mix == 0 ? p.dn_norm_w : p.hg_norm_w) + l * 64 + (c & 63);
    float y[4];
#pragma unroll
    for (int i = 0; i < 4; ++i) y[i] = o[i] * rs * nw_[i] * siluf_(g[i]);
    uint2 ov; ov.x = pack2(y[0], y[1]); ov.y = pack2(y[2], y[3]);
    *(uint2*)(Y + (size_t)r * 1024 + (mix == 0 ? 0 : 768) + c) = ov;
  }
}

DEV bf16x8 pack8(const f32x4& a, const f32x4& b) {
  union { bf16x8 v; unsigned u[4]; } r;
  r.u[0] = pack2(a[0], a[1]); r.u[1] = pack2(a[2], a[3]); r.u[2] = pack2(b[0], b[1]); r.u[3] = pack2(b[2], b[3]);
  return r.v;
}
DEV void vt_tr_store(bf16_t* vt, int off, int key, const uint4& v) {
  vt[(off + 0) * LDT + key] = (bf16_t)(v.x & 0xffffu); vt[(off + 1) * LDT + key] = (bf16_t)(v.x >> 16);
  vt[(off + 2) * LDT + key] = (bf16_t)(v.y & 0xffffu); vt[(off + 3) * LDT + key] = (bf16_t)(v.y >> 16);
  vt[(off + 4) * LDT + key] = (bf16_t)(v.z & 0xffffu); vt[(off + 5) * LDT + key] = (bf16_t)(v.z >> 16);
  vt[(off + 6) * LDT + key] = (bf16_t)(v.w & 0xffffu); vt[(off + 7) * LDT + key] = (bf16_t)(v.w >> 16);
}
DEV void vt_prep_item(const Params& p, int bh, int t, char* ldsc) {
  bf16_t* sT = (bf16_t*)ldsc;
  const int tid = tid_opaque(), b = bh >> 2, h = bh & 3;
  const bf16_t* P = (const bf16_t*)(p.ws + OFF_P);
  const int trow = t < 4 ? LAT_ + b * 256 + t * 64 : b * 16384 + (t - 4) * 64;
  const int lkey = tid >> 3, loff = (tid & 7) * 8;
  const int lkp = lkey < 16 ? ((lkey >> 2) * 8 + (lkey & 3)) : (((lkey - 16) >> 2) * 8 + 4 + (lkey & 3));
  const uint4 v0 = *(const uint4*)(P + (size_t)(trow + lkey) * PN_ + C_DFV + h * 64 + loff);
  const uint4 v1 = *(const uint4*)(P + (size_t)(trow + lkey + 32) * PN_ + C_DFV + h * 64 + loff);
  vt_tr_store(sT, loff, lkp, v0); vt_tr_store(sT, loff, lkp + 32, v1);
  __syncthreads();
  bf16_t* dst = (bf16_t*)(p.ws + OFF_VTG) + ((size_t)bh * 64) * 16640 + (size_t)t * 64;
#pragma unroll
  for (int i = 0; i < 2; ++i) { const int dv = (tid >> 3) + 32 * i; *(uint4*)(dst + (size_t)dv * 16640 + loff) = *(const uint4*)&sT[dv * LDT + loff]; }
  __syncthreads();
}

template <int MODE>
DEV void attn_item(const Params& p, int l, int kind, int b, int h, int qt, char* ldsc) {
  bf16_t* Ks = (bf16_t*)ldsc;
  bf16_t* VT = Ks + 2 * 64 * LDT;
  float* sRpb = (float*)(ldsc + 4 * 64 * LDT * 2);
  const int tid = tid_opaque(), lane = tid & 63, wid = tid >> 6, fr = lane & 15, fq = lane >> 4;
  const bf16_t* P = (const bf16_t*)(p.ws + OFF_P);
  bf16_t* Y = (bf16_t*)(p.ws + OFF_XY);
  const int qcol = (MODE == 0 ? C_DFQ : C_NAQ) + h * 64, kcol = (MODE == 0 ? C_DFK : C_NAK) + h * 64, vcol = (MODE == 0 ? C_DFV : C_NAV) + h * 64;
  const int qrow0 = kind == 0 ? b * 16384 + qt * 64 : LAT_ + b * 256 + qt * 64;
  int nprim = 0, prim_row0 = 0, r_start = 0;
  if (kind == 0) { if (MODE == 0) { nprim = 256; prim_row0 = b * 16384; } else { r_start = qt - 4; r_start = r_start < 0 ? 0 : (r_start > 248 ? 248 : r_start); nprim = 8; prim_row0 = b * 16384 + r_start * 64; } }
  const int ntiles = nprim + 4, ctx_row0 = LAT_ + b * 256;
  float lam = 0.f;
  if (MODE == 0) {
    const float* lp = p.df_lambda + l * 128;
    float a = lane < 32 ? lp[lane] * lp[32 + lane] : 0.f, c = lane < 32 ? lp[64 + lane] * lp[96 + lane] : 0.f;
#pragma unroll
    for (int o = 32; o > 0; o >>= 1) { a += __shfl_xor(a, o); c += __shfl_xor(c, o); }
    lam = __expf(a) - __expf(c) + p.lam_init[l];
  } else {
    for (int i = tid; i < 465; i += 256) sRpb[i] = p.na_rpb[(size_t)(l * 4 + h) * 465 + i];
  }
  const int qrow = qrow0 + wid * 16 + fr;
  const bf16x8 q0 = *(const bf16x8*)(P + (size_t)qrow * PN_ + qcol + fq * 8);
  const bf16x8 q1 = *(const bf16x8*)(P + (size_t)qrow * PN_ + qcol + 32 + fq * 8);
  f32x4 O1[4], O2[4];
#pragma unroll
  for (int i = 0; i < 4; ++i) { O1[i] = (f32x4){0.f, 0.f, 0.f, 0.f}; O2[i] = (f32x4){0.f, 0.f, 0.f, 0.f}; }
  float m1 = -INFINITY, m2 = -INFINITY;
  f32x4 L1 = {0.f, 0.f, 0.f, 0.f}, L2 = {0.f, 0.f, 0.f, 0.f};
  const float sc = (MODE == 0 ? 0.17677669529663687f : 0.125f) * LOG2E;
  const int lkey = tid >> 3, loff = (tid & 7) * 8;
  const bf16_t* vtg = (const bf16_t*)(p.ws + OFF_VTG) + (size_t)(b * 4 + h) * 64 * 16640;
  const int lkp = lkey < 16 ? ((lkey >> 2) * 8 + (lkey & 3)) : (((lkey - 16) >> 2) * 8 + 4 + (lkey & 3));
  uint4 rk0A, rk1A, rv0A, rv1A, rk0B, rk1B, rv0B, rv1B;
#define ATT_GLOAD(it_, S) do { const int trow_ = (it_) < nprim ? prim_row0 + (it_) * 64 : ctx_row0 + ((it_) - nprim) * 64; \
    const bf16_t* s0_ = P + (size_t)(trow_ + lkey) * PN_; const bf16_t* s1_ = P + (size_t)(trow_ + lkey + 32) * PN_; \
    rk0##S = *(const uint4*)(s0_ + kcol + loff); rk1##S = *(const uint4*)(s1_ + kcol + loff); \
    if (MODE == 0) { const int kt_ = (it_) < nprim ? 4 + (it_) : (it_) - nprim; const bf16_t* v_ = vtg + (size_t)lkey * 16640 + kt_ * 64 + loff; \
      rv0##S = *(const uint4*)(v_); rv1##S = *(const uint4*)(v_ + (size_t)32 * 16640); } \
    else { rv0##S = *(const uint4*)(s0_ + vcol + loff); rv1##S = *(const uint4*)(s1_ + vcol + loff); } } while (0)
#define ATT_LSTORE(buf_, S) do { bf16_t* ks_ = Ks + (buf_) * 64 * LDT; bf16_t* vt_ = VT + (buf_) * 64 * LDT; \
    *(uint4*)&ks_[lkey * LDT + loff] = rk0##S; *(uint4*)&ks_[(lkey + 32) * LDT + loff] = rk1##S; \
    if (MODE == 0) { *(uint4*)&vt_[lkey * LDT + loff] = rv0##S; *(uint4*)&vt_[(lkey + 32) * LDT + loff] = rv1##S; } \
    else { vt_tr_store(vt_, loff, lkp, rv0##S); vt_tr_store(vt_, loff, lkp + 32, rv1##S); } } while (0)
  ATT_GLOAD(0, A); __builtin_amdgcn_sched_barrier(0); ATT_GLOAD(1, B); __builtin_amdgcn_sched_barrier(0);
  for (int it0 = 0; it0 < ntiles; it0 += 2) {
#pragma unroll
   for (int half = 0; half < 2; ++half) {
    const int it = it0 + half, buf = half;
    if (half == 0) ATT_LSTORE(0, A); else ATT_LSTORE(1, B);
    __syncthreads();
    { const int itn = (it + 2 < ntiles) ? it + 2 : ntiles - 1; if (half == 0) ATT_GLOAD(itn, A); else ATT_GLOAD(itn, B); }
    __builtin_amdgcn_sched_barrier(0);
    const bf16_t* ks = Ks + buf * 64 * LDT; const bf16_t* vt = VT + buf * 64 * LDT;
    f32x4 s1[4], s2[4];
#pragma unroll
    for (int kt = 0; kt < 4; ++kt) {
      const bf16x8 k0 = *(const bf16x8*)&ks[(kt * 16 + fr) * LDT + fq * 8], k1 = *(const bf16x8*)&ks[(kt * 16 + fr) * LDT + 32 + fq * 8];
      const f32x4 z = {0.f, 0.f, 0.f, 0.f};
      if (MODE == 0) { s1[kt] = mfma16(k0, q0, z); s2[kt] = mfma16(k1, q1, z); }
      else { s1[kt] = mfma16(k1, q1, mfma16(k0, q0, z)); }
    }
    float pre = sc;
    if (MODE == 1 && kind == 0 && it < nprim) {
      const int w = wid * 16 + fr; int cs = w - 8; cs = cs < 0 ? 0 : (cs > 48 ? 48 : cs);
      const float* rp = sRpb + (r_start + it - qt + 7) * 31 + 15 - w;
#pragma unroll
      for (int kt = 0; kt < 4; ++kt)
#pragma unroll
        for (int r = 0; r < 4; ++r) { const int kj = kt * 16 + fq * 4 + r; const bool ok = (kj >= cs) && (kj < cs + 16);
          s1[kt][r] = ok ? s1[kt][r] * sc + rp[ok ? kj : w] * LOG2E : -INFINITY; }
      pre = 1.0f;
    }
    {
      float lm = fmaxf(fmaxf(s1[0][0], s1[0][1]), s1[0][2]);
      lm = fmaxf(fmaxf(lm, s1[0][3]), s1[1][0]); lm = fmaxf(fmaxf(lm, s1[1][1]), s1[1][2]); lm = fmaxf(fmaxf(lm, s1[1][3]), s1[2][0]); lm = fmaxf(fmaxf(lm, s1[2][1]), s1[2][2]);
      lm = fmaxf(fmaxf(lm, s1[2][3]), s1[3][0]); lm = fmaxf(fmaxf(lm, s1[3][1]), s1[3][2]); lm = fmaxf(lm, s1[3][3]);
      lm *= pre;
      if (__any(lm > m1 + 8.0f)) {
        float mx = fmaxf(lm, __shfl_xor(lm, 16)); mx = fmaxf(mx, __shfl_xor(mx, 32));
        const float mn = fmaxf(m1, mx), al = __builtin_amdgcn_exp2f(m1 - mn); m1 = mn;
#pragma unroll
        for (int dt = 0; dt < 4; ++dt) O1[dt] = O1[dt] * al;
        L1 = L1 * al;
      }
      { const f32x2_t pv = {pre, pre}, nm = {-m1, -m1};
#pragma unroll
        for (int kt = 0; kt < 4; ++kt) {
          const f32x2_t a = __builtin_elementwise_fma((f32x2_t){s1[kt][0], s1[kt][1]}, pv, nm), b = __builtin_elementwise_fma((f32x2_t){s1[kt][2], s1[kt][3]}, pv, nm);
          s1[kt][0] = __builtin_amdgcn_exp2f(a.x); s1[kt][1] = __builtin_amdgcn_exp2f(a.y); s1[kt][2] = __builtin_amdgcn_exp2f(b.x); s1[kt][3] = __builtin_amdgcn_exp2f(b.y); } }
    }
    if (MODE == 0) {
      float lm = fmaxf(fmaxf(s2[0][0], s2[0][1]), s2[0][2]);
      lm = fmaxf(fmaxf(lm, s2[0][3]), s2[1][0]); lm = fmaxf(fmaxf(lm, s2[1][1]), s2[1][2]); lm = fmaxf(fmaxf(lm, s2[1][3]), s2[2][0]); lm = fmaxf(fmaxf(lm, s2[2][1]), s2[2][2]);
      lm = fmaxf(fmaxf(lm, s2[2][3]), s2[3][0]); lm = fmaxf(fmaxf(lm, s2[3][1]), s2[3][2]); lm = fmaxf(lm, s2[3][3]);
      lm *= sc;
      if (__any(lm > m2 + 8.0f)) {
        float mx = fmaxf(lm, __shfl_xor(lm, 16)); mx = fmaxf(mx, __shfl_xor(mx, 32));
        const float mn = fmaxf(m2, mx), al = __builtin_amdgcn_exp2f(m2 - mn); m2 = mn;
#pragma unroll
        for (int dt = 0; dt < 4; ++dt) O2[dt] = O2[dt] * al;
        L2 = L2 * al;
      }
      { const f32x2_t pv = {sc, sc}, nm = {-m2, -m2};
#pragma unroll
        for (int kt = 0; kt < 4; ++kt) {
          const f32x2_t a = __builtin_elementwise_fma((f32x2_t){s2[kt][0], s2[kt][1]}, pv, nm), b = __builtin_elementwise_fma((f32x2_t){s2[kt][2], s2[kt][3]}, pv, nm);
          s2[kt][0] = __builtin_amdgcn_exp2f(a.x); s2[kt][1] = __builtin_amdgcn_exp2f(a.y); s2[kt][2] = __builtin_amdgcn_exp2f(b.x); s2[kt][3] = __builtin_amdgcn_exp2f(b.y); } }
    }
    union { bf16x8 v; unsigned u[4]; } ones; ones.u[0] = ones.u[1] = ones.u[2] = ones.u[3] = 0x3f803f80u;
#pragma unroll
    for (int kk = 0; kk < 2; ++kk) {
      const bf16x8 pb1 = pack8(s1[2 * kk], s1[2 * kk + 1]);
      bf16x8 pb2 = pb1; if (MODE == 0) pb2 = pack8(s2[2 * kk], s2[2 * kk + 1]);
      L1 = mfma16(ones.v, pb1, L1);
      if (MODE == 0) L2 = mfma16(ones.v, pb2, L2);
#pragma unroll
      for (int dt = 0; dt < 4; ++dt) {
        const bf16x8 vfv = *(const bf16x8*)&vt[(dt * 16 + fr) * LDT + 32 * kk + fq * 8];
        O1[dt] = mfma16(vfv, pb1, O1[dt]);
        if (MODE == 0) O2[dt] = mfma16(vfv, pb2, O2[dt]);
      }
    }
   }
  }
  const float i1 = 1.0f / L1[0];
  float o[4][4];
  if (MODE == 0) {
    const float i2 = lam / L2[0];
    float ss = 0.f;
#pragma unroll
    for (int dt = 0; dt < 4; ++dt)
#pragma unroll
      for (int r = 0; r < 4; ++r) { o[dt][r] = O1[dt][r] * i1 - O2[dt][r] * i2; ss += o[dt][r] * o[dt][r]; }
    ss += __shfl_xor(ss, 16); ss += __shfl_xor(ss, 32);
    const float rs = rsqrtf(ss * (1.0f / 64.0f) + EPS_) * (1.0f - p.lam_init[l]);
#pragma unroll
    for (int dt = 0; dt < 4; ++dt)
#pragma unroll
      for (int r = 0; r < 4; ++r) o[dt][r] *= rs * p.df_norm_w[l * 64 + dt * 16 + fq * 4 + r];
  } else {
#pragma unroll
    for (int dt = 0; dt < 4; ++dt)
#pragma unroll
      for (int r = 0; r < 4; ++r) o[dt][r] = O1[dt][r] * i1;
  }
  bf16_t* yr = Y + (size_t)qrow * 1024 + (MODE == 0 ? 512 : 256) + h * 64 + fq * 4;
#pragma unroll
  for (int dt = 0; dt < 4; ++dt) { uint2 ov; ov.x = pack2(o[dt][0], o[dt][1]); ov.y = pack2(o[dt][2], o[dt][3]); *(uint2*)(yr + dt * 16) = ov; }
  __syncthreads();
}

struct DnIn { bf16x8 qa[2], ka[2], wa[2], qb[4][2]; uint2 ut[4]; f32x4 gr; float gc[4]; float gl; };
DEV int chain_cg(int b, int dir, int step) {
  if (step < 4) return 512 + b * 4 + (dir ? 3 - step : step);
  const int ci = step - 4; return b * 256 + (dir ? 255 - ci : ci);
}
DEV void dn_load(const Params& p, DnIn& in, int cg, int h, int dir, int wid, int fr, int fq) {
  const bf16_t* Yq = (const bf16_t*)(p.ws + OFF_XY); const bf16_t* DK = (const bf16_t*)(p.ws + OFF_DNK);
  const size_t base = ((size_t)(dir * 520 + cg) * 4 + h);
  const bf16_t* W = (const bf16_t*)(p.ws + OFF_DNW) + base * 4096; const bf16_t* UT = (const bf16_t*)(p.ws + OFF_DNUT) + base * 4096;
  const float* G = (const float*)(p.ws + OFF_DNG) + base * 64;
  const int tau = wid * 16 + fr, row = cg * 64 + (dir ? 63 - tau : tau);
#pragma unroll
  for (int ks = 0; ks < 2; ++ks) {
    in.qa[ks] = *(const bf16x8*)(Yq + (size_t)row * 1024 + h * 64 + ks * 32 + fq * 8);
    in.ka[ks] = *(const bf16x8*)(DK + (size_t)row * 256 + h * 64 + ks * 32 + fq * 8);
    in.wa[ks] = *(const bf16x8*)(W + tau * 64 + ks * 32 + fq * 8);
  }
#pragma unroll
  for (int n = 0; n < 4; ++n) {
    const int t2 = n * 16 + fr, row2 = cg * 64 + (dir ? 63 - t2 : t2);
#pragma unroll
    for (int ks = 0; ks < 2; ++ks) in.qb[n][ks] = *(const bf16x8*)(Yq + (size_t)row2 * 1024 + h * 64 + ks * 32 + fq * 8);
    in.ut[n] = *(const uint2*)(UT + (n * 16 + fr) * 64 + wid * 16 + fq * 4);
    in.gc[n] = G[n * 16 + fr];
  }
  in.gr = *(const f32x4*)(G + wid * 16 + fq * 4);
  in.gl = G[63];
}
DEV void dn_scan_chain(const Params& p, int l, int chain, char* ldsc) {
  bf16_t* ST = (bf16_t*)ldsc; bf16_t* sAt = ST + 64 * LDT; bf16_t* sVT = sAt + 64 * LDT; bf16_t* sVT2 = sVT + 64 * LDT; bf16_t* sKT = sVT2 + 64 * LDT;
  const int tid = tid_opaque(), lane = tid & 63, wid = tid >> 6, fr = lane & 15, fq = lane >> 4;
  const int b = chain >> 3, h = (chain >> 1) & 3, dir = chain & 1;
  bf16_t* P = (bf16_t*)(p.ws + OFF_P);
  const int ocol = (dir ? C_DNK : C_DNQ) + h * 64;
  f32x4 S[4];
#pragma unroll
  for (int n = 0; n < 4; ++n) { S[n] = (f32x4){0.f, 0.f, 0.f, 0.f}; *(uint2*)&ST[(n * 16 + fr) * LDT + wid * 16 + fq * 4] = (uint2){0u, 0u}; }
  DnIn cur; dn_load(p, cur, chain_cg(b, dir, 0), h, dir, wid, fr, fq);
  __syncthreads();
  for (int step = 0; step < 260; ++step) {
    const int cg = chain_cg(b, dir, step);
    DnIn nxt; dn_load(p, nxt, chain_cg(b, dir, step + 1 < 260 ? step + 1 : step), h, dir, wid, fr, fq);
    __builtin_amdgcn_sched_barrier(0);
    const f32x4 z = {0.f, 0.f, 0.f, 0.f};
#pragma unroll
    for (int n = 0; n < 4; ++n) {
      f32x4 a = mfma16(cur.ka[0], cur.qb[n][0], z); a = mfma16(cur.ka[1], cur.qb[n][1], a);
      float v[4];
#pragma unroll
      for (int r = 0; r < 4; ++r) { const int s = wid * 16 + fq * 4 + r, t = n * 16 + fr; v[r] = (s <= t) ? a[r] * __expf(cur.gc[n] - cur.gr[r]) : 0.f; }
      uint2 o; o.x = pack2(v[0], v[1]); o.y = pack2(v[2], v[3]);
      *(uint2*)&sAt[(n * 16 + fr) * LDT + wid * 16 + fq * 4] = o;
    }
    f32x4 o1[4];
#pragma unroll
    for (int n = 0; n < 4; ++n) {
      f32x4 ws = z, qs = z;
#pragma unroll
      for (int ks = 0; ks < 2; ++ks) { const bf16x8 bst = *(const bf16x8*)&ST[(n * 16 + fr) * LDT + ks * 32 + fq * 8]; ws = mfma16(cur.wa[ks], bst, ws); qs = mfma16(cur.qa[ks], bst, qs); }
      const float u[4] = {lo_bf(cur.ut[n].x), hi_bf(cur.ut[n].x), lo_bf(cur.ut[n].y), hi_bf(cur.ut[n].y)};
      float vn[4], vn2[4];
#pragma unroll
      for (int r = 0; r < 4; ++r) { vn[r] = u[r] - ws[r]; vn2[r] = vn[r] * __expf(cur.gl - cur.gr[r]); o1[n][r] = qs[r] * __expf(cur.gr[r]); }
      uint2 a, c; a.x = pack2(vn[0], vn[1]); a.y = pack2(vn[2], vn[3]); c.x = pack2(vn2[0], vn2[1]); c.y = pack2(vn2[2], vn2[3]);
      *(uint2*)&sVT[(n * 16 + fr) * LDT + wid * 16 + fq * 4] = a;
      *(uint2*)&sVT2[(n * 16 + fr) * LDT + wid * 16 + fq * 4] = c;
    }
#pragma unroll
    for (int ks = 0; ks < 2; ++ks)
#pragma unroll
      for (int e = 0; e < 8; ++e) sKT[(ks * 32 + fq * 8 + e) * LDT + wid * 16 + fr] = (bf16_t)cur.ka[ks][e];
    __syncthreads();
    const float egl = __expf(cur.gl);
#pragma unroll
    for (int n = 0; n < 4; ++n) {
      f32x4 av = o1[n], kv = z;
#pragma unroll
      for (int ks = 0; ks < 2; ++ks) {
        const bf16x8 aa = *(const bf16x8*)&sAt[(wid * 16 + fr) * LDT + ks * 32 + fq * 8];
        const bf16x8 ak = *(const bf16x8*)&sKT[(wid * 16 + fr) * LDT + ks * 32 + fq * 8];
        const bf16x8 b1 = *(const bf16x8*)&sVT[(n * 16 + fr) * LDT + ks * 32 + fq * 8];
        const bf16x8 b2 = *(const bf16x8*)&sVT2[(n * 16 + fr) * LDT + ks * 32 + fq * 8];
        av = mfma16(aa, b1, av); kv = mfma16(ak, b2, kv);
      }
#pragma unroll
      for (int r = 0; r < 4; ++r) { const int tau = wid * 16 + fq * 4 + r, row = cg * 64 + (dir ? 63 - tau : tau);
        P[(size_t)row * PN_ + ocol + n * 16 + fr] = f2bf(av[r]); S[n][r] = S[n][r] * egl + kv[r]; }
    }
    __syncthreads();
#pragma unroll
    for (int n = 0; n < 4; ++n) { uint2 o; o.x = pack2(S[n][0], S[n][1]); o.y = pack2(S[n][2], S[n][3]); *(uint2*)&ST[(n * 16 + fr) * LDT + wid * 16 + fq * 4] = o; }
    __syncthreads();
    __builtin_amdgcn_sched_barrier(0);
    cur = nxt;
  }
}

struct HgIn { bf16x8 qa[2], aa[2], ka[2]; uint4 v[2]; f32x4 de; };
DEV void hg_load(const Params& p, HgIn& in, int cg, int h, int dir, int tid) {
  const int lane = tid & 63, wid = tid >> 6, fr = lane & 15, fq = lane >> 4;
  const bf16_t* P = (const bf16_t*)(p.ws + OFF_P); const bf16_t* Y = (const bf16_t*)(p.ws + OFF_XY);
  const size_t base = ((size_t)(dir * 520 + cg) * 4 + h);
  const bf16_t* ATT = (const bf16_t*)(p.ws + OFF_HGATT) + base * 4096;
  const float* DE = (const float*)(p.ws + OFF_HGDE) + base * 64;
  const int tau = wid * 16 + fr, row = cg * 64 + (dir ? 63 - tau : tau);
#pragma unroll
  for (int ks = 0; ks < 2; ++ks) {
    in.qa[ks] = dir ? *(const bf16x8*)(Y + (size_t)row * 1024 + 768 + h * 64 + ks * 32 + fq * 8) : *(const bf16x8*)(P + (size_t)row * PN_ + C_HGQ + h * 64 + ks * 32 + fq * 8);
    in.aa[ks] = *(const bf16x8*)(ATT + tau * 64 + ks * 32 + fq * 8);
    in.ka[ks] = *(const bf16x8*)(P + (size_t)row * PN_ + (dir ? C_HGFB : C_HGFF) + h * 64 + ks * 32 + fq * 8);
  }
#pragma unroll
  for (int i = 0; i < 2; ++i) { const int t2 = (tid >> 3) + 32 * i, row2 = cg * 64 + (dir ? 63 - t2 : t2); in.v[i] = *(const uint4*)(P + (size_t)row2 * PN_ + C_HGI + h * 64 + (tid & 7) * 8); }
  in.de = *(const f32x4*)(DE + wid * 16 + fq * 4);
}
DEV void hg_stage(const HgIn& in, bf16_t* kt, bf16_t* vt, int tid) {
  const int lane = tid & 63, wid = tid >> 6, fr = lane & 15, fq = lane >> 4;
#pragma unroll
  for (int ks = 0; ks < 2; ++ks)
#pragma unroll
    for (int e = 0; e < 8; ++e) kt[(ks * 32 + fq * 8 + e) * LDT + wid * 16 + fr] = (bf16_t)in.ka[ks][e];
  vt_tr_store(vt, (tid & 7) * 8, (tid >> 3), in.v[0]); vt_tr_store(vt, (tid & 7) * 8, (tid >> 3) + 32, in.v[1]);
}
DEV void hg_scan_chain(const Params& p, int l, int chain, char* ldsc) {
  bf16_t* ST = (bf16_t*)ldsc; bf16_t* sVT = ST + 2 * 64 * LDT; bf16_t* sKT = sVT + 2 * 64 * LDT;
  const int tid = tid_opaque(), lane = tid & 63, wid = tid >> 6, fr = lane & 15, fq = lane >> 4;
  const int b = chain >> 3, h = (chain >> 1) & 3, dir = chain & 1;
  bf16_t* P = (bf16_t*)(p.ws + OFF_P); bf16_t* Y = (bf16_t*)(p.ws + OFF_XY);
  f32x4 S[4];
#pragma unroll
  for (int n = 0; n < 4; ++n) { S[n] = (f32x4){0.f, 0.f, 0.f, 0.f}; *(uint2*)&ST[(n * 16 + fr) * LDT + wid * 16 + fq * 4] = (uint2){0u, 0u}; }
  HgIn cur; hg_load(p, cur, chain_cg(b, dir, 0), h, dir, tid);
  hg_stage(cur, sKT, sVT, tid);
  __syncthreads();
  for (int step = 0; step < 260; ++step) {
    const int cg = chain_cg(b, dir, step), bufc = step & 1;
    HgIn nxt; hg_load(p, nxt, chain_cg(b, dir, step + 1 < 260 ? step + 1 : step), h, dir, tid);
    __builtin_amdgcn_sched_barrier(0);
    const bf16_t* st = ST + bufc * 64 * LDT; const bf16_t* vt = sVT + bufc * 64 * LDT; const bf16_t* kt = sKT + bufc * 64 * LDT;
    bf16_t* st2 = ST + (bufc ^ 1) * 64 * LDT;
    const f32x4 z = {0.f, 0.f, 0.f, 0.f};
#pragma unroll
    for (int n = 0; n < 4; ++n) {
      f32x4 o = z, kv = z;
#pragma unroll
      for (int ks = 0; ks < 2; ++ks) {
        const bf16x8 bs = *(const bf16x8*)&st[(n * 16 + fr) * LDT + ks * 32 + fq * 8];
        const bf16x8 bv = *(const bf16x8*)&vt[(n * 16 + fr) * LDT + ks * 32 + fq * 8];
        const bf16x8 ak = *(const bf16x8*)&kt[(wid * 16 + fr) * LDT + ks * 32 + fq * 8];
        o = mfma16(cur.qa[ks], bs, o); o = mfma16(cur.aa[ks], bv, o); kv = mfma16(ak, bv, kv);
      }
#pragma unroll
      for (int r = 0; r < 4; ++r) { const int tau = wid * 16 + fq * 4 + r, row = cg * 64 + (dir ? 63 - tau : tau);
        if (dir) Y[(size_t)row * 1024 + 768 + h * 64 + n * 16 + fr] = f2bf(o[r]); else P[(size_t)row * PN_ + C_HGQ + h * 64 + n * 16 + fr] = f2bf(o[r]);
        S[n][r] = S[n][r] * cur.de[r] + kv[r]; }
      uint2 ov; ov.x = pack2(S[n][0], S[n][1]); ov.y = pack2(S[n][2], S[n][3]);
      *(uint2*)&st2[(n * 16 + fr) * LDT + wid * 16 + fq * 4] = ov;
    }
    hg_stage(nxt, sKT + (bufc ^ 1) * 64 * LDT, sVT + (bufc ^ 1) * 64 * LDT, tid);
    __syncthreads();
    __builtin_amdgcn_sched_barrier(0);
    cur = nxt;
  }
}

DEV void mixer_phase(const Params& p, int l, char* lds) {
  __shared__ int s_item;
  unsigned* ctr = (unsigned*)(p.ws + OFF_CTRL) + l;
  const int n_scan = 32, n_df = 2048 * (1 + EXP_DF2), n_na = 2048, n_ctx = (l == 0) ? 64 : 0;
  const int total = n_scan + n_df + n_na + n_ctx;
  for (;;) {
    if (tid_opaque() == 0) s_item = (int)atomicAdd(ctr, 1u);
    __syncthreads();
    const int it = s_item;
    __syncthreads();
    if (it >= total) break;
    const int lo = l;
    if (it < 16) { dn_scan_chain(p, lo, it, lds);
#if EXP_SCAN2
      __syncthreads(); dn_scan_chain(p, lo, it, lds);
#endif
    }
    else if (it < 32) hg_scan_chain(p, lo, it - 16, lds);
    else if (it < 32 + n_df) { const int a = (it - 32) & 2047; attn_item<0>(p, lo, 0, a >> 10, (a >> 8) & 3, a & 255, lds); }
    else if (it < 32 + n_df + n_na) { const int a = it - 32 - n_df; attn_item<1>(p, lo, 0, a >> 10, (a >> 8) & 3, a & 255, lds); }
    else { const int a = it - 32 - n_df - n_na; const int md = a >> 5, bb = (a >> 4) & 1, hh = (a >> 2) & 3, qt = a & 3;
      if (md == 0) attn_item<0>(p, lo, 1, bb, hh, qt, lds); else attn_item<1>(p, lo, 1, bb, hh, qt, lds); }
  }
}

DEV void final_phase(const Params& p) {
  const int lane = tid_opaque() & 63, gw = bid_opaque() * 4 + (tid_opaque() >> 6), nw = gridDim.x * 4;
  for (int r = gw; r < LAT_; r += nw) {
    float4* xr = (float4*)(p.out + (size_t)r * 1024);
    float4 v[4]; float ss = 0.f;
#pragma unroll
    for (int i = 0; i < 4; ++i) { v[i] = xr[lane + 64 * i]; ss += v[i].x * v[i].x + v[i].y * v[i].y + v[i].z * v[i].z + v[i].w * v[i].w; }
#pragma unroll
    for (int o = 32; o > 0; o >>= 1) ss += __shfl_xor(ss, o);
    const float rs = rsqrtf(ss * (1.0f / 1024.0f) + EPS_);
#pragma unroll
    for (int i = 0; i < 4; ++i) { const float4 w4 = *(const float4*)(p.final_norm_w + (lane + 64 * i) * 4);
      float4 o4 = {v[i].x * rs * w4.x, v[i].y * rs * w4.y, v[i].z * rs * w4.z, v[i].w * rs * w4.w}; xr[lane + 64 * i] = o4; }
  }
}


#define XB_TMO      128
#define XB_XCNT(j)  (256  + 64 * (j))
#define XB_XSUB(j)  (1280 + 64 * (j))
#define XB_XGEN(j)  (2304 + 64 * (j))
#define XB_TOP      3328
#define XB_TOPGEN   3392
#define XB_SPIN_CAP (1u << 22)
#define LAS __attribute__((address_space(3)))
DEV unsigned xb_ld(unsigned* p)              { return __hip_atomic_load(p, __ATOMIC_RELAXED, __HIP_MEMORY_SCOPE_AGENT); }
DEV unsigned xb_add(unsigned* p, unsigned v) { return __hip_atomic_fetch_add(p, v, __ATOMIC_RELAXED, __HIP_MEMORY_SCOPE_AGENT); }
DEV unsigned xb_xcc_id() { return (unsigned)__builtin_amdgcn_s_getreg((3 << 11) | 20) & 0xFu; }
#define XB_SPIN(cond, bar) do { unsigned _sp = 0; while (cond) { __builtin_amdgcn_s_sleep(1); \
    if ((++_sp & 255u) == 0u) { if (xb_ld(&(bar)[XB_TMO])) break; if (_sp > XB_SPIN_CAP) { atomicAdd(&(bar)[XB_TMO], 1u); break; } } } } while (0)
struct XcdBarrier { unsigned* bar; unsigned x; volatile LAS unsigned* st; };
DEV XcdBarrier xcd_barrier_post(unsigned* bar, volatile LAS unsigned* st) {
  XcdBarrier b; b.bar = bar; b.x = xb_xcc_id(); b.st = st;
  if (threadIdx.x == 0) (void)xb_add(&bar[XB_XCNT(b.x)], 1u);
  return b;
}
DEV void xcd_barrier_complete(unsigned* bar, unsigned x, unsigned& nloc, unsigned& nx) {
  const unsigned G = gridDim.x * gridDim.y * gridDim.z;
  unsigned sum, cnt, mine, sp = 0u;
  for (;;) {
    sum = 0u; cnt = 0u; mine = 0u;
#pragma unroll
    for (unsigned j = 0; j < 16; ++j) { const unsigned c = xb_ld(&bar[XB_XCNT(j)]); sum += c; cnt += (c > 0u) ? 1u : 0u; mine = (j == x) ? c : mine; }
    if (sum == G) break;
    __builtin_amdgcn_s_sleep(1);
    if ((++sp & 255u) == 0u) { if (xb_ld(&bar[XB_TMO])) break; if (sp > XB_SPIN_CAP) { atomicAdd(&bar[XB_TMO], 1u); break; } }
  }
  nloc = mine > 0u ? mine : 1u; nx = cnt > 0u ? cnt : 1u;
}
DEV void xcd_barrier(const XcdBarrier& b) {
  asm volatile("s_waitcnt vmcnt(0)" ::: "memory");
  __syncthreads();
  if (threadIdx.x == 0) {
    unsigned* bar = b.bar;
    __builtin_amdgcn_s_waitcnt(0);
    unsigned nloc = b.st[0], nx = b.st[1];
    if (nloc == 0u) { xcd_barrier_complete(bar, b.x, nloc, nx); b.st[0] = nloc; b.st[1] = nx; }
    const unsigned old = xb_add(&bar[XB_XSUB(b.x)], 1u);
    const unsigned gen = old / nloc;
    if (old + 1u == (gen + 1u) * nloc) {
      __builtin_amdgcn_fence(__ATOMIC_RELEASE, "agent");
      asm volatile("s_waitcnt vmcnt(0)" ::: "memory");
      const unsigned og = xb_add(&bar[XB_TOP], 1u);
      const unsigned tg = og / nx;
      if (og + 1u == (tg + 1u) * nx) xb_add(&bar[XB_TOPGEN], 1u);
      else XB_SPIN(xb_ld(&bar[XB_TOPGEN]) == tg, bar);
      __builtin_amdgcn_fence(__ATOMIC_ACQUIRE, "agent");
      xb_add(&bar[XB_XGEN(b.x)], 1u);
      asm volatile("s_waitcnt vmcnt(0)" ::: "memory");
    } else {
      XB_SPIN(xb_ld(&bar[XB_XGEN(b.x)]) == gen, bar);
      __builtin_amdgcn_fence(__ATOMIC_ACQUIRE, "agent");
      asm volatile("s_waitcnt vmcnt(0)" ::: "memory");
    }
  }
  __syncthreads();
}

constexpr int LDS_BYTES = 76800;
__global__ void __launch_bounds__(256, 2) mega(Params p) {
  extern __shared__ __attribute__((aligned(16))) char lds[];
  cg::grid_group grid = cg::this_grid();
  __shared__ uint4 xb_words;
  if (threadIdx.x == 0) xb_words = make_uint4(0u, 0u, 0u, 0u);
  __syncthreads();
  const XcdBarrier xb = xcd_barrier_post((unsigned*)(p.ws + OFF_BAR), (volatile LAS unsigned*)&xb_words);
  phase0(p, lds);
  grid.sync();
  for (int l = 0; l < 2; ++l) {
    const char* wb = p.ws + OFF_WB + (size_t)l * WB_LAYER;
    const bf16_t* XY = (const bf16_t*)(p.ws + OFF_XY);
    norm_phase(p, l, 0);
    xcd_barrier(xb);
    { EpiArgs e{l, 0, false}; gemm_phase<0>(p, XY, (const bf16_t*)(wb + WB_IN), 1024, 260, 31, e, lds, l * 4 + 0); }
    xcd_barrier(xb);
#if EXP_IN2
    { EpiArgs e{l, 0, false}; gemm_phase<0>(p, XY, (const bf16_t*)(wb + WB_IN), 1024, 260, 31, e, lds, 8 + l); }
    xcd_barrier(xb);
#endif
    prep_phase(p, l, lds);
    xcd_barrier(xb);
    mixer_phase(p, l, lds);
    xcd_barrier(xb);
    post_phase(p, l);
    xcd_barrier(xb);
    { EpiArgs e{l, 2, l == 0}; gemm_phase<1>(p, XY, (const bf16_t*)(wb + WB_OUT), 1024, 260, 8, e, lds, l * 4 + 1); }
    xcd_barrier(xb);
    norm_phase(p, l, 1);
    xcd_barrier(xb);
    { EpiArgs e{l, 0, false}; gemm_phase<2>(p, XY, (const bf16_t*)(wb + WB_UP), 1024, 265, 44, e, lds, l * 4 + 2); }
    xcd_barrier(xb);
#if EXP_UP2
    { EpiArgs e{l, 0, false}; gemm_phase<2>(p, XY, (const bf16_t*)(wb + WB_UP), 1024, 265, 44, e, lds, l * 4 + 2); }
    xcd_barrier(xb);
#endif
    { EpiArgs e{l, 5, false}; gemm_phase<1>(p, (const bf16_t*)(p.ws + OFF_P), (const bf16_t*)(wb + WB_DOWN), 2816, 260, 8, e, lds, l * 4 + 3); }
    xcd_barrier(xb);
  }
  final_phase(p);
}

extern "C" void kernel_launch(void* const* d_in, const int* in_sizes, int n_in, void* d_out, int out_size, void* d_ws, size_t ws_size, hipStream_t stream) {
  static int grid_blocks = 0;
  if (!grid_blocks) {
    int dev = 0, cus = 0, per_cu = 0;
    hipGetDevice(&dev);
    hipDeviceGetAttribute(&cus, hipDeviceAttributeMultiprocessorCount, dev);
    hipFuncSetAttribute((const void*)mega, hipFuncAttributeMaxDynamicSharedMemorySize, LDS_BYTES);
    hipOccupancyMaxActiveBlocksPerMultiprocessor(&per_cu, mega, 256, LDS_BYTES);
    if (per_cu > 2) per_cu = 2;
    if (per_cu < 1) per_cu = 1;
    grid_blocks = cus * per_cu;
  }
  Params p{};
  const float** f = (const float**)&p;
  for (int i = 0; i < 23; ++i) f[i] = (const float*)d_in[i];
  p.out = (float*)d_out; p.ws = (char*)d_ws;
  p.lam_init[0] = (float)(0.8 - 0.6 * exp(-0.3 * 0.0)); p.lam_init[1] = (float)(0.8 - 0.6 * exp(-0.3 * 1.0));
  p.debug = 0; p.pad = 0;
  if (ws_size < WS_NEED) fprintf(stderr, "workspace too small: %zu < %zu\n", ws_size, (size_t)WS_NEED);
  (void)hipMemsetAsync((char*)d_ws + OFF_BAR, 0, 16384, stream);
  void* args[] = {&p};
  hipError_t e = hipLaunchCooperativeKernel((void*)mega, dim3(grid_blocks), dim3(256), args, LDS_BYTES, stream);
  if (e != hipSuccess) fprintf(stderr, "cooperative launch failed: %s (grid %d)\n", hipGetErrorString(e), grid_blocks);
}
```

```cpp
#include <hip/hip_runtime.h>
#include <hip/hip_cooperative_groups.h>
#include <cstdio>
#include <cstdint>
#include <cmath>
namespace cg = cooperative_groups;
#define EXP_UP2 0
#define EXP_IN2 0
#define EXP_SCAN2 0
#define EXP_DF2 0

typedef unsigned short bf16_t;
typedef short bf16x8 __attribute__((ext_vector_type(8)));
typedef float f32x4 __attribute__((ext_vector_type(4)));
#define DEV __device__ __forceinline__

constexpr int R_ = 33280, LAT_ = 32768, D_ = 1024, PN_ = 3968, PIN_ = 3856, DFF_ = 2816;
constexpr int C_DNQ = 0, C_DNK = 256, C_DNV = 512, C_DNG = 768, C_DNBA = 1024, C_NAQ = 1040, C_NAK = 1296, C_NAV = 1552,
              C_DFQ = 1808, C_DFK = 2064, C_DFV = 2320, C_HGQ = 2576, C_HGI = 2832, C_HGFF = 3088, C_HGFB = 3344, C_HGG = 3600;
constexpr int LDT = 72;
constexpr float EPS_ = 1e-6f;
constexpr float LOG2E = 1.4426950408889634f;

constexpr size_t OFF_CTRL = 0;
constexpr size_t OFF_MOD = 4096;
constexpr size_t OFF_HCTX = OFF_MOD + 2 * 3 * 6144 * 4;
constexpr size_t OFF_WB = OFF_HCTX + 512 * 1024 * 4;
constexpr size_t WB_IN = 0, WB_OUT = (size_t)PN_ * 1024 * 2, WB_UP = WB_OUT + 1024 * 1024 * 2, WB_DOWN = WB_UP + (size_t)5632 * 1024 * 2,
                 WB_LAYER = WB_DOWN + (size_t)1024 * 2816 * 2;
constexpr size_t OFF_XY = OFF_WB + 2 * WB_LAYER;
constexpr size_t OFF_P = OFF_XY + (size_t)R_ * 1024 * 2;
constexpr size_t OFF_DNK = OFF_P + (size_t)R_ * PN_ * 2;
constexpr size_t SZ_CH = (size_t)2 * 520 * 4 * 64 * 64 * 2;
constexpr size_t OFF_DNW = OFF_DNK + (size_t)R_ * 256 * 2;
constexpr size_t OFF_DNUT = OFF_DNW + SZ_CH;
constexpr size_t OFF_HGATT = OFF_DNUT + SZ_CH;
constexpr size_t OFF_DNG = OFF_HGATT + SZ_CH;
constexpr size_t OFF_HGDE = OFF_DNG + (size_t)2 * 520 * 4 * 64 * 4;
constexpr size_t OFF_BAR = OFF_HGDE + (size_t)2 * 520 * 4 * 64 * 4;
constexpr size_t OFF_VTG = OFF_BAR + 16384;
constexpr size_t WS_NEED = OFF_VTG + (size_t)8 * 64 * 16640 * 2;

struct Params {
  const float *x, *c, *ctx, *c_ctx, *w_ada, *b_ada, *norm1_w, *norm2_w, *w_in, *dn_conv_w, *dn_a_log, *dn_dt_bias, *dn_norm_w, *na_rpb,
      *df_lambda, *df_norm_w, *hg_lb_raw, *hg_norm_w, *w_out, *w_up, *ffn_conv_w, *w_down, *final_norm_w;
  float* out; char* ws;
  float lam_init[2]; int debug; int pad;
};

DEV float bf2f(bf16_t h) { return __uint_as_float((unsigned)h << 16); }
typedef __bf16 bf16x2_t __attribute__((ext_vector_type(2)));
typedef float f32x2_t __attribute__((ext_vector_type(2)));
DEV unsigned pack2(float lo, float hi) { f32x2_t f = {lo, hi}; bf16x2_t b = __builtin_convertvector(f, bf16x2_t); return __builtin_bit_cast(unsigned, b); }
DEV bf16_t f2bf(float f) { return (bf16_t)(pack2(f, f) & 0xffffu); }
DEV float lo_bf(unsigned u) { return __uint_as_float(u << 16); }
DEV float hi_bf(unsigned u) { return __uint_as_float(u & 0xffff0000u); }
DEV float sigmoidf_(float x) { return __builtin_amdgcn_rcpf(1.0f + __builtin_amdgcn_exp2f(-LOG2E * x)); }
DEV float siluf_(float x) { return x * __builtin_amdgcn_rcpf(1.0f + __builtin_amdgcn_exp2f(-LOG2E * x)); }
DEV f32x4 mfma16(bf16x8 a, bf16x8 b, f32x4 c) { return __builtin_amdgcn_mfma_f32_16x16x32_bf16(a, b, c, 0, 0, 0); }

DEV int tid_opaque() { int t = threadIdx.x; asm volatile("" : "+v"(t)); return t; }
DEV int bid_opaque() { int t = blockIdx.x; asm volatile("" : "+s"(t)); return t; }
DEV int grp_of(int r) { return r < LAT_ ? (r >> 14) : 2; }
DEV bool seq_first(int r) { return r < LAT_ ? ((r & 16383) == 0) : (((r - LAT_) & 255) == 0); }
DEV bool seq_last(int r) { return r < LAT_ ? ((r & 16383) == 16383) : (((r - LAT_) & 255) == 255); }

DEV void transpose_tile(const float* __restrict__ src, bf16_t* __restrict__ dst, int K, int N, int k0, int n0, int drow0, float* lds) {
  const int tx = tid_opaque() & 63, ty = tid_opaque() >> 6;
#pragma unroll 4
  for (int i = 0; i < 16; ++i) { const int k = ty + 4 * i; lds[k * 65 + tx] = (n0 + tx < N) ? src[(size_t)(k0 + k) * N + n0 + tx] : 0.f; }
  __syncthreads();
#pragma unroll 4
  for (int i = 0; i < 16; ++i) { const int n = ty + 4 * i; dst[(size_t)(drow0 + n) * K + k0 + tx] = f2bf(lds[tx * 65 + n]); }
  __syncthreads();
}

DEV void phase0(const Params& p, char* ldsc) {
  float* lds = (float*)ldsc;
  const int tid = tid_opaque();
  if (bid_opaque() == 0) ((unsigned*)(p.ws + OFF_CTRL))[tid] = 0u;
  constexpr int T_IN = 16 * 62, T_OUT = 256, T_UP = 16 * 88, T_DOWN = 44 * 16, T_L = T_IN + T_OUT + T_UP + T_DOWN;
  const int nitems = 2 * T_L + 192;
  for (int it = bid_opaque(); it < nitems; it += gridDim.x) {
    if (it < 2 * T_L) {
      const int l = it / T_L; int t = it % T_L;
      char* wb = p.ws + OFF_WB + (size_t)l * WB_LAYER;
      if (t < T_IN) { transpose_tile(p.w_in + (size_t)l * 1024 * PIN_, (bf16_t*)(wb + WB_IN), 1024, PIN_, (t % 16) * 64, (t / 16) * 64, (t / 16) * 64, lds); continue; }
      t -= T_IN;
      if (t < T_OUT) { transpose_tile(p.w_out + (size_t)l * 1024 * 1024, (bf16_t*)(wb + WB_OUT), 1024, 1024, (t % 16) * 64, (t / 16) * 64, (t / 16) * 64, lds); continue; }
      t -= T_OUT;
      if (t < T_UP) { const int nt = t / 16; const int drow = nt < 44 ? nt * 128 : (nt - 44) * 128 + 64;
        transpose_tile(p.w_up + (size_t)l * 1024 * 5632, (bf16_t*)(wb + WB_UP), 1024, 5632, (t % 16) * 64, nt * 64, drow, lds); continue; }
      t -= T_UP;
      transpose_tile(p.w_down + (size_t)l * 2816 * 1024, (bf16_t*)(wb + WB_DOWN), 2816, 1024, (t % 44) * 64, (t / 44) * 64, (t / 44) * 64, lds);
    } else {
      const int a = it - 2 * T_L, l = a / 96, cb = a % 96;
      float* sS = lds;
      float* sP = lds + 3072;
      for (int i = tid; i < 3072; i += 256) { const int g = i >> 10, k = i & 1023; const float v = g < 2 ? p.c[g * 1024 + k] : p.c_ctx[k]; sS[i] = siluf_(v); }
      __syncthreads();
      const int col = cb * 64 + (tid & 63), kq = tid >> 6;
      const float* w = p.w_ada + (size_t)l * 1024 * 6144 + col;
      float a0 = 0.f, a1 = 0.f, a2 = 0.f;
#pragma unroll 8
      for (int k = kq * 256; k < kq * 256 + 256; ++k) { const float wv = w[(size_t)k * 6144]; a0 += sS[k] * wv; a1 += sS[1024 + k] * wv; a2 += sS[2048 + k] * wv; }
      sP[(kq * 3 + 0) * 64 + (tid & 63)] = a0; sP[(kq * 3 + 1) * 64 + (tid & 63)] = a1; sP[(kq * 3 + 2) * 64 + (tid & 63)] = a2;
      __syncthreads();
      if (tid < 192) { const int g = tid >> 6, cc = tid & 63; const float s = sP[(0 * 3 + g) * 64 + cc] + sP[(1 * 3 + g) * 64 + cc] + sP[(2 * 3 + g) * 64 + cc] + sP[(3 * 3 + g) * 64 + cc];
        ((float*)(p.ws + OFF_MOD))[(l * 3 + g) * 6144 + cb * 64 + cc] = s + p.b_ada[l * 6144 + cb * 64 + cc]; }
      __syncthreads();
    }
  }
}

DEV const float* xrow_ptr(const Params& p, int r, bool from_input) {
  if (r < LAT_) return (from_input ? p.x : p.out) + (size_t)r * 1024;
  return (from_input ? p.ctx : (const float*)(p.ws + OFF_HCTX)) + (size_t)(r - LAT_) * 1024;
}
DEV void norm_phase(const Params& p, int l, int which) {
  const int lane = tid_opaque() & 63, gw = bid_opaque() * 4 + (tid_opaque() >> 6), nw = gridDim.x * 4;
  const float* nwt = (which == 0 ? p.norm1_w : p.norm2_w) + l * 1024;
  bf16_t* xn = (bf16_t*)(p.ws + OFF_XY);
  for (int r = gw; r < R_; r += nw) {
    const float4* xr = (const float4*)xrow_ptr(p, r, l == 0 && which == 0);
    const float* mod = (const float*)(p.ws + OFF_MOD) + (l * 3 + grp_of(r)) * 6144 + which * 3 * 1024;
    float4 v[4]; float ss = 0.f;
#pragma unroll
    for (int i = 0; i < 4; ++i) { v[i] = xr[lane + 64 * i]; ss += v[i].x * v[i].x + v[i].y * v[i].y + v[i].z * v[i].z + v[i].w * v[i].w; }
#pragma unroll
    for (int o = 32; o > 0; o >>= 1) ss += __shfl_xor(ss, o);
    const float rs = rsqrtf(ss * (1.0f / 1024.0f) + EPS_);
#pragma unroll
    for (int i = 0; i < 4; ++i) {
      const int c = (lane + 64 * i) * 4;
      const float4 w4 = *(const float4*)(nwt + c), sh = *(const float4*)(mod + c), sc = *(const float4*)(mod + 1024 + c);
      const float y0 = v[i].x * rs * w4.x * (1.f + sc.x) + sh.x, y1 = v[i].y * rs * w4.y * (1.f + sc.y) + sh.y;
      const float y2 = v[i].z * rs * w4.z * (1.f + sc.z) + sh.z, y3 = v[i].w * rs * w4.w * (1.f + sc.w) + sh.w;
      uint2 o; o.x = pack2(y0, y1); o.y = pack2(y2, y3);
      *(uint2*)(xn + (size_t)r * 1024 + c) = o;
    }
  }
}

struct EpiArgs { int l; int gi; bool first; };
template <int EPI>
DEV void gemm_tile(const Params& p, const bf16_t* __restrict__ A, const bf16_t* __restrict__ Bt, int K, int arow0, int brow0, int tn, const EpiArgs& e, char* ldsc) {
  bf16_t* As = (bf16_t*)ldsc;
  bf16_t* Bs = As + 2 * 128 * 64;
  const int tid = tid_opaque(), lane = tid & 63, wid = __builtin_amdgcn_readfirstlane(tid >> 6), fr = lane & 15, fq = lane >> 4, wm = wid >> 1, wn = wid & 1;
  const int lr = tid >> 3, lc = (((tid & 7) ^ (lr & 7)) * 8);
  size_t ao0, ao1, ao2, ao3;
  { int r0 = arow0 + lr, r1 = r0 + 32, r2 = r0 + 64, r3 = r0 + 96;
    r0 = r0 < 0 ? 0 : (r0 > R_ - 1 ? R_ - 1 : r0); r1 = r1 < 0 ? 0 : (r1 > R_ - 1 ? R_ - 1 : r1); r2 = r2 < 0 ? 0 : (r2 > R_ - 1 ? R_ - 1 : r2); r3 = r3 < 0 ? 0 : (r3 > R_ - 1 ? R_ - 1 : r3);
    ao0 = (size_t)r0 * K + lc; ao1 = (size_t)r1 * K + lc; ao2 = (size_t)r2 * K + lc; ao3 = (size_t)r3 * K + lc; }
  const bf16_t* bp0 = Bt + (size_t)(brow0 + lr) * K + lc;
  const size_t bstep = (size_t)32 * K;
  f32x4 acc[4][4];
#pragma unroll
  for (int a = 0; a < 4; ++a)
#pragma unroll
    for (int b = 0; b < 4; ++b) acc[a][b] = (f32x4){0.f, 0.f, 0.f, 0.f};
  const int nk = K >> 6;
  char* ldsA = (char*)As + wid * 1024; char* ldsB = (char*)Bs + wid * 1024;
#define GEMM_GLDS(kt_, buf_) do { const int ko_ = (kt_) * 64; char* la_ = ldsA + (buf_) * 16384; char* lb_ = ldsB + (buf_) * 16384; \
    __builtin_amdgcn_global_load_lds((const unsigned*)(A + ao0 + ko_), (unsigned*)(la_), 16, 0, 0); \
    __builtin_amdgcn_global_load_lds((const unsigned*)(A + ao1 + ko_), (unsigned*)(la_ + 4096), 16, 0, 0); \
    __builtin_amdgcn_global_load_lds((const unsigned*)(A + ao2 + ko_), (unsigned*)(la_ + 8192), 16, 0, 0); \
    __builtin_amdgcn_global_load_lds((const unsigned*)(A + ao3 + ko_), (unsigned*)(la_ + 12288), 16, 0, 0); \
    __builtin_amdgcn_global_load_lds((const unsigned*)(bp0 + ko_), (unsigned*)(lb_), 16, 0, 0); \
    __builtin_amdgcn_global_load_lds((const unsigned*)(bp0 + bstep + ko_), (unsigned*)(lb_ + 4096), 16, 0, 0); \
    __builtin_amdgcn_global_load_lds((const unsigned*)(bp0 + 2 * bstep + ko_), (unsigned*)(lb_ + 8192), 16, 0, 0); \
    __builtin_amdgcn_global_load_lds((const unsigned*)(bp0 + 3 * bstep + ko_), (unsigned*)(lb_ + 12288), 16, 0, 0); } while (0)
  GEMM_GLDS(0, 0);
  for (int kt = 0; kt < nk; ++kt) {
   {
    const int buf = kt & 1;
    asm volatile("s_waitcnt vmcnt(0)" ::: "memory");
    __syncthreads();
    if (kt + 1 < nk) GEMM_GLDS(kt + 1, buf ^ 1);
    __builtin_amdgcn_sched_barrier(0);
    const bf16_t* as = As + buf * 128 * 64; const bf16_t* bs = Bs + buf * 128 * 64;
#pragma unroll
    for (int ks = 0; ks < 2; ++ks) {
      bf16x8 af[4], bfr[4];
#pragma unroll
      for (int i = 0; i < 4; ++i) { af[i] = *(const bf16x8*)&as[(wm * 64 + i * 16 + fr) * 64 + (((ks * 4 + fq) ^ (fr & 7)) * 8)]; bfr[i] = *(const bf16x8*)&bs[(wn * 64 + i * 16 + fr) * 64 + (((ks * 4 + fq) ^ (fr & 7)) * 8)]; }
#pragma unroll
      for (int ni = 0; ni < 4; ++ni)
#pragma unroll
        for (int mi = 0; mi < 4; ++mi) acc[ni][mi] = mfma16(bfr[ni], af[mi], acc[ni][mi]);
    }
   }
  }
  __syncthreads();
  if (EPI == 0) {
    bf16_t* P = (bf16_t*)(p.ws + OFF_P);
#pragma unroll
    for (int mi = 0; mi < 4; ++mi) { const size_t row = (size_t)(arow0 + wm * 64 + mi * 16 + fr);
#pragma unroll
      for (int ni = 0; ni < 4; ++ni) { uint2 o; o.x = pack2(acc[ni][mi][0], acc[ni][mi][1]); o.y = pack2(acc[ni][mi][2], acc[ni][mi][3]);
        *(uint2*)(P + row * PN_ + brow0 + wn * 64 + ni * 16 + fq * 4) = o; } }
  } else if (EPI == 1) {
#pragma unroll
    for (int mi = 0; mi < 4; ++mi) { const int row = arow0 + wm * 64 + mi * 16 + fr;
      const float* xin = xrow_ptr(p, row, e.first);
      float* xout = row < LAT_ ? p.out + (size_t)row * 1024 : (float*)(p.ws + OFF_HCTX) + (size_t)(row - LAT_) * 1024;
      const float* gate = (const float*)(p.ws + OFF_MOD) + (e.l * 3 + grp_of(row)) * 6144 + e.gi * 1024;
#pragma unroll
      for (int ni = 0; ni < 4; ++ni) { const int col = brow0 + wn * 64 + ni * 16 + fq * 4;
        const float4 xi = *(const float4*)(xin + col), g = *(const float4*)(gate + col);
        float4 o; o.x = xi.x + g.x * acc[ni][mi][0]; o.y = xi.y + g.y * acc[ni][mi][1]; o.z = xi.z + g.z * acc[ni][mi][2]; o.w = xi.w + g.w * acc[ni][mi][3];
        *(float4*)(xout + col) = o; } }
  } else {
    constexpr int GS = 68;
    float* G = (float*)ldsc;
    float* Vb = (float*)(ldsc + 128 * GS * 4);
    if (wn == 0) {
#pragma unroll
      for (int mi = 0; mi < 4; ++mi)
#pragma unroll
        for (int ni = 0; ni < 4; ++ni) *(f32x4*)&G[(wm * 64 + mi * 16 + fr) * GS + ni * 16 + fq * 4] = acc[ni][mi];
    } else {
#pragma unroll
      for (int mi = 2; mi < 4; ++mi)
#pragma unroll
        for (int ni = 0; ni < 4; ++ni) *(f32x4*)&Vb[(wm * 64 + mi * 16 + fr) * GS + ni * 16 + fq * 4] = acc[ni][mi];
    }
    __syncthreads();
    {
      bf16_t* H = (bf16_t*)(p.ws + OFF_P);
      const float* cw = p.ffn_conv_w + (size_t)e.l * 3 * DFF_ + tn * 64;
#pragma unroll
      for (int mi2 = 0; mi2 < 2; ++mi2) { const int mi = wn == 1 ? mi2 : mi2 + 2; const int m = wm * 64 + mi * 16 + fr, gr = arow0 + m;
        const bool valid = (m >= 1) && (m <= 126) && (gr >= 0) && (gr < R_);
        if (valid) { const bool hasp = !seq_first(gr), hasn = !seq_last(gr);
#pragma unroll
          for (int ni = 0; ni < 4; ++ni) { const int c0 = ni * 16 + fq * 4;
            const f32x4 w0 = *(const f32x4*)(cw + c0), w1 = *(const f32x4*)(cw + DFF_ + c0), w2 = *(const f32x4*)(cw + 2 * DFF_ + c0);
            const f32x4 z4 = {0.f, 0.f, 0.f, 0.f};
            const f32x4 g1 = *(const f32x4*)&G[m * GS + c0];
            const f32x4 g0 = hasp ? *(const f32x4*)&G[(m - 1) * GS + c0] : z4;
            const f32x4 g2 = hasn ? *(const f32x4*)&G[(m + 1) * GS + c0] : z4;
            const f32x4 cv = w1 * g1 + w0 * g0 + w2 * g2;
            f32x4 vv; if (wn == 1) vv = acc[ni][mi2]; else vv = *(const f32x4*)&Vb[m * GS + c0];
            uint2 o; o.x = pack2(siluf_(cv[0]) * vv[0], siluf_(cv[1]) * vv[1]); o.y = pack2(siluf_(cv[2]) * vv[2], siluf_(cv[3]) * vv[3]);
            *(uint2*)(H + (size_t)gr * DFF_ + tn * 64 + c0) = o; } } }
    }
    __syncthreads();
  }
}

DEV unsigned xcc_id() { return (unsigned)__builtin_amdgcn_s_getreg((3 << 11) | 20) & 7u; }
template <int EPI>
DEV void gemm_phase(const Params& p, const bf16_t* A, const bf16_t* Bt, int K, int ntm, int ntn, const EpiArgs& e, char* lds, int gidx) {
  __shared__ int s_q;
  unsigned* ctr = (unsigned*)(p.ws + OFF_CTRL) + 8 + gidx * 8;
  const int x0 = (int)xcc_id(), nig = 8 * ntn;
  for (int xo = 0; xo < 8; ++xo) {
    const int xcd = (x0 + xo) & 7, cnt = (ntm - xcd + 7) >> 3, total = cnt * ntn;
    for (;;) {
      if (tid_opaque() == 0) s_q = (int)atomicAdd(ctr + xcd, 1u);
      __syncthreads();
      const int q = s_q;
      __syncthreads();
      if (q >= total) break;
      const int grp = q / nig, rem = q - grp * nig, fm = grp * 8, gsz = (cnt - fm) < 8 ? (cnt - fm) : 8;
      const int tm = xcd + 8 * (fm + rem % gsz), tn = rem / gsz;
      const int arow0 = (EPI == 2) ? tm * 126 - 1 : tm * 128;
      gemm_tile<EPI>(p, A, Bt, K, arow0, tn * 128, tn, e, lds);
    }
  }
}

DEV float wave_incl_scan(float v, int lane) {
#pragma unroll
  for (int o = 1; o < 64; o <<= 1) { const float t = __shfl_up(v, o); if (lane >= o) v += t; }
  return v;
}
DEV void dn_prep_item(const Params& p, int l, int cg, int h, char* ldsc) {
  bf16_t* sIn = (bf16_t*)ldsc;
  float* sKK = (float*)ldsc;
  float* sQ = (float*)(ldsc + 25344);
  float* sK = (float*)(ldsc + 41984);
  float* sV = (float*)(ldsc + 58624);
  float* sBeta = (float*)(ldsc + 75264);
  float* sG = sBeta + 128;
  const int tid = tid_opaque(), lane = tid & 63, wid = tid >> 6;
  const bf16_t* P = (const bf16_t*)(p.ws + OFF_P);
  const int row0 = cg * 64;
  const bool hasp = !seq_first(row0), hasn = !seq_last(row0 + 63);
  for (int c = tid; c < 66 * 24; c += 256) {
    const int j = c / 24, cc = c % 24, part = cc >> 3, off = (cc & 7) * 8;
    uint4 v = {0u, 0u, 0u, 0u};
    const bool ok = (j == 0) ? hasp : (j == 65 ? hasn : true);
    if (ok) v = *(const uint4*)(P + (size_t)(row0 - 1 + j) * PN_ + part * 256 + h * 64 + off);
    *(uint4*)&sIn[j * 192 + part * 64 + off] = v;
  }
  __syncthreads();
  if (tid < 192) {
    const float* cw = p.dn_conv_w + (size_t)l * 3 * 768;
    const int ch = tid, part = ch >> 6, d = ch & 63, wc = part * 256 + h * 64 + d;
    const float w0 = cw[wc], w1 = cw[768 + wc], w2 = cw[1536 + wc];
    float* dst = part == 0 ? sQ : (part == 1 ? sK : sV);
    float x0 = bf2f(sIn[ch]), x1 = bf2f(sIn[192 + ch]);
#pragma unroll 4
    for (int t = 0; t < 64; ++t) {
      const float x2 = bf2f(sIn[(t + 2) * 192 + ch]);
      dst[t * 65 + d] = siluf_(w0 * x0 + w1 * x1 + w2 * x2);
      x0 = x1; x1 = x2;
    }
  }
  __syncthreads();
  {
    bf16_t* Y = (bf16_t*)(p.ws + OFF_XY); bf16_t* DK = (bf16_t*)(p.ws + OFF_DNK);
    for (int i = 0; i < 16; ++i) {
      const int t = wid * 16 + i;
      float q = sQ[t * 65 + lane], k = sK[t * 65 + lane];
      float sq = q * q, sk = k * k;
#pragma unroll
      for (int o = 32; o > 0; o >>= 1) { sq += __shfl_xor(sq, o); sk += __shfl_xor(sk, o); }
      q *= rsqrtf(sq + EPS_); k *= rsqrtf(sk + EPS_);
      sK[t * 65 + lane] = k;
      Y[(size_t)(row0 + t) * 1024 + h * 64 + lane] = f2bf(q * 0.125f);
      DK[(size_t)(row0 + t) * 256 + h * 64 + lane] = f2bf(k);
    }
    if (wid < 2) {
      const int dir = wid, t = dir ? 63 - lane : lane;
      const bf16_t* ba = P + (size_t)(row0 + t) * PN_ + C_DNBA;
      const float beta = sigmoidf_(bf2f(ba[dir * 4 + h]));
      const float xr = bf2f(ba[(2 + dir) * 4 + h]) + p.dn_dt_bias[l * 8 + dir * 4 + h];
      const float sp = fmaxf(xr, 0.f) + log1pf(__expf(-fabsf(xr)));
      const float la = -__expf(p.dn_a_log[l * 8 + dir * 4 + h]) * sp;
      const float g = wave_incl_scan(la, lane);
      sBeta[dir * 64 + lane] = beta; sG[dir * 64 + lane] = g;
      ((float*)(p.ws + OFF_DNG))[((size_t)(dir * 520 + cg) * 4 + h) * 64 + lane] = g;
    }
  }
  __syncthreads();
  const int dir = wid >> 1, role = wid & 1;
  float x[64];
  {
    const int t_l = dir ? 63 - lane : lane;
    const float bsc = sBeta[dir * 64 + lane] * (role == 0 ? __expf(sG[dir * 64 + lane]) : 1.f);
    const float* srcm = role == 0 ? sK : sV;
#pragma unroll
    for (int c = 0; c < 64; ++c) x[c] = srcm[t_l * 65 + c] * bsc;
  }
  {
    const int ti = tid >> 4, si = tid & 15;
    float a[4][4];
#pragma unroll
    for (int i = 0; i < 4; ++i)
#pragma unroll
      for (int j = 0; j < 4; ++j) a[i][j] = 0.f;
#pragma unroll 2
    for (int d = 0; d < 64; ++d) {
      float kt[4], ks[4];
#pragma unroll
      for (int i = 0; i < 4; ++i) { kt[i] = sK[(ti * 4 + i) * 65 + d]; ks[i] = sK[(si * 4 + i) * 65 + d]; }
#pragma unroll
      for (int i = 0; i < 4; ++i)
#pragma unroll
        for (int j = 0; j < 4; ++j) a[i][j] += kt[i] * ks[j];
    }
#pragma unroll
    for (int i = 0; i < 4; ++i)
#pragma unroll
      for (int j = 0; j < 4; ++j) sKK[(ti * 4 + i) * 65 + si * 4 + j] = a[i][j];
  }
  __syncthreads();
  {
    float* sA0 = sQ; float* sA1 = sK;
    for (int idx = tid; idx < 2 * 4096; idx += 256) {
      const int dd = idx >> 12, i = (idx >> 6) & 63, j = idx & 63;
      const int ti = dd ? 63 - i : i, tj = dd ? 63 - j : j;
      float v = 0.f;
      if (j < i) v = sBeta[dd * 64 + i] * sKK[ti * 65 + tj] * __expf(sG[dd * 64 + i] - sG[dd * 64 + j]);
      (dd ? sA1 : sA0)[i * 65 + j] = v;
    }
  }
  __syncthreads();
  {
    const float* sA = dir ? sK : sQ;
#pragma unroll 1
    for (int j = 0; j < 63; ++j) {
      float a = sA[lane * 65 + j]; a = lane > j ? a : 0.f;
#pragma unroll
      for (int c = 0; c < 64; ++c) { const float xj = __int_as_float(__builtin_amdgcn_readlane(__float_as_int(x[c]), j)); x[c] -= a * xj; }
    }
    const size_t base = ((size_t)(dir * 520 + cg) * 4 + h) * 4096;
    if (role == 0) {
      bf16_t* W = (bf16_t*)(p.ws + OFF_DNW) + base + lane * 64;
#pragma unroll
      for (int i = 0; i < 8; ++i) { uint4 o; o.x = pack2(x[i * 8], x[i * 8 + 1]); o.y = pack2(x[i * 8 + 2], x[i * 8 + 3]); o.z = pack2(x[i * 8 + 4], x[i * 8 + 5]); o.w = pack2(x[i * 8 + 6], x[i * 8 + 7]);
        *(uint4*)(W + i * 8) = o; }
    } else {
      bf16_t* UT = (bf16_t*)(p.ws + OFF_DNUT) + base;
#pragma unroll
      for (int c = 0; c < 64; ++c) UT[c * 64 + lane] = f2bf(x[c]);
    }
  }
  __syncthreads();
}

DEV void hg_prep_item(const Params& p, int l, int cg, int h, char* ldsc) {
  float* sQ = (float*)ldsc;
  float* sK = (float*)(ldsc + 16640);
  float* sC = (float*)(ldsc + 33280);
  float* sT = (float*)(ldsc + 49920);
  const int tid = tid_opaque(), d = tid & 63, part = tid >> 6;
  bf16_t* P = (bf16_t*)(p.ws + OFF_P); bf16_t* Y = (bf16_t*)(p.ws + OFF_XY);
  const int row0 = cg * 64;
#pragma unroll 4
  for (int i = 0; i < 16; ++i) { const int t = part * 16 + i; sQ[t * 65 + d] = 0.125f * bf2f(P[(size_t)(row0 + t) * PN_ + C_HGQ + h * 64 + d]); }
  for (int dir = 0; dir < 2; ++dir) {
    float lbv = 0.f;
    if (l == 1) { const float r0 = p.hg_lb_raw[dir * 256 + h * 64 + d], r1 = p.hg_lb_raw[512 + dir * 256 + h * 64 + d]; lbv = 1.0f / (1.0f + __expf(r0 - r1)); }
    const int fcol = (dir ? C_HGFB : C_HGFF) + h * 64 + d;
    float kk[16], cc[16]; float run = 0.f;
#pragma unroll
    for (int i = 0; i < 16; ++i) {
      const int tau = part * 16 + i, t = dir ? 63 - tau : tau;
      const float raw = bf2f(P[(size_t)(row0 + t) * PN_ + fcol]);
      const float k = (1.f - lbv) * sigmoidf_(-raw);
      kk[i] = k; run += __logf(1.0f - k); cc[i] = run;
    }
    sT[part * 64 + d] = run;
    __syncthreads();
    float offs = 0.f;
    for (int q = 0; q < part; ++q) offs += sT[q * 64 + d];
    const float clast = sT[d] + sT[64 + d] + sT[128 + d] + sT[192 + d];
#pragma unroll
    for (int i = 0; i < 16; ++i) {
      const int tau = part * 16 + i, t = dir ? 63 - tau : tau;
      const float c = cc[i] + offs;
      sK[tau * 65 + d] = kk[i]; sC[tau * 65 + d] = c * LOG2E;
      const float qb = sQ[t * 65 + d] * __expf(c), ke = kk[i] * __expf(clast - c);
      if (dir == 0) P[(size_t)(row0 + t) * PN_ + C_HGQ + h * 64 + d] = f2bf(qb); else Y[(size_t)(row0 + t) * 1024 + 768 + h * 64 + d] = f2bf(qb);
      P[(size_t)(row0 + t) * PN_ + fcol] = f2bf(ke);
    }
    if (part == 0) ((float*)(p.ws + OFF_HGDE))[((size_t)(dir * 520 + cg) * 4 + h) * 64 + d] = __expf(clast);
    __syncthreads();
    {
      const int ti = tid >> 4, si = tid & 15;
      float a[4][4];
#pragma unroll
      for (int i = 0; i < 4; ++i)
#pragma unroll
        for (int j = 0; j < 4; ++j) a[i][j] = 0.f;
      if (si < ti) {
#pragma unroll 2
        for (int dd = 0; dd < 64; ++dd) {
          float qa[4], ca[4], kb[4], cb[4];
#pragma unroll
          for (int i = 0; i < 4; ++i) { const int tau = ti * 4 + i, t = dir ? 63 - tau : tau; qa[i] = sQ[t * 65 + dd]; ca[i] = sC[tau * 65 + dd]; kb[i] = sK[(si * 4 + i) * 65 + dd]; cb[i] = sC[(si * 4 + i) * 65 + dd]; }
          const float cr = ca[0];
          float qe[4], ke[4];
          qe[0] = qa[0];
#pragma unroll
          for (int i = 1; i < 4; ++i) qe[i] = qa[i] * __builtin_amdgcn_exp2f(ca[i] - cr);
#pragma unroll
          for (int j = 0; j < 4; ++j) ke[j] = kb[j] * __builtin_amdgcn_exp2f(cr - cb[j]);
#pragma unroll
          for (int i = 0; i < 4; ++i)
#pragma unroll
            for (int j = 0; j < 4; ++j) a[i][j] += qe[i] * ke[j];
        }
      }
      bf16_t* ATT = (bf16_t*)(p.ws + OFF_HGATT) + ((size_t)(dir * 520 + cg) * 4 + h) * 4096;
      if (si != ti) {
#pragma unroll
        for (int i = 0; i < 4; ++i) { const int tau = ti * 4 + i;
          uint2 o; o.x = pack2(a[i][0], a[i][1]); o.y = pack2(a[i][2], a[i][3]);
          *(uint2*)(ATT + tau * 64 + si * 4) = o; }
      }
      {
        const int dtile = tid >> 4, i = (tid >> 2) & 3, j = tid & 3, tau = dtile * 4 + i, sg = dtile * 4 + j, t = dir ? 63 - tau : tau;
        float s = 0.f;
        if (sg <= tau) {
#pragma unroll 4
          for (int dd = 0; dd < 64; ++dd) s += sQ[t * 65 + dd] * sK[sg * 65 + dd] * __builtin_amdgcn_exp2f(fminf(sC[tau * 65 + dd] - sC[sg * 65 + dd], 0.f));
        }
        ATT[tau * 64 + sg] = f2bf(s);
      }
    }
    __syncthreads();
  }
}

DEV void rope_rows(const Params& p, int rb) {
  bf16_t* P = (bf16_t*)(p.ws + OFF_P);
  const int tid = tid_opaque(), r = rb * 16 + (tid >> 4), v = tid & 15;
  const int tpos = r & 16383, grow = tpos >> 6, gcol = tpos & 63;
  bf16_t* ptr = P + (size_t)r * PN_ + (v < 8 ? C_DFQ : C_DFK) + (v & 7) * 32;
  uint4 u[4];
#pragma unroll
  for (int i = 0; i < 4; ++i) u[i] = *(const uint4*)(ptr + i * 8);
  float xv[32];
#pragma unroll
  for (int i = 0; i < 4; ++i) { xv[i * 8 + 0] = lo_bf(u[i].x); xv[i * 8 + 1] = hi_bf(u[i].x); xv[i * 8 + 2] = lo_bf(u[i].y); xv[i * 8 + 3] = hi_bf(u[i].y);
    xv[i * 8 + 4] = lo_bf(u[i].z); xv[i * 8 + 5] = hi_bf(u[i].z); xv[i * 8 + 6] = lo_bf(u[i].w); xv[i * 8 + 7] = hi_bf(u[i].w); }
  const float inv[8] = {1.0f, 0.31622776601683794f, 0.1f, 0.031622776601683794f, 0.01f, 0.0031622776601683794f, 0.001f, 0.00031622776601683794f};
  float yv[32];
#pragma unroll
  for (int i = 0; i < 8; ++i) {
    float ar = (float)grow * inv[i] * 0.15915494309189535f, ac = (float)gcol * inv[i] * 0.15915494309189535f;
    ar -= floorf(ar); ac -= floorf(ac);
    const float cr = __builtin_amdgcn_cosf(ar), sr = __builtin_amdgcn_sinf(ar), cc = __builtin_amdgcn_cosf(ac), sc = __builtin_amdgcn_sinf(ac);
    yv[i] = xv[i] * cr - xv[i + 8] * sr; yv[i + 8] = xv[i + 8] * cr + xv[i] * sr;
    yv[16 + i] = xv[16 + i] * cc - xv[24 + i] * sc; yv[24 + i] = xv[24 + i] * cc + xv[16 + i] * sc;
  }
#pragma unroll
  for (int i = 0; i < 4; ++i) { uint4 o; o.x = pack2(yv[i * 8], yv[i * 8 + 1]); o.y = pack2(yv[i * 8 + 2], yv[i * 8 + 3]); o.z = pack2(yv[i * 8 + 4], yv[i * 8 + 5]); o.w = pack2(yv[i * 8 + 6], yv[i * 8 + 7]);
    *(uint4*)(ptr + i * 8) = o; }
}

DEV void vt_prep_item(const Params& p, int bh, int t, char* ldsc);
DEV void prep_phase(const Params& p, int l, char* lds) {
  __shared__ int s_pq;
  unsigned* ctr = (unsigned*)(p.ws + OFF_CTRL) + 4 + l;
  const int nitems = 4160 + 2048 + 2080;
  for (;;) {
    if (tid_opaque() == 0) s_pq = (int)atomicAdd(ctr, 1u);
    __syncthreads();
    const int it = s_pq;
    __syncthreads();
    if (it >= nitems) break;
    const int lo = l;
    if (it < 2080) dn_prep_item(p, lo, it >> 2, it & 3, lds);
    else if (it < 4160) hg_prep_item(p, lo, (it - 2080) >> 2, (it - 2080) & 3, lds);
    else if (it < 6208) rope_rows(p, it - 4160);
    else vt_prep_item(p, (it - 6208) / 260, (it - 6208) % 260, lds);
  }
}

DEV void post_phase(const Params& p, int l) {
  const int lane = tid_opaque() & 63, gw = bid_opaque() * 4 + (tid_opaque() >> 6), nw = gridDim.x * 4;
  bf16_t* P = (bf16_t*)(p.ws + OFF_P); bf16_t* Y = (bf16_t*)(p.ws + OFF_XY);
  for (int it = gw; it < 2 * R_; it += nw) {
    const int r = it >> 1, mix = it & 1;
    const int c = lane * 4;
    uint2 uf, ub, ug;
    if (mix == 0) { uf = *(const uint2*)(P + (size_t)r * PN_ + C_DNQ + c); ub = *(const uint2*)(P + (size_t)r * PN_ + C_DNK + c); ug = *(const uint2*)(P + (size_t)r * PN_ + C_DNG + c); }
    else { uf = *(const uint2*)(P + (size_t)r * PN_ + C_HGQ + c); ub = *(const uint2*)(Y + (size_t)r * 1024 + 768 + c); ug = *(const uint2*)(P + (size_t)r * PN_ + C_HGG + c); }
    float o[4] = {lo_bf(uf.x) + lo_bf(ub.x), hi_bf(uf.x) + hi_bf(ub.x), lo_bf(uf.y) + lo_bf(ub.y), hi_bf(uf.y) + hi_bf(ub.y)};
    const float g[4] = {lo_bf(ug.x), hi_bf(ug.x), lo_bf(ug.y), hi_bf(ug.y)};
    float ss = o[0] * o[0] + o[1] * o[1] + o[2] * o[2] + o[3] * o[3];
#pragma unroll
    for (int s = 8; s > 0; s >>= 1) ss += __shfl_xor(ss, s);
    const float rs = rsqrtf(ss * (1.0f / 64.0f) + EPS_);
    const float* nw_ = (mix == 0 ? p.dn_norm_w : p.hg_norm_w) + l * 64 + (c & 63);
    float y[4];
#pragma unroll
    for (int i = 0; i < 4; ++i) y[i] = o[i] * rs * nw_[i] * siluf_(g[i]);
    uint2 ov; ov.x = pack2(y[0], y[1]); ov.y = pack2(y[2], y[3]);
    *(uint2*)(Y + (size_t)r * 1024 + (mix == 0 ? 0 : 768) + c) = ov;
  }
}

DEV bf16x8 pack8(const f32x4& a, const f32x4& b) {
  union { bf16x8 v; unsigned u[4]; } r;
  r.u[0] = pack2(a[0], a[1]); r.u[1] = pack2(a[2], a[3]); r.u[2] = pack2(b[0], b[1]); r.u[3] = pack2(b[2], b[3]);
  return r.v;
}
DEV void vt_tr_store(bf16_t* vt, int off, int key, const uint4& v) {
  vt[(off + 0) * LDT + key] = (bf16_t)(v.x & 0xffffu); vt[(off + 1) * LDT + key] = (bf16_t)(v.x >> 16);
  vt[(off + 2) * LDT + key] = (bf16_t)(v.y & 0xffffu); vt[(off + 3) * LDT + key] = (bf16_t)(v.y >> 16);
  vt[(off + 4) * LDT + key] = (bf16_t)(v.z & 0xffffu); vt[(off + 5) * LDT + key] = (bf16_t)(v.z >> 16);
  vt[(off + 6) * LDT + key] = (bf16_t)(v.w & 0xffffu); vt[(off + 7) * LDT + key] = (bf16_t)(v.w >> 16);
}
DEV void vt_prep_item(const Params& p, int bh, int t, char* ldsc) {
  bf16_t* sT = (bf16_t*)ldsc;
  const int tid = tid_opaque(), b = bh >> 2, h = bh & 3;
  const bf16_t* P = (const bf16_t*)(p.ws + OFF_P);
  const int trow = t < 4 ? LAT_ + b * 256 + t * 64 : b * 16384 + (t - 4) * 64;
  const int lkey = tid >> 3, loff = (tid & 7) * 8;
  const int lkp = lkey < 16 ? ((lkey >> 2) * 8 + (lkey & 3)) : (((lkey - 16) >> 2) * 8 + 4 + (lkey & 3));
  const uint4 v0 = *(const uint4*)(P + (size_t)(trow + lkey) * PN_ + C_DFV + h * 64 + loff);
  const uint4 v1 = *(const uint4*)(P + (size_t)(trow + lkey + 32) * PN_ + C_DFV + h * 64 + loff);
  vt_tr_store(sT, loff, lkp, v0); vt_tr_store(sT, loff, lkp + 32, v1);
  __syncthreads();
  bf16_t* dst = (bf16_t*)(p.ws + OFF_VTG) + ((size_t)bh * 64) * 16640 + (size_t)t * 64;
#pragma unroll
  for (int i = 0; i < 2; ++i) { const int dv = (tid >> 3) + 32 * i; *(uint4*)(dst + (size_t)dv * 16640 + loff) = *(const uint4*)&sT[dv * LDT + loff]; }
  __syncthreads();
}

template <int MODE>
DEV void attn_item(const Params& p, int l, int kind, int b, int h, int qt, char* ldsc) {
  bf16_t* Ks = (bf16_t*)ldsc;
  bf16_t* VT = Ks + 2 * 64 * LDT;
  float* sRpb = (float*)(ldsc + 4 * 64 * LDT * 2);
  const int tid = tid_opaque(), lane = tid & 63, wid = tid >> 6, fr = lane & 15, fq = lane >> 4;
  const bf16_t* P = (const bf16_t*)(p.ws + OFF_P);
  bf16_t* Y = (bf16_t*)(p.ws + OFF_XY);
  const int qcol = (MODE == 0 ? C_DFQ : C_NAQ) + h * 64, kcol = (MODE == 0 ? C_DFK : C_NAK) + h * 64, vcol = (MODE == 0 ? C_DFV : C_NAV) + h * 64;
  const int qrow0 = kind == 0 ? b * 16384 + qt * 64 : LAT_ + b * 256 + qt * 64;
  int nprim = 0, prim_row0 = 0, r_start = 0;
  if (kind == 0) { if (MODE == 0) { nprim = 256; prim_row0 = b * 16384; } else { r_start = qt - 4; r_start = r_start < 0 ? 0 : (r_start > 248 ? 248 : r_start); nprim = 8; prim_row0 = b * 16384 + r_start * 64; } }
  const int ntiles = nprim + 4, ctx_row0 = LAT_ + b * 256;
  float lam = 0.f;
  if (MODE == 0) {
    const float* lp = p.df_lambda + l * 128;
    float a = lane < 32 ? lp[lane] * lp[32 + lane] : 0.f, c = lane < 32 ? lp[64 + lane] * lp[96 + lane] : 0.f;
#pragma unroll
    for (int o = 32; o > 0; o >>= 1) { a += __shfl_xor(a, o); c += __shfl_xor(c, o); }
    lam = __expf(a) - __expf(c) + p.lam_init[l];
  } else {
    for (int i = tid; i < 465; i += 256) sRpb[i] = p.na_rpb[(size_t)(l * 4 + h) * 465 + i];
  }
  const int qrow = qrow0 + wid * 16 + fr;
  const bf16x8 q0 = *(const bf16x8*)(P + (size_t)qrow * PN_ + qcol + fq * 8);
  const bf16x8 q1 = *(const bf16x8*)(P + (size_t)qrow * PN_ + qcol + 32 + fq * 8);
  f32x4 O1[4], O2[4];
#pragma unroll
  for (int i = 0; i < 4; ++i) { O1[i] = (f32x4){0.f, 0.f, 0.f, 0.f}; O2[i] = (f32x4){0.f, 0.f, 0.f, 0.f}; }
  float m1 = -INFINITY, m2 = -INFINITY;
  f32x4 L1 = {0.f, 0.f, 0.f, 0.f}, L2 = {0.f, 0.f, 0.f, 0.f};
  const float sc = (MODE == 0 ? 0.17677669529663687f : 0.125f) * LOG2E;
  const int lkey = tid >> 3, loff = (tid & 7) * 8;
  const bf16_t* vtg = (const bf16_t*)(p.ws + OFF_VTG) + (size_t)(b * 4 + h) * 64 * 16640;
  const int lkp = lkey < 16 ? ((lkey >> 2) * 8 + (lkey & 3)) : (((lkey - 16) >> 2) * 8 + 4 + (lkey & 3));
  uint4 rk0A, rk1A, rv0A, rv1A, rk0B, rk1B, rv0B, rv1B;
#define ATT_GLOAD(it_, S) do { const int trow_ = (it_) < nprim ? prim_row0 + (it_) * 64 : ctx_row0 + ((it_) - nprim) * 64; \
    const bf16_t* s0_ = P + (size_t)(trow_ + lkey) * PN_; const bf16_t* s1_ = P + (size_t)(trow_ + lkey + 32) * PN_; \
    rk0##S = *(const uint4*)(s0_ + kcol + loff); rk1##S = *(const uint4*)(s1_ + kcol + loff); \
    if (MODE == 0) { const int kt_ = (it_) < nprim ? 4 + (it_) : (it_) - nprim; const bf16_t* v_ = vtg + (size_t)lkey * 16640 + kt_ * 64 + loff; \
      rv0##S = *(const uint4*)(v_); rv1##S = *(const uint4*)(v_ + (size_t)32 * 16640); } \
    else { rv0##S = *(const uint4*)(s0_ + vcol + loff); rv1##S = *(const uint4*)(s1_ + vcol + loff); } } while (0)
#define ATT_LSTORE(buf_, S) do { bf16_t* ks_ = Ks + (buf_) * 64 * LDT; bf16_t* vt_ = VT + (buf_) * 64 * LDT; \
    *(uint4*)&ks_[lkey * LDT + loff] = rk0##S; *(uint4*)&ks_[(lkey + 32) * LDT + loff] = rk1##S; \
    if (MODE == 0) { *(uint4*)&vt_[lkey * LDT + loff] = rv0##S; *(uint4*)&vt_[(lkey + 32) * LDT + loff] = rv1##S; } \
    else { vt_tr_store(vt_, loff, lkp, rv0##S); vt_tr_store(vt_, loff, lkp + 32, rv1##S); } } while (0)
  ATT_GLOAD(0, A); __builtin_amdgcn_sched_barrier(0); ATT_GLOAD(1, B); __builtin_amdgcn_sched_barrier(0);
  for (int it0 = 0; it0 < ntiles; it0 += 2) {
#pragma unroll
   for (int half = 0; half < 2; ++half) {
    const int it = it0 + half, buf = half;
    if (half == 0) ATT_LSTORE(0, A); else ATT_LSTORE(1, B);
    __syncthreads();
    { const int itn = (it + 2 < ntiles) ? it + 2 : ntiles - 1; if (half == 0) ATT_GLOAD(itn, A); else ATT_GLOAD(itn, B); }
    __builtin_amdgcn_sched_barrier(0);
    const bf16_t* ks = Ks + buf * 64 * LDT; const bf16_t* vt = VT + buf * 64 * LDT;
    f32x4 s1[4], s2[4];
#pragma unroll
    for (int kt = 0; kt < 4; ++kt) {
      const bf16x8 k0 = *(const bf16x8*)&ks[(kt * 16 + fr) * LDT + fq * 8], k1 = *(const bf16x8*)&ks[(kt * 16 + fr) * LDT + 32 + fq * 8];
      const f32x4 z = {0.f, 0.f, 0.f, 0.f};
      if (MODE == 0) { s1[kt] = mfma16(k0, q0, z); s2[kt] = mfma16(k1, q1, z); }
      else { s1[kt] = mfma16(k1, q1, mfma16(k0, q0, z)); }
    }
    float pre = sc;
    if (MODE == 1 && kind == 0 && it < nprim) {
      const int w = wid * 16 + fr; int cs = w - 8; cs = cs < 0 ? 0 : (cs > 48 ? 48 : cs);
      const float* rp = sRpb + (r_start + it - qt + 7) * 31 + 15 - w;
#pragma unroll
      for (int kt = 0; kt < 4; ++kt)
#pragma unroll
        for (int r = 0; r < 4; ++r) { const int kj = kt * 16 + fq * 4 + r; const bool ok = (kj >= cs) && (kj < cs + 16);
          s1[kt][r] = ok ? s1[kt][r] * sc + rp[ok ? kj : w] * LOG2E : -INFINITY; }
      pre = 1.0f;
    }
    {
      float lm = fmaxf(fmaxf(s1[0][0], s1[0][1]), s1[0][2]);
      lm = fmaxf(fmaxf(lm, s1[0][3]), s1[1][0]); lm = fmaxf(fmaxf(lm, s1[1][1]), s1[1][2]); lm = fmaxf(fmaxf(lm, s1[1][3]), s1[2][0]); lm = fmaxf(fmaxf(lm, s1[2][1]), s1[2][2]);
      lm = fmaxf(fmaxf(lm, s1[2][3]), s1[3][0]); lm = fmaxf(fmaxf(lm, s1[3][1]), s1[3][2]); lm = fmaxf(lm, s1[3][3]);
      lm *= pre;
      if (__any(lm > m1 + 8.0f)) {
        float mx = fmaxf(lm, __shfl_xor(lm, 16)); mx = fmaxf(mx, __shfl_xor(mx, 32));
        const float mn = fmaxf(m1, mx), al = __builtin_amdgcn_exp2f(m1 - mn); m1 = mn;
#pragma unroll
        for (int dt = 0; dt < 4; ++dt) O1[dt] = O1[dt] * al;
        L1 = L1 * al;
      }
      { const f32x2_t pv = {pre, pre}, nm = {-m1, -m1};
#pragma unroll
        for (int kt = 0; kt < 4; ++kt) {
          const f32x2_t a = __builtin_elementwise_fma((f32x2_t){s1[kt][0], s1[kt][1]}, pv, nm), b = __builtin_elementwise_fma((f32x2_t){s1[kt][2], s1[kt][3]}, pv, nm);
          s1[kt][0] = __builtin_amdgcn_exp2f(a.x); s1[kt][1] = __builtin_amdgcn_exp2f(a.y); s1[kt][2] = __builtin_amdgcn_exp2f(b.x); s1[kt][3] = __builtin_amdgcn_exp2f(b.y); } }
    }
    if (MODE == 0) {
      float lm = fmaxf(fmaxf(s2[0][0], s2[0][1]), s2[0][2]);
      lm = fmaxf(fmaxf(lm, s2[0][3]), s2[1][0]); lm = fmaxf(fmaxf(lm, s2[1][1]), s2[1][2]); lm = fmaxf(fmaxf(lm, s2[1][3]), s2[2][0]); lm = fmaxf(fmaxf(lm, s2[2][1]), s2[2][2]);
      lm = fmaxf(fmaxf(lm, s2[2][3]), s2[3][0]); lm = fmaxf(fmaxf(lm, s2[3][1]), s2[3][2]); lm = fmaxf(lm, s2[3][3]);
      lm *= sc;
      if (__any(lm > m2 + 8.0f)) {
        float mx = fmaxf(lm, __shfl_xor(lm, 16)); mx = fmaxf(mx, __shfl_xor(mx, 32));
        const float mn = fmaxf(m2, mx), al = __builtin_amdgcn_exp2f(m2 - mn); m2 = mn;
#pragma unroll
        for (int dt = 0; dt < 4; ++dt) O2[dt] = O2[dt] * al;
        L2 = L2 * al;
      }
      { const f32x2_t pv = {sc, sc}, nm = {-m2, -m2};
#pragma unroll
        for (int kt = 0; kt < 4; ++kt) {
          const f32x2_t a = __builtin_elementwise_fma((f32x2_t){s2[kt][0], s2[kt][1]}, pv, nm), b = __builtin_elementwise_fma((f32x2_t){s2[kt][2], s2[kt][3]}, pv, nm);
          s2[kt][0] = __builtin_amdgcn_exp2f(a.x); s2[kt][1] = __builtin_amdgcn_exp2f(a.y); s2[kt][2] = __builtin_amdgcn_exp2f(b.x); s2[kt][3] = __builtin_amdgcn_exp2f(b.y); } }
    }
    union { bf16x8 v; unsigned u[4]; } ones; ones.u[0] = ones.u[1] = ones.u[2] = ones.u[3] = 0x3f803f80u;
#pragma unroll
    for (int kk = 0; kk < 2; ++kk) {
      const bf16x8 pb1 = pack8(s1[2 * kk], s1[2 * kk + 1]);
      bf16x8 pb2 = pb1; if (MODE == 0) pb2 = pack8(s2[2 * kk], s2[2 * kk + 1]);
      L1 = mfma16(ones.v, pb1, L1);
      if (MODE == 0) L2 = mfma16(ones.v, pb2, L2);
#pragma unroll
      for (int dt = 0; dt < 4; ++dt) {
        const bf16x8 vfv = *(const bf16x8*)&vt[(dt * 16 + fr) * LDT + 32 * kk + fq * 8];
        O1[dt] = mfma16(vfv, pb1, O1[dt]);
        if (MODE == 0) O2[dt] = mfma16(vfv, pb2, O2[dt]);
      }
    }
   }
  }
  const float i1 = 1.0f / L1[0];
  float o[4][4];
  if (MODE == 0) {
    const float i2 = lam / L2[0];
    float ss = 0.f;
#pragma unroll
    for (int dt = 0; dt < 4; ++dt)
#pragma unroll
      for (int r = 0; r < 4; ++r) { o[dt][r] = O1[dt][r] * i1 - O2[dt][r] * i2; ss += o[dt][r] * o[dt][r]; }
    ss += __shfl_xor(ss, 16); ss += __shfl_xor(ss, 32);
    const float rs = rsqrtf(ss * (1.0f / 64.0f) + EPS_) * (1.0f - p.lam_init[l]);
#pragma unroll
    for (int dt = 0; dt < 4; ++dt)
#pragma unroll
      for (int r = 0; r < 4; ++r) o[dt][r] *= rs * p.df_norm_w[l * 64 + dt * 16 + fq * 4 + r];
  } else {
#pragma unroll
    for (int dt = 0; dt < 4; ++dt)
#pragma unroll
      for (int r = 0; r < 4; ++r) o[dt][r] = O1[dt][r] * i1;
  }
  bf16_t* yr = Y + (size_t)qrow * 1024 + (MODE == 0 ? 512 : 256) + h * 64 + fq * 4;
#pragma unroll
  for (int dt = 0; dt < 4; ++dt) { uint2 ov; ov.x = pack2(o[dt][0], o[dt][1]); ov.y = pack2(o[dt][2], o[dt][3]); *(uint2*)(yr + dt * 16) = ov; }
  __syncthreads();
}

struct DnIn { bf16x8 qa[2], ka[2], wa[2], qb[4][2]; uint2 ut[4]; f32x4 gr; float gc[4]; float gl; };
DEV int chain_cg(int b, int dir, int step) {
  if (step < 4) return 512 + b * 4 + (dir ? 3 - step : step);
  const int ci = step - 4; return b * 256 + (dir ? 255 - ci : ci);
}
DEV void dn_load(const Params& p, DnIn& in, int cg, int h, int dir, int wid, int fr, int fq) {
  const bf16_t* Yq = (const bf16_t*)(p.ws + OFF_XY); const bf16_t* DK = (const bf16_t*)(p.ws + OFF_DNK);
  const size_t base = ((size_t)(dir * 520 + cg) * 4 + h);
  const bf16_t* W = (const bf16_t*)(p.ws + OFF_DNW) + base * 4096; const bf16_t* UT = (const bf16_t*)(p.ws + OFF_DNUT) + base * 4096;
  const float* G = (const float*)(p.ws + OFF_DNG) + base * 64;
  const int tau = wid * 16 + fr, row = cg * 64 + (dir ? 63 - tau : tau);
#pragma unroll
  for (int ks = 0; ks < 2; ++ks) {
    in.qa[ks] = *(const bf16x8*)(Yq + (size_t)row * 1024 + h * 64 + ks * 32 + fq * 8);
    in.ka[ks] = *(const bf16x8*)(DK + (size_t)row * 256 + h * 64 + ks * 32 + fq * 8);
    in.wa[ks] = *(const bf16x8*)(W + tau * 64 + ks * 32 + fq * 8);
  }
#pragma unroll
  for (int n = 0; n < 4; ++n) {
    const int t2 = n * 16 + fr, row2 = cg * 64 + (dir ? 63 - t2 : t2);
#pragma unroll
    for (int ks = 0; ks < 2; ++ks) in.qb[n][ks] = *(const bf16x8*)(Yq + (size_t)row2 * 1024 + h * 64 + ks * 32 + fq * 8);
    in.ut[n] = *(const uint2*)(UT + (n * 16 + fr) * 64 + wid * 16 + fq * 4);
    in.gc[n] = G[n * 16 + fr];
  }
  in.gr = *(const f32x4*)(G + wid * 16 + fq * 4);
  in.gl = G[63];
}
DEV void dn_scan_chain(const Params& p, int l, int chain, char* ldsc) {
  bf16_t* ST = (bf16_t*)ldsc; bf16_t* sAt = ST + 64 * LDT; bf16_t* sVT = sAt + 64 * LDT; bf16_t* sVT2 = sVT + 64 * LDT; bf16_t* sKT = sVT2 + 64 * LDT;
  const int tid = tid_opaque(), lane = tid & 63, wid = tid >> 6, fr = lane & 15, fq = lane >> 4;
  const int b = chain >> 3, h = (chain >> 1) & 3, dir = chain & 1;
  bf16_t* P = (bf16_t*)(p.ws + OFF_P);
  const int ocol = (dir ? C_DNK : C_DNQ) + h * 64;
  f32x4 S[4];
#pragma unroll
  for (int n = 0; n < 4; ++n) { S[n] = (f32x4){0.f, 0.f, 0.f, 0.f}; *(uint2*)&ST[(n * 16 + fr) * LDT + wid * 16 + fq * 4] = (uint2){0u, 0u}; }
  DnIn cur; dn_load(p, cur, chain_cg(b, dir, 0), h, dir, wid, fr, fq);
  __syncthreads();
  for (int step = 0; step < 260; ++step) {
    const int cg = chain_cg(b, dir, step);
    DnIn nxt; dn_load(p, nxt, chain_cg(b, dir, step + 1 < 260 ? step + 1 : step), h, dir, wid, fr, fq);
    __builtin_amdgcn_sched_barrier(0);
    const f32x4 z = {0.f, 0.f, 0.f, 0.f};
#pragma unroll
    for (int n = 0; n < 4; ++n) {
      f32x4 a = mfma16(cur.ka[0], cur.qb[n][0], z); a = mfma16(cur.ka[1], cur.qb[n][1], a);
      float v[4];
#pragma unroll
      for (int r = 0; r < 4; ++r) { const int s = wid * 16 + fq * 4 + r, t = n * 16 + fr; v[r] = (s <= t) ? a[r] * __expf(cur.gc[n] - cur.gr[r]) : 0.f; }
      uint2 o; o.x = pack2(v[0], v[1]); o.y = pack2(v[2], v[3]);
      *(uint2*)&sAt[(n * 16 + fr) * LDT + wid * 16 + fq * 4] = o;
    }
    f32x4 o1[4];
#pragma unroll
    for (int n = 0; n < 4; ++n) {
      f32x4 ws = z, qs = z;
#pragma unroll
      for (int ks = 0; ks < 2; ++ks) { const bf16x8 bst = *(const bf16x8*)&ST[(n * 16 + fr) * LDT + ks * 32 + fq * 8]; ws = mfma16(cur.wa[ks], bst, ws); qs = mfma16(cur.qa[ks], bst, qs); }
      const float u[4] = {lo_bf(cur.ut[n].x), hi_bf(cur.ut[n].x), lo_bf(cur.ut[n].y), hi_bf(cur.ut[n].y)};
      float vn[4], vn2[4];
#pragma unroll
      for (int r = 0; r < 4; ++r) { vn[r] = u[r] - ws[r]; vn2[r] = vn[r] * __expf(cur.gl - cur.gr[r]); o1[n][r] = qs[r] * __expf(cur.gr[r]); }
      uint2 a, c; a.x = pack2(vn[0], vn[1]); a.y = pack2(vn[2], vn[3]); c.x = pack2(vn2[0], vn2[1]); c.y = pack2(vn2[2], vn2[3]);
      *(uint2*)&sVT[(n * 16 + fr) * LDT + wid * 16 + fq * 4] = a;
      *(uint2*)&sVT2[(n * 16 + fr) * LDT + wid * 16 + fq * 4] = c;
    }
#pragma unroll
    for (int ks = 0; ks < 2; ++ks)
#pragma unroll
      for (int e = 0; e < 8; ++e) sKT[(ks * 32 + fq * 8 + e) * LDT + wid * 16 + fr] = (bf16_t)cur.ka[ks][e];
    __syncthreads();
    const float egl = __expf(cur.gl);
#pragma unroll
    for (int n = 0; n < 4; ++n) {
      f32x4 av = o1[n], kv = z;
#pragma unroll
      for (int ks = 0; ks < 2; ++ks) {
        const bf16x8 aa = *(const bf16x8*)&sAt[(wid * 16 + fr) * LDT + ks * 32 + fq * 8];
        const bf16x8 ak = *(const bf16x8*)&sKT[(wid * 16 + fr) * LDT + ks * 32 + fq * 8];
        const bf16x8 b1 = *(const bf16x8*)&sVT[(n * 16 + fr) * LDT + ks * 32 + fq * 8];
        const bf16x8 b2 = *(const bf16x8*)&sVT2[(n * 16 + fr) * LDT + ks * 32 + fq * 8];
        av = mfma16(aa, b1, av); kv = mfma16(ak, b2, kv);
      }
#pragma unroll
      for (int r = 0; r < 4; ++r) { const int tau = wid * 16 + fq * 4 + r, row = cg * 64 + (dir ? 63 - tau : tau);
        P[(size_t)row * PN_ + ocol + n * 16 + fr] = f2bf(av[r]); S[n][r] = S[n][r] * egl + kv[r]; }
    }
    __syncthreads();
#pragma unroll
    for (int n = 0; n < 4; ++n) { uint2 o; o.x = pack2(S[n][0], S[n][1]); o.y = pack2(S[n][2], S[n][3]); *(uint2*)&ST[(n * 16 + fr) * LDT + wid * 16 + fq * 4] = o; }
    __syncthreads();
    __builtin_amdgcn_sched_barrier(0);
    cur = nxt;
  }
}

struct HgIn { bf16x8 qa[2], aa[2], ka[2]; uint4 v[2]; f32x4 de; };
DEV void hg_load(const Params& p, HgIn& in, int cg, int h, int dir, int tid) {
  const int lane = tid & 63, wid = tid >> 6, fr = lane & 15, fq = lane >> 4;
  const bf16_t* P = (const bf16_t*)(p.ws + OFF_P); const bf16_t* Y = (const bf16_t*)(p.ws + OFF_XY);
  const size_t base = ((size_t)(dir * 520 + cg) * 4 + h);
  const bf16_t* ATT = (const bf16_t*)(p.ws + OFF_HGATT) + base * 4096;
  const float* DE = (const float*)(p.ws + OFF_HGDE) + base * 64;
  const int tau = wid * 16 + fr, row = cg * 64 + (dir ? 63 - tau : tau);
#pragma unroll
  for (int ks = 0; ks < 2; ++ks) {
    in.qa[ks] = dir ? *(const bf16x8*)(Y + (size_t)row * 1024 + 768 + h * 64 + ks * 32 + fq * 8) : *(const bf16x8*)(P + (size_t)row * PN_ + C_HGQ + h * 64 + ks * 32 + fq * 8);
    in.aa[ks] = *(const bf16x8*)(ATT + tau * 64 + ks * 32 + fq * 8);
    in.ka[ks] = *(const bf16x8*)(P + (size_t)row * PN_ + (dir ? C_HGFB : C_HGFF) + h * 64 + ks * 32 + fq * 8);
  }
#pragma unroll
  for (int i = 0; i < 2; ++i) { const int t2 = (tid >> 3) + 32 * i, row2 = cg * 64 + (dir ? 63 - t2 : t2); in.v[i] = *(const uint4*)(P + (size_t)row2 * PN_ + C_HGI + h * 64 + (tid & 7) * 8); }
  in.de = *(const f32x4*)(DE + wid * 16 + fq * 4);
}
DEV void hg_stage(const HgIn& in, bf16_t* kt, bf16_t* vt, int tid) {
  const int lane = tid & 63, wid = tid >> 6, fr = lane & 15, fq = lane >> 4;
#pragma unroll
  for (int ks = 0; ks < 2; ++ks)
#pragma unroll
    for (int e = 0; e < 8; ++e) kt[(ks * 32 + fq * 8 + e) * LDT + wid * 16 + fr] = (bf16_t)in.ka[ks][e];
  vt_tr_store(vt, (tid & 7) * 8, (tid >> 3), in.v[0]); vt_tr_store(vt, (tid & 7) * 8, (tid >> 3) + 32, in.v[1]);
}
DEV void hg_scan_chain(const Params& p, int l, int chain, char* ldsc) {
  bf16_t* ST = (bf16_t*)ldsc; bf16_t* sVT = ST + 2 * 64 * LDT; bf16_t* sKT = sVT + 2 * 64 * LDT;
  const int tid = tid_opaque(), lane = tid & 63, wid = tid >> 6, fr = lane & 15, fq = lane >> 4;
  const int b = chain >> 3, h = (chain >> 1) & 3, dir = chain & 1;
  bf16_t* P = (bf16_t*)(p.ws + OFF_P); bf16_t* Y = (bf16_t*)(p.ws + OFF_XY);
  f32x4 S[4];
#pragma unroll
  for (int n = 0; n < 4; ++n) { S[n] = (f32x4){0.f, 0.f, 0.f, 0.f}; *(uint2*)&ST[(n * 16 + fr) * LDT + wid * 16 + fq * 4] = (uint2){0u, 0u}; }
  HgIn cur; hg_load(p, cur, chain_cg(b, dir, 0), h, dir, tid);
  hg_stage(cur, sKT, sVT, tid);
  __syncthreads();
  for (int step = 0; step < 260; ++step) {
    const int cg = chain_cg(b, dir, step), bufc = step & 1;
    HgIn nxt; hg_load(p, nxt, chain_cg(b, dir, step + 1 < 260 ? step + 1 : step), h, dir, tid);
    __builtin_amdgcn_sched_barrier(0);
    const bf16_t* st = ST + bufc * 64 * LDT; const bf16_t* vt = sVT + bufc * 64 * LDT; const bf16_t* kt = sKT + bufc * 64 * LDT;
    bf16_t* st2 = ST + (bufc ^ 1) * 64 * LDT;
    const f32x4 z = {0.f, 0.f, 0.f, 0.f};
#pragma unroll
    for (int n = 0; n < 4; ++n) {
      f32x4 o = z, kv = z;
#pragma unroll
      for (int ks = 0; ks < 2; ++ks) {
        const bf16x8 bs = *(const bf16x8*)&st[(n * 16 + fr) * LDT + ks * 32 + fq * 8];
        const bf16x8 bv = *(const bf16x8*)&vt[(n * 16 + fr) * LDT + ks * 32 + fq * 8];
        const bf16x8 ak = *(const bf16x8*)&kt[(wid * 16 + fr) * LDT + ks * 32 + fq * 8];
        o = mfma16(cur.qa[ks], bs, o); o = mfma16(cur.aa[ks], bv, o); kv = mfma16(ak, bv, kv);
      }
#pragma unroll
      for (int r = 0; r < 4; ++r) { const int tau = wid * 16 + fq * 4 + r, row = cg * 64 + (dir ? 63 - tau : tau);
        if (dir) Y[(size_t)row * 1024 + 768 + h * 64 + n * 16 + fr] = f2bf(o[r]); else P[(size_t)row * PN_ + C_HGQ + h * 64 + n * 16 + fr] = f2bf(o[r]);
        S[n][r] = S[n][r] * cur.de[r] + kv[r]; }
      uint2 ov; ov.x = pack2(S[n][0], S[n][1]); ov.y = pack2(S[n][2], S[n][3]);
      *(uint2*)&st2[(n * 16 + fr) * LDT + wid * 16 + fq * 4] = ov;
    }
    hg_stage(nxt, sKT + (bufc ^ 1) * 64 * LDT, sVT + (bufc ^ 1) * 64 * LDT, tid);
    __syncthreads();
    __builtin_amdgcn_sched_barrier(0);
    cur = nxt;
  }
}

DEV void mixer_phase(const Params& p, int l, char* lds) {
  __shared__ int s_item;
  unsigned* ctr = (unsigned*)(p.ws + OFF_CTRL) + l;
  const int n_scan = 32, n_df = 2048 * (1 + EXP_DF2), n_na = 2048, n_ctx = (l == 0) ? 64 : 0;
  const int total = n_scan + n_df + n_na + n_ctx;
  for (;;) {
    if (tid_opaque() == 0) s_item = (int)atomicAdd(ctr, 1u);
    __syncthreads();
    const int it = s_item;
    __syncthreads();
    if (it >= total) break;
    const int lo = l;
    if (it < 16) { dn_scan_chain(p, lo, it, lds);
#if EXP_SCAN2
      __syncthreads(); dn_scan_chain(p, lo, it, lds);
#endif
    }
    else if (it < 32) hg_scan_chain(p, lo, it - 16, lds);
    else if (it < 32 + n_df) { const int a = (it - 32) & 2047; attn_item<0>(p, lo, 0, a >> 10, (a >> 8) & 3, a & 255, lds); }
    else if (it < 32 + n_df + n_na) { const int a = it - 32 - n_df; attn_item<1>(p, lo, 0, a >> 10, (a >> 8) & 3, a & 255, lds); }
    else { const int a = it - 32 - n_df - n_na; const int md = a >> 5, bb = (a >> 4) & 1, hh = (a >> 2) & 3, qt = a & 3;
      if (md == 0) attn_item<0>(p, lo, 1, bb, hh, qt, lds); else attn_item<1>(p, lo, 1, bb, hh, qt, lds); }
  }
}

DEV void final_phase(const Params& p) {
  const int lane = tid_opaque() & 63, gw = bid_opaque() * 4 + (tid_opaque() >> 6), nw = gridDim.x * 4;
  for (int r = gw; r < LAT_; r += nw) {
    float4* xr = (float4*)(p.out + (size_t)r * 1024);
    float4 v[4]; float ss = 0.f;
#pragma unroll
    for (int i = 0; i < 4; ++i) { v[i] = xr[lane + 64 * i]; ss += v[i].x * v[i].x + v[i].y * v[i].y + v[i].z * v[i].z + v[i].w * v[i].w; }
#pragma unroll
    for (int o = 32; o > 0; o >>= 1) ss += __shfl_xor(ss, o);
    const float rs = rsqrtf(ss * (1.0f / 1024.0f) + EPS_);
#pragma unroll
    for (int i = 0; i < 4; ++i) { const float4 w4 = *(const float4*)(p.final_norm_w + (lane + 64 * i) * 4);
      float4 o4 = {v[i].x * rs * w4.x, v[i].y * rs * w4.y, v[i].z * rs * w4.z, v[i].w * rs * w4.w}; xr[lane + 64 * i] = o4; }
  }
}


#define XB_TMO      128
#define XB_XCNT(j)  (256  + 64 * (j))
#define XB_XSUB(j)  (1280 + 64 * (j))
#define XB_XGEN(j)  (2304 + 64 * (j))
#define XB_TOP      3328
#define XB_TOPGEN   3392
#define XB_SPIN_CAP (1u << 22)
#define LAS __attribute__((address_space(3)))
DEV unsigned xb_ld(unsigned* p)              { return __hip_atomic_load(p, __ATOMIC_RELAXED, __HIP_MEMORY_SCOPE_AGENT); }
DEV unsigned xb_add(unsigned* p, unsigned v) { return __hip_atomic_fetch_add(p, v, __ATOMIC_RELAXED, __HIP_MEMORY_SCOPE_AGENT); }
DEV unsigned xb_xcc_id() { return (unsigned)__builtin_amdgcn_s_getreg((3 << 11) | 20) & 0xFu; }
#define XB_SPIN(cond, bar) do { unsigned _sp = 0; while (cond) { __builtin_amdgcn_s_sleep(1); \
    if ((++_sp & 255u) == 0u) { if (xb_ld(&(bar)[XB_TMO])) break; if (_sp > XB_SPIN_CAP) { atomicAdd(&(bar)[XB_TMO], 1u); break; } } } } while (0)
struct XcdBarrier { unsigned* bar; unsigned x; volatile LAS unsigned* st; };
DEV XcdBarrier xcd_barrier_post(unsigned* bar, volatile LAS unsigned* st) {
  XcdBarrier b; b.bar = bar; b.x = xb_xcc_id(); b.st = st;
  if (threadIdx.x == 0) (void)xb_add(&bar[XB_XCNT(b.x)], 1u);
  return b;
}
DEV void xcd_barrier_complete(unsigned* bar, unsigned x, unsigned& nloc, unsigned& nx) {
  const unsigned G = gridDim.x * gridDim.y * gridDim.z;
  unsigned sum, cnt, mine, sp = 0u;
  for (;;) {
    sum = 0u; cnt = 0u; mine = 0u;
#pragma unroll
    for (unsigned j = 0; j < 16; ++j) { const unsigned c = xb_ld(&bar[XB_XCNT(j)]); sum += c; cnt += (c > 0u) ? 1u : 0u; mine = (j == x) ? c : mine; }
    if (sum == G) break;
    __builtin_amdgcn_s_sleep(1);
    if ((++sp & 255u) == 0u) { if (xb_ld(&bar[XB_TMO])) break; if (sp > XB_SPIN_CAP) { atomicAdd(&bar[XB_TMO], 1u); break; } }
  }
  nloc = mine > 0u ? mine : 1u; nx = cnt > 0u ? cnt : 1u;
}
DEV void xcd_barrier(const XcdBarrier& b) {
  asm volatile("s_waitcnt vmcnt(0)" ::: "memory");
  __syncthreads();
  if (threadIdx.x == 0) {
    unsigned* bar = b.bar;
    __builtin_amdgcn_s_waitcnt(0);
    unsigned nloc = b.st[0], nx = b.st[1];
    if (nloc == 0u) { xcd_barrier_complete(bar, b.x, nloc, nx); b.st[0] = nloc; b.st[1] = nx; }
    const unsigned old = xb_add(&bar[XB_XSUB(b.x)], 1u);
    const unsigned gen = old / nloc;
    if (old + 1u == (gen + 1u) * nloc) {
      __builtin_amdgcn_fence(__ATOMIC_RELEASE, "agent");
      asm volatile("s_waitcnt vmcnt(0)" ::: "memory");
      const unsigned og = xb_add(&bar[XB_TOP], 1u);
      const unsigned tg = og / nx;
      if (og + 1u == (tg + 1u) * nx) xb_add(&bar[XB_TOPGEN], 1u);
      else XB_SPIN(xb_ld(&bar[XB_TOPGEN]) == tg, bar);
      __builtin_amdgcn_fence(__ATOMIC_ACQUIRE, "agent");
      xb_add(&bar[XB_XGEN(b.x)], 1u);
      asm volatile("s_waitcnt vmcnt(0)" ::: "memory");
    } else {
      XB_SPIN(xb_ld(&bar[XB_XGEN(b.x)]) == gen, bar);
      __builtin_amdgcn_fence(__ATOMIC_ACQUIRE, "agent");
      asm volatile("s_waitcnt vmcnt(0)" ::: "memory");
    }
  }
  __syncthreads();
}

constexpr int LDS_BYTES = 76800;
__global__ void __launch_bounds__(256, 2) mega(Params p) {
  extern __shared__ __attribute__((aligned(16))) char lds[];
  cg::grid_group grid = cg::this_grid();
  __shared__ uint4 xb_words;
  if (threadIdx.x == 0) xb_words = make_uint4(0u, 0u, 0u, 0u);
  __syncthreads();
  const XcdBarrier xb = xcd_barrier_post((unsigned*)(p.ws + OFF_BAR), (volatile LAS unsigned*)&xb_words);
  phase0(p, lds);
  grid.sync();
  for (int l = 0; l < 2; ++l) {
    const char* wb = p.ws + OFF_WB + (size_t)l * WB_LAYER;
    const bf16_t* XY = (const bf16_t*)(p.ws + OFF_XY);
    norm_phase(p, l, 0);
    xcd_barrier(xb);
    { EpiArgs e{l, 0, false}; gemm_phase<0>(p, XY, (const bf16_t*)(wb + WB_IN), 1024, 260, 31, e, lds, l * 4 + 0); }
    xcd_barrier(xb);
#if EXP_IN2
    { EpiArgs e{l, 0, false}; gemm_phase<0>(p, XY, (const bf16_t*)(wb + WB_IN), 1024, 260, 31, e, lds, 8 + l); }
    xcd_barrier(xb);
#endif
    prep_phase(p, l, lds);
    xcd_barrier(xb);
    mixer_phase(p, l, lds);
    xcd_barrier(xb);
    post_phase(p, l);
    xcd_barrier(xb);
    { EpiArgs e{l, 2, l == 0}; gemm_phase<1>(p, XY, (const bf16_t*)(wb + WB_OUT), 1024, 260, 8, e, lds, l * 4 + 1); }
    xcd_barrier(xb);
    norm_phase(p, l, 1);
    xcd_barrier(xb);
    { EpiArgs e{l, 0, false}; gemm_phase<2>(p, XY, (const bf16_t*)(wb + WB_UP), 1024, 265, 44, e, lds, l * 4 + 2); }
    xcd_barrier(xb);
#if EXP_UP2
    { EpiArgs e{l, 0, false}; gemm_phase<2>(p, XY, (const bf16_t*)(wb + WB_UP), 1024, 265, 44, e, lds, l * 4 + 2); }
    xcd_barrier(xb);
#endif
    { EpiArgs e{l, 5, false}; gemm_phase<1>(p, (const bf16_t*)(p.ws + OFF_P), (const bf16_t*)(wb + WB_DOWN), 2816, 260, 8, e, lds, l * 4 + 3); }
    xcd_barrier(xb);
  }
  final_phase(p);
}

extern "C" void kernel_launch(void* const* d_in, const int* in_sizes, int n_in, void* d_out, int out_size, void* d_ws, size_t ws_size, hipStream_t stream) {
  static int grid_blocks = 0;
  if (!grid_blocks) {
    int dev = 0, cus = 0, per_cu = 0;
    hipGetDevice(&dev);
    hipDeviceGetAttribute(&cus, hipDeviceAttributeMultiprocessorCount, dev);
    hipFuncSetAttribute((const void*)mega, hipFuncAttributeMaxDynamicSharedMemorySize, LDS_BYTES);
    hipOccupancyMaxActiveBlocksPerMultiprocessor(&per_cu, mega, 256, LDS_BYTES);
    if (per_cu > 2) per_cu = 2;
    if (per_cu < 1) per_cu = 1;
    grid_blocks = cus * per_cu;
  }
  Params p{};
  const float** f = (const float**)&p;
  for (int i = 0; i < 23; ++i) f[i] = (const float*)d_in[i];
  p.out = (float*)d_out; p.ws = (char*)d_ws;
  p.lam_init[0] = (float)(0.8 - 0.6 * exp(-0.3 * 0.0)); p.lam_init[1] = (float)(0.8 - 0.6 * exp(-0.3 * 1.0));
  p.debug = 0; p.pad = 0;
  if (ws_size < WS_NEED) fprintf(stderr, "workspace too small: %zu < %zu\n", ws_size, (size_t)WS_NEED);
  (void)hipMemsetAsync((char*)d_ws + OFF_BAR, 0, 16384, stream);
  void* args[] = {&p};
  hipError_t e = hipLaunchCooperativeKernel((void*)mega, dim3(grid_blocks), dim3(256), args, LDS_BYTES, stream);
  if (e != hipSuccess) fprintf(stderr, "cooperative launch failed: %s (grid %d)\n", hipGetErrorString(e), grid_blocks);
}
```

```cpp
#include <hip/hip_runtime.h>
#include <hip/hip_cooperative_groups.h>
#include <cstdio>
#include <cstdint>
#include <cmath>
namespace cg = cooperative_groups;
#define EXP_UP2 0
#define EXP_IN2 0
#define EXP_SCAN2 0
#define EXP_DF2 0

typedef unsigned short bf16_t;
typedef short bf16x8 __attribute__((ext_vector_type(8)));
typedef float f32x4 __attribute__((ext_vector_type(4)));
#define DEV __device__ __forceinline__

constexpr int R_ = 33280, LAT_ = 32768, D_ = 1024, PN_ = 3968, PIN_ = 3856, DFF_ = 2816;
constexpr int C_DNQ = 0, C_DNK = 256, C_DNV = 512, C_DNG = 768, C_DNBA = 1024, C_NAQ = 1040, C_NAK = 1296, C_NAV = 1552,
              C_DFQ = 1808, C_DFK = 2064, C_DFV = 2320, C_HGQ = 2576, C_HGI = 2832, C_HGFF = 3088, C_HGFB = 3344, C_HGG = 3600;
constexpr int LDT = 72;
constexpr float EPS_ = 1e-6f;
constexpr float LOG2E = 1.4426950408889634f;

constexpr size_t OFF_CTRL = 0;
constexpr size_t OFF_MOD = 4096;
constexpr size_t OFF_HCTX = OFF_MOD + 2 * 3 * 6144 * 4;
constexpr size_t OFF_WB = OFF_HCTX + 512 * 1024 * 4;
constexpr size_t WB_IN = 0, WB_OUT = (size_t)PN_ * 1024 * 2, WB_UP = WB_OUT + 1024 * 1024 * 2, WB_DOWN = WB_UP + (size_t)5632 * 1024 * 2,
                 WB_LAYER = WB_DOWN + (size_t)1024 * 2816 * 2;
constexpr size_t OFF_XY = OFF_WB + 2 * WB_LAYER;
constexpr size_t OFF_P = OFF_XY + (size_t)R_ * 1024 * 2;
constexpr size_t OFF_DNK = OFF_P + (size_t)R_ * PN_ * 2;
constexpr size_t SZ_CH = (size_t)2 * 520 * 4 * 64 * 64 * 2;
constexpr size_t OFF_DNW = OFF_DNK + (size_t)R_ * 256 * 2;
constexpr size_t OFF_DNUT = OFF_DNW + SZ_CH;
constexpr size_t OFF_HGATT = OFF_DNUT + SZ_CH;
constexpr size_t OFF_DNG = OFF_HGATT + SZ_CH;
constexpr size_t OFF_HGDE = OFF_DNG + (size_t)2 * 520 * 4 * 64 * 4;
constexpr size_t OFF_BAR = OFF_HGDE + (size_t)2 * 520 * 4 * 64 * 4;
constexpr size_t OFF_VTG = OFF_BAR + 16384;
constexpr size_t WS_NEED = OFF_VTG + (size_t)8 * 64 * 16640 * 2;

struct Params {
  const float *x, *c, *ctx, *c_ctx, *w_ada, *b_ada, *norm1_w, *norm2_w, *w_in, *dn_conv_w, *dn_a_log, *dn_dt_bias, *dn_norm_w, *na_rpb,
      *df_lambda, *df_norm_w, *hg_lb_raw, *hg_norm_w, *w_out, *w_up, *ffn_conv_w, *w_down, *final_norm_w;
  float* out; char* ws;
  float lam_init[2]; int debug; int pad;
};

DEV float bf2f(bf16_t h) { return __uint_as_float((unsigned)h << 16); }
typedef __bf16 bf16x2_t __attribute__((ext_vector_type(2)));
typedef float f32x2_t __attribute__((ext_vector_type(2)));
DEV unsigned pack2(float lo, float hi) { f32x2_t f = {lo, hi}; bf16x2_t b = __builtin_convertvector(f, bf16x2_t); return __builtin_bit_cast(unsigned, b); }
DEV bf16_t f2bf(float f) { return (bf16_t)(pack2(f, f) & 0xffffu); }
DEV float lo_bf(unsigned u) { return __uint_as_float(u << 16); }
DEV float hi_bf(unsigned u) { return __uint_as_float(u & 0xffff0000u); }
DEV float sigmoidf_(float x) { return __builtin_amdgcn_rcpf(1.0f + __builtin_amdgcn_exp2f(-LOG2E * x)); }
DEV float siluf_(float x) { return x * __builtin_amdgcn_rcpf(1.0f + __builtin_amdgcn_exp2f(-LOG2E * x)); }
DEV f32x4 mfma16(bf16x8 a, bf16x8 b, f32x4 c) { return __builtin_amdgcn_mfma_f32_16x16x32_bf16(a, b, c, 0, 0, 0); }

DEV int tid_opaque() { int t = threadIdx.x; asm volatile("" : "+v"(t)); return t; }
DEV int bid_opaque() { int t = blockIdx.x; asm volatile("" : "+s"(t)); return t; }
DEV int grp_of(int r) { return r < LAT_ ? (r >> 14) : 2; }
DEV bool seq_first(int r) { return r < LAT_ ? ((r & 16383) == 0) : (((r - LAT_) & 255) == 0); }
DEV bool seq_last(int r) { return r < LAT_ ? ((r & 16383) == 16383) : (((r - LAT_) & 255) == 255); }

DEV void transpose_tile(const float* __restrict__ src, bf16_t* __restrict__ dst, int K, int N, int k0, int n0, int drow0, float* lds) {
  const int tx = tid_opaque() & 63, ty = tid_opaque() >> 6;
#pragma unroll 4
  for (int i = 0; i < 16; ++i) { const int k = ty + 4 * i; lds[k * 65 + tx] = (n0 + tx < N) ? src[(size_t)(k0 + k) * N + n0 + tx] : 0.f; }
  __syncthreads();
#pragma unroll 4
  for (int i = 0; i < 16; ++i) { const int n = ty + 4 * i; dst[(size_t)(drow0 + n) * K + k0 + tx] = f2bf(lds[tx * 65 + n]); }
  __syncthreads();
}

DEV void phase0(const Params& p, char* ldsc) {
  float* lds = (float*)ldsc;
  const int tid = tid_opaque();
  if (bid_opaque() == 0) ((unsigned*)(p.ws + OFF_CTRL))[tid] = 0u;
  constexpr int T_IN = 16 * 62, T_OUT = 256, T_UP = 16 * 88, T_DOWN = 44 * 16, T_L = T_IN + T_OUT + T_UP + T_DOWN;
  const int nitems = 2 * T_L + 192;
  for (int it = bid_opaque(); it < nitems; it += gridDim.x) {
    if (it < 2 * T_L) {
      const int l = it / T_L; int t = it % T_L;
      char* wb = p.ws + OFF_WB + (size_t)l * WB_LAYER;
      if (t < T_IN) { transpose_tile(p.w_in + (size_t)l * 1024 * PIN_, (bf16_t*)(wb + WB_IN), 1024, PIN_, (t % 16) * 64, (t / 16) * 64, (t / 16) * 64, lds); continue; }
      t -= T_IN;
      if (t < T_OUT) { transpose_tile(p.w_out + (size_t)l * 1024 * 1024, (bf16_t*)(wb + WB_OUT), 1024, 1024, (t % 16) * 64, (t / 16) * 64, (t / 16) * 64, lds); continue; }
      t -= T_OUT;
      if (t < T_UP) { const int nt = t / 16; const int drow = nt < 44 ? nt * 128 : (nt - 44) * 128 + 64;
        transpose_tile(p.w_up + (size_t)l * 1024 * 5632, (bf16_t*)(wb + WB_UP), 1024, 5632, (t % 16) * 64, nt * 64, drow, lds); continue; }
      t -= T_UP;
      transpose_tile(p.w_down + (size_t)l * 2816 * 1024, (bf16_t*)(wb + WB_DOWN), 2816, 1024, (t % 44) * 64, (t / 44) * 64, (t / 44) * 64, lds);
    } else {
      const int a = it - 2 * T_L, l = a / 96, cb = a % 96;
      float* sS = lds;
      float* sP = lds + 3072;
      for (int i = tid; i < 3072; i += 256) { const int g = i >> 10, k = i & 1023; const float v = g < 2 ? p.c[g * 1024 + k] : p.c_ctx[k]; sS[i] = siluf_(v); }
      __syncthreads();
      const int col = cb * 64 + (tid & 63), kq = tid >> 6;
      const float* w = p.w_ada + (size_t)l * 1024 * 6144 + col;
      float a0 = 0.f, a1 = 0.f, a2 = 0.f;
#pragma unroll 8
      for (int k = kq * 256; k < kq * 256 + 256; ++k) { const float wv = w[(size_t)k * 6144]; a0 += sS[k] * wv; a1 += sS[1024 + k] * wv; a2 += sS[2048 + k] * wv; }
      sP[(kq * 3 + 0) * 64 + (tid & 63)] = a0; sP[(kq * 3 + 1) * 64 + (tid & 63)] = a1; sP[(kq * 3 + 2) * 64 + (tid & 63)] = a2;
      __syncthreads();
      if (tid < 192) { const int g = tid >> 6, cc = tid & 63; const float s = sP[(0 * 3 + g) * 64 + cc] + sP[(1 * 3 + g) * 64 + cc] + sP[(2 * 3 + g) * 64 + cc] + sP[(3 * 3 + g) * 64 + cc];
        ((float*)(p.ws + OFF_MOD))[(l * 3 + g) * 6144 + cb * 64 + cc] = s + p.b_ada[l * 6144 + cb * 64 + cc]; }
      __syncthreads();
    }
  }
}

DEV const float* xrow_ptr(const Params& p, int r, bool from_input) {
  if (r < LAT_) return (from_input ? p.x : p.out) + (size_t)r * 1024;
  return (from_input ? p.ctx : (const float*)(p.ws + OFF_HCTX)) + (size_t)(r - LAT_) * 1024;
}
DEV void norm_phase(const Params& p, int l, int which) {
  const int lane = tid_opaque() & 63, gw = bid_opaque() * 4 + (tid_opaque() >> 6), nw = gridDim.x * 4;
  const float* nwt = (which == 0 ? p.norm1_w : p.norm2_w) + l * 1024;
  bf16_t* xn = (bf16_t*)(p.ws + OFF_XY);
  for (int r = gw; r < R_; r += nw) {
    const float4* xr = (const float4*)xrow_ptr(p, r, l == 0 && which == 0);
    const float* mod = (const float*)(p.ws + OFF_MOD) + (l * 3 + grp_of(r)) * 6144 + which * 3 * 1024;
    float4 v[4]; float ss = 0.f;
#pragma unroll
    for (int i = 0; i < 4; ++i) { v[i] = xr[lane + 64 * i]; ss += v[i].x * v[i].x + v[i].y * v[i].y + v[i].z * v[i].z + v[i].w * v[i].w; }
#pragma unroll
    for (int o = 32; o > 0; o >>= 1) ss += __shfl_xor(ss, o);
    const float rs = rsqrtf(ss * (1.0f / 1024.0f) + EPS_);
#pragma unroll
    for (int i = 0; i < 4; ++i) {
      const int c = (lane + 64 * i) * 4;
      const float4 w4 = *(const float4*)(nwt + c), sh = *(const float4*)(mod + c), sc = *(const float4*)(mod + 1024 + c);
      const float y0 = v[i].x * rs * w4.x * (1.f + sc.x) + sh.x, y1 = v[i].y * rs * w4.y * (1.f + sc.y) + sh.y;
      const float y2 = v[i].z * rs * w4.z * (1.f + sc.z) + sh.z, y3 = v[i].w * rs * w4.w * (1.f + sc.w) + sh.w;
      uint2 o; o.x = pack2(y0, y1); o.y = pack2(y2, y3);
      *(uint2*)(xn + (size_t)r * 1024 + c) = o;
    }
  }
}

struct EpiArgs { int l; int gi; bool first; };
template <int EPI>
DEV void gemm_tile(const Params& p, const bf16_t* __restrict__ A, const bf16_t* __restrict__ Bt, int K, int arow0, int brow0, int tn, const EpiArgs& e, char* ldsc) {
  bf16_t* As = (bf16_t*)ldsc;
  bf16_t* Bs = As + 2 * 128 * 64;
  const int tid = tid_opaque(), lane = tid & 63, wid = __builtin_amdgcn_readfirstlane(tid >> 6), fr = lane & 15, fq = lane >> 4, wm = wid >> 1, wn = wid & 1;
  const int lr = tid >> 3, lc = (((tid & 7) ^ (lr & 7)) * 8);
  size_t ao0, ao1, ao2, ao3;
  { int r0 = arow0 + lr, r1 = r0 + 32, r2 = r0 + 64, r3 = r0 + 96;
    r0 = r0 < 0 ? 0 : (r0 > R_ - 1 ? R_ - 1 : r0); r1 = r1 < 0 ? 0 : (r1 > R_ - 1 ? R_ - 1 : r1); r2 = r2 < 0 ? 0 : (r2 > R_ - 1 ? R_ - 1 : r2); r3 = r3 < 0 ? 0 : (r3 > R_ - 1 ? R_ - 1 : r3);
    ao0 = (size_t)r0 * K + lc; ao1 = (size_t)r1 * K + lc; ao2 = (size_t)r2 * K + lc; ao3 = (size_t)r3 * K + lc; }
  const bf16_t* bp0 = Bt + (size_t)(brow0 + lr) * K + lc;
  const size_t bstep = (size_t)32 * K;
  f32x4 acc[4][4];
#pragma unroll
  for (int a = 0; a < 4; ++a)
#pragma unroll
    for (int b = 0; b < 4; ++b) acc[a][b] = (f32x4){0.f, 0.f, 0.f, 0.f};
  const int nk = K >> 6;
  char* ldsA = (char*)As + wid * 1024; char* ldsB = (char*)Bs + wid * 1024;
#define GEMM_GLDS(kt_, buf_) do { const int ko_ = (kt_) * 64; char* la_ = ldsA + (buf_) * 16384; char* lb_ = ldsB + (buf_) * 16384; \
    __builtin_amdgcn_global_load_lds((const unsigned*)(A + ao0 + ko_), (unsigned*)(la_), 16, 0, 0); \
    __builtin_amdgcn_global_load_lds((const unsigned*)(A + ao1 + ko_), (unsigned*)(la_ + 4096), 16, 0, 0); \
    __builtin_amdgcn_global_load_lds((const unsigned*)(A + ao2 + ko_), (unsigned*)(la_ + 8192), 16, 0, 0); \
    __builtin_amdgcn_global_load_lds((const unsigned*)(A + ao3 + ko_), (unsigned*)(la_ + 12288), 16, 0, 0); \
    __builtin_amdgcn_global_load_lds((const unsigned*)(bp0 + ko_), (unsigned*)(lb_), 16, 0, 0); \
    __builtin_amdgcn_global_load_lds((const unsigned*)(bp0 + bstep + ko_), (unsigned*)(lb_ + 4096), 16, 0, 0); \
    __builtin_amdgcn_global_load_lds((const unsigned*)(bp0 + 2 * bstep + ko_), (unsigned*)(lb_ + 8192), 16, 0, 0); \
    __builtin_amdgcn_global_load_lds((const unsigned*)(bp0 + 3 * bstep + ko_), (unsigned*)(lb_ + 12288), 16, 0, 0); } while (0)
  GEMM_GLDS(0, 0);
  for (int kt = 0; kt < nk; ++kt) {
   {
    const int buf = kt & 1;
    asm volatile("s_waitcnt vmcnt(0)" ::: "memory");
    __syncthreads();
    if (kt + 1 < nk) GEMM_GLDS(kt + 1, buf ^ 1);
    __builtin_amdgcn_sched_barrier(0);
    const bf16_t* as = As + buf * 128 * 64; const bf16_t* bs = Bs + buf * 128 * 64;
#pragma unroll
    for (int ks = 0; ks < 2; ++ks) {
      bf16x8 af[4], bfr[4];
#pragma unroll
      for (int i = 0; i < 4; ++i) { af[i] = *(const bf16x8*)&as[(wm * 64 + i * 16 + fr) * 64 + (((ks * 4 + fq) ^ (fr & 7)) * 8)]; bfr[i] = *(const bf16x8*)&bs[(wn * 64 + i * 16 + fr) * 64 + (((ks * 4 + fq) ^ (fr & 7)) * 8)]; }
#pragma unroll
      for (int ni = 0; ni < 4; ++ni)
#pragma unroll
        for (int mi = 0; mi < 4; ++mi) acc[ni][mi] = mfma16(bfr[ni], af[mi], acc[ni][mi]);
    }
   }
  }
  __syncthreads();
  if (EPI == 0) {
    bf16_t* P = (bf16_t*)(p.ws + OFF_P);
#pragma unroll
    for (int mi = 0; mi < 4; ++mi) { const size_t row = (size_t)(arow0 + wm * 64 + mi * 16 + fr);
#pragma unroll
      for (int ni = 0; ni < 4; ++ni) { uint2 o; o.x = pack2(acc[ni][mi][0], acc[ni][mi][1]); o.y = pack2(acc[ni][mi][2], acc[ni][mi][3]);
        *(uint2*)(P + row * PN_ + brow0 + wn * 64 + ni * 16 + fq * 4) = o; } }
  } else if (EPI == 1) {
#pragma unroll
    for (int mi = 0; mi < 4; ++mi) { const int row = arow0 + wm * 64 + mi * 16 + fr;
      const float* xin = xrow_ptr(p, row, e.first);
      float* xout = row < LAT_ ? p.out + (size_t)row * 1024 : (float*)(p.ws + OFF_HCTX) + (size_t)(row - LAT_) * 1024;
      const float* gate = (const float*)(p.ws + OFF_MOD) + (e.l * 3 + grp_of(row)) * 6144 + e.gi * 1024;
#pragma unroll
      for (int ni = 0; ni < 4; ++ni) { const int col = brow0 + wn * 64 + ni * 16 + fq * 4;
        const float4 xi = *(const float4*)(xin + col), g = *(const float4*)(gate + col);
        float4 o; o.x = xi.x + g.x * acc[ni][mi][0]; o.y = xi.y + g.y * acc[ni][mi][1]; o.z = xi.z + g.z * acc[ni][mi][2]; o.w = xi.w + g.w * acc[ni][mi][3];
        *(float4*)(xout + col) = o; } }
  } else {
    constexpr int GS = 68;
    float* G = (float*)ldsc;
    float* Vb = (float*)(ldsc + 128 * GS * 4);
    if (wn == 0) {
#pragma unroll
      for (int mi = 0; mi < 4; ++mi)
#pragma unroll
        for (int ni = 0; ni < 4; ++ni) *(f32x4*)&G[(wm * 64 + mi * 16 + fr) * GS + ni * 16 + fq * 4] = acc[ni][mi];
    } else {
#pragma unroll
      for (int mi = 2; mi < 4; ++mi)
#pragma unroll
        for (int ni = 0; ni < 4; ++ni) *(f32x4*)&Vb[(wm * 64 + mi * 16 + fr) * GS + ni * 16 + fq * 4] = acc[ni][mi];
    }
    __syncthreads();
    {
      bf16_t* H = (bf16_t*)(p.ws + OFF_P);
      const float* cw = p.ffn_conv_w + (size_t)e.l * 3 * DFF_ + tn * 64;
#pragma unroll
      for (int mi2 = 0; mi2 < 2; ++mi2) { const int mi = wn == 1 ? mi2 : mi2 + 2; const int m = wm * 64 + mi * 16 + fr, gr = arow0 + m;
        const bool valid = (m >= 1) && (m <= 126) && (gr >= 0) && (gr < R_);
        if (valid) { const bool hasp = !seq_first(gr), hasn = !seq_last(gr);
#pragma unroll
          for (int ni = 0; ni < 4; ++ni) { const int c0 = ni * 16 + fq * 4;
            const f32x4 w0 = *(const f32x4*)(cw + c0), w1 = *(const f32x4*)(cw + DFF_ + c0), w2 = *(const f32x4*)(cw + 2 * DFF_ + c0);
            const f32x4 z4 = {0.f, 0.f, 0.f, 0.f};
            const f32x4 g1 = *(const f32x4*)&G[m * GS + c0];
            const f32x4 g0 = hasp ? *(const f32x4*)&G[(m - 1) * GS + c0] : z4;
            const f32x4 g2 = hasn ? *(const f32x4*)&G[(m + 1) * GS + c0] : z4;
            const f32x4 cv = w1 * g1 + w0 * g0 + w2 * g2;
            f32x4 vv; if (wn == 1) vv = acc[ni][mi2]; else vv = *(const f32x4*)&Vb[m * GS + c0];
            uint2 o; o.x = pack2(siluf_(cv[0]) * vv[0], siluf_(cv[1]) * vv[1]); o.y = pack2(siluf_(cv[2]) * vv[2], siluf_(cv[3]) * vv[3]);
            *(uint2*)(H + (size_t)gr * DFF_ + tn * 64 + c0) = o; } } }
    }
    __syncthreads();
  }
}

DEV unsigned xcc_id() { return (unsigned)__builtin_amdgcn_s_getreg((3 << 11) | 20) & 7u; }
template <int EPI>
DEV void gemm_phase(const Params& p, const bf16_t* A, const bf16_t* Bt, int K, int ntm, int ntn, const EpiArgs& e, char* lds, int gidx) {
  __shared__ int s_q;
  unsigned* ctr = (unsigned*)(p.ws + OFF_CTRL) + 8 + gidx * 8;
  const int x0 = (int)xcc_id(), nig = 8 * ntn;
  for (int xo = 0; xo < 8; ++xo) {
    const int xcd = (x0 + xo) & 7, cnt = (ntm - xcd + 7) >> 3, total = cnt * ntn;
    for (;;) {
      if (tid_opaque() == 0) s_q = (int)atomicAdd(ctr + xcd, 1u);
      __syncthreads();
      const int q = s_q;
      __syncthreads();
      if (q >= total) break;
      const int grp = q / nig, rem = q - grp * nig, fm = grp * 8, gsz = (cnt - fm) < 8 ? (cnt - fm) : 8;
      const int tm = xcd + 8 * (fm + rem % gsz), tn = rem / gsz;
      const int arow0 = (EPI == 2) ? tm * 126 - 1 : tm * 128;
      gemm_tile<EPI>(p, A, Bt, K, arow0, tn * 128, tn, e, lds);
    }
  }
}

DEV float wave_incl_scan(float v, int lane) {
#pragma unroll
  for (int o = 1; o < 64; o <<= 1) { const float t = __shfl_up(v, o); if (lane >= o) v += t; }
  return v;
}
DEV void dn_prep_item(const Params& p, int l, int cg, int h, char* ldsc) {
  bf16_t* sIn = (bf16_t*)ldsc;
  float* sKK = (float*)ldsc;
  float* sQ = (float*)(ldsc + 25344);
  float* sK = (float*)(ldsc + 41984);
  float* sV = (float*)(ldsc + 58624);
  float* sBeta = (float*)(ldsc + 75264);
  float* sG = sBeta + 128;
  const int tid = tid_opaque(), lane = tid & 63, wid = tid >> 6;
  const bf16_t* P = (const bf16_t*)(p.ws + OFF_P);
  const int row0 = cg * 64;
  const bool hasp = !seq_first(row0), hasn = !seq_last(row0 + 63);
  for (int c = tid; c < 66 * 24; c += 256) {
    const int j = c / 24, cc = c % 24, part = cc >> 3, off = (cc & 7) * 8;
    uint4 v = {0u, 0u, 0u, 0u};
    const bool ok = (j == 0) ? hasp : (j == 65 ? hasn : true);
    if (ok) v = *(const uint4*)(P + (size_t)(row0 - 1 + j) * PN_ + part * 256 + h * 64 + off);
    *(uint4*)&sIn[j * 192 + part * 64 + off] = v;
  }
  __syncthreads();
  if (tid < 192) {
    const float* cw = p.dn_conv_w + (size_t)l * 3 * 768;
    const int ch = tid, part = ch >> 6, d = ch & 63, wc = part * 256 + h * 64 + d;
    const float w0 = cw[wc], w1 = cw[768 + wc], w2 = cw[1536 + wc];
    float* dst = part == 0 ? sQ : (part == 1 ? sK : sV);
    float x0 = bf2f(sIn[ch]), x1 = bf2f(sIn[192 + ch]);
#pragma unroll 4
    for (int t = 0; t < 64; ++t) {
      const float x2 = bf2f(sIn[(t + 2) * 192 + ch]);
      dst[t * 65 + d] = siluf_(w0 * x0 + w1 * x1 + w2 * x2);
      x0 = x1; x1 = x2;
    }
  }
  __syncthreads();
  {
    bf16_t* Y = (bf16_t*)(p.ws + OFF_XY); bf16_t* DK = (bf16_t*)(p.ws + OFF_DNK);
    for (int i = 0; i < 16; ++i) {
      const int t = wid * 16 + i;
      float q = sQ[t * 65 + lane], k = sK[t * 65 + lane];
      float sq = q * q, sk = k * k;
#pragma unroll
      for (int o = 32; o > 0; o >>= 1) { sq += __shfl_xor(sq, o); sk += __shfl_xor(sk, o); }
      q *= rsqrtf(sq + EPS_); k *= rsqrtf(sk + EPS_);
      sK[t * 65 + lane] = k;
      Y[(size_t)(row0 + t) * 1024 + h * 64 + lane] = f2bf(q * 0.125f);
      DK[(size_t)(row0 + t) * 256 + h * 64 + lane] = f2bf(k);
    }
    if (wid < 2) {
      const int dir = wid, t = dir ? 63 - lane : lane;
      const bf16_t* ba = P + (size_t)(row0 + t) * PN_ + C_DNBA;
      const float beta = sigmoidf_(bf2f(ba[dir * 4 + h]));
      const float xr = bf2f(ba[(2 + dir) * 4 + h]) + p.dn_dt_bias[l * 8 + dir * 4 + h];
      const float sp = fmaxf(xr, 0.f) + log1pf(__expf(-fabsf(xr)));
      const float la = -__expf(p.dn_a_log[l * 8 + dir * 4 + h]) * sp;
      const float g = wave_incl_scan(la, lane);
      sBeta[dir * 64 + lane] = beta; sG[dir * 64 + lane] = g;
      ((float*)(p.ws + OFF_DNG))[((size_t)(dir * 520 + cg) * 4 + h) * 64 + lane] = g;
    }
  }
  __syncthreads();
  const int dir = wid >> 1, role = wid & 1;
  float x[64];
  {
    const int t_l = dir ? 63 - lane : lane;
    const float bsc = sBeta[dir * 64 + lane] * (role == 0 ? __expf(sG[dir * 64 + lane]) : 1.f);
    const float* srcm = role == 0 ? sK : sV;
#pragma unroll
    for (int c = 0; c < 64; ++c) x[c] = srcm[t_l * 65 + c] * bsc;
  }
  {
    const int ti = tid >> 4, si = tid & 15;
    float a[4][4];
#pragma unroll
    for (int i = 0; i < 4; ++i)
#pragma unroll
      for (int j = 0; j < 4; ++j) a[i][j] = 0.f;
#pragma unroll 2
    for (int d = 0; d < 64; ++d) {
      float kt[4], ks[4];
#pragma unroll
      for (int i = 0; i < 4; ++i) { kt[i] = sK[(ti * 4 + i) * 65 + d]; ks[i] = sK[(si * 4 + i) * 65 + d]; }
#pragma unroll
      for (int i = 0; i < 4; ++i)
#pragma unroll
        for (int j = 0; j < 4; ++j) a[i][j] += kt[i] * ks[j];
    }
#pragma unroll
    for (int i = 0; i < 4; ++i)
#pragma unroll
      for (int j = 0; j < 4; ++j) sKK[(ti * 4 + i) * 65 + si * 4 + j] = a[i][j];
  }
  __syncthreads();
  {
    float* sA0 = sQ; float* sA1 = sK;
    for (int idx = tid; idx < 2 * 4096; idx += 256) {
      const int dd = idx >> 12, i = (idx >> 6) & 63, j = idx & 63;
      const int ti = dd ? 63 - i : i, tj = dd ? 63 - j : j;
      float v = 0.f;
      if (j < i) v = sBeta[dd * 64 + i] * sKK[ti * 65 + tj] * __expf(sG[dd * 64 + i] - sG[dd * 64 + j]);
      (dd ? sA1 : sA0)[i * 65 + j] = v;
    }
  }
  __syncthreads();
  {
    const float* sA = dir ? sK : sQ;
#pragma unroll 1
    for (int j = 0; j < 63; ++j) {
      float a = sA[lane * 65 + j]; a = lane > j ? a : 0.f;
      const f32x2_t na = {-a, -a};
#pragma unroll
      for (int c = 0; c < 64; c += 2) {
        const f32x2_t xj = {__int_as_float(__builtin_amdgcn_readlane(__float_as_int(x[c]), j)), __int_as_float(__builtin_amdgcn_readlane(__float_as_int(x[c + 1]), j))};
        const f32x2_t xv = __builtin_elementwise_fma(na, xj, (f32x2_t){x[c], x[c + 1]});
        x[c] = xv.x; x[c + 1] = xv.y;
      }
    }
    const size_t base = ((size_t)(dir * 520 + cg) * 4 + h) * 4096;
    if (role == 0) {
      bf16_t* W = (bf16_t*)(p.ws + OFF_DNW) + base + lane * 64;
#pragma unroll
      for (int i = 0; i < 8; ++i) { uint4 o; o.x = pack2(x[i * 8], x[i * 8 + 1]); o.y = pack2(x[i * 8 + 2], x[i * 8 + 3]); o.z = pack2(x[i * 8 + 4], x[i * 8 + 5]); o.w = pack2(x[i * 8 + 6], x[i * 8 + 7]);
        *(uint4*)(W + i * 8) = o; }
    } else {
      bf16_t* UT = (bf16_t*)(p.ws + OFF_DNUT) + base;
#pragma unroll
      for (int c = 0; c < 64; ++c) UT[c * 64 + lane] = f2bf(x[c]);
    }
  }
  __syncthreads();
}

DEV void hg_prep_item(const Params& p, int l, int cg, int h, char* ldsc) {
  float* sQ = (float*)ldsc;
  float* sK = (float*)(ldsc + 16640);
  float* sC = (float*)(ldsc + 33280);
  float* sT = (float*)(ldsc + 49920);
  const int tid = tid_opaque(), d = tid & 63, part = tid >> 6;
  bf16_t* P = (bf16_t*)(p.ws + OFF_P); bf16_t* Y = (bf16_t*)(p.ws + OFF_XY);
  const int row0 = cg * 64;
#pragma unroll 4
  for (int i = 0; i < 16; ++i) { const int t = part * 16 + i; sQ[t * 65 + d] = 0.125f * bf2f(P[(size_t)(row0 + t) * PN_ + C_HGQ + h * 64 + d]); }
  for (int dir = 0; dir < 2; ++dir) {
    float lbv = 0.f;
    if (l == 1) { const float r0 = p.hg_lb_raw[dir * 256 + h * 64 + d], r1 = p.hg_lb_raw[512 + dir * 256 + h * 64 + d]; lbv = 1.0f / (1.0f + __expf(r0 - r1)); }
    const int fcol = (dir ? C_HGFB : C_HGFF) + h * 64 + d;
    float kk[16], cc[16]; float run = 0.f;
#pragma unroll
    for (int i = 0; i < 16; ++i) {
      const int tau = part * 16 + i, t = dir ? 63 - tau : tau;
      const float raw = bf2f(P[(size_t)(row0 + t) * PN_ + fcol]);
      const float k = (1.f - lbv) * sigmoidf_(-raw);
      kk[i] = k; run += __logf(1.0f - k); cc[i] = run;
    }
    sT[part * 64 + d] = run;
    __syncthreads();
    float offs = 0.f;
    for (int q = 0; q < part; ++q) offs += sT[q * 64 + d];
    const float clast = sT[d] + sT[64 + d] + sT[128 + d] + sT[192 + d];
#pragma unroll
    for (int i = 0; i < 16; ++i) {
      const int tau = part * 16 + i, t = dir ? 63 - tau : tau;
      const float c = cc[i] + offs;
      sK[tau * 65 + d] = kk[i]; sC[tau * 65 + d] = c * LOG2E;
      const float qb = sQ[t * 65 + d] * __expf(c), ke = kk[i] * __expf(clast - c);
      if (dir == 0) P[(size_t)(row0 + t) * PN_ + C_HGQ + h * 64 + d] = f2bf(qb); else Y[(size_t)(row0 + t) * 1024 + 768 + h * 64 + d] = f2bf(qb);
      P[(size_t)(row0 + t) * PN_ + fcol] = f2bf(ke);
    }
    if (part == 0) ((float*)(p.ws + OFF_HGDE))[((size_t)(dir * 520 + cg) * 4 + h) * 64 + d] = __expf(clast);
    __syncthreads();
    {
      const int ti = tid >> 4, si = tid & 15;
      float a[4][4];
#pragma unroll
      for (int i = 0; i < 4; ++i)
#pragma unroll
        for (int j = 0; j < 4; ++j) a[i][j] = 0.f;
      if (si < ti) {
#pragma unroll 2
        for (int dd = 0; dd < 64; ++dd) {
          float qa[4], ca[4], kb[4], cb[4];
#pragma unroll
          for (int i = 0; i < 4; ++i) { const int tau = ti * 4 + i, t = dir ? 63 - tau : tau; qa[i] = sQ[t * 65 + dd]; ca[i] = sC[tau * 65 + dd]; kb[i] = sK[(si * 4 + i) * 65 + dd]; cb[i] = sC[(si * 4 + i) * 65 + dd]; }
          const float cr = ca[0];
          float qe[4], ke[4];
          qe[0] = qa[0];
#pragma unroll
          for (int i = 1; i < 4; ++i) qe[i] = qa[i] * __builtin_amdgcn_exp2f(ca[i] - cr);
#pragma unroll
          for (int j = 0; j < 4; ++j) ke[j] = kb[j] * __builtin_amdgcn_exp2f(cr - cb[j]);
#pragma unroll
          for (int i = 0; i < 4; ++i)
#pragma unroll
            for (int j = 0; j < 4; ++j) a[i][j] += qe[i] * ke[j];
        }
      }
      bf16_t* ATT = (bf16_t*)(p.ws + OFF_HGATT) + ((size_t)(dir * 520 + cg) * 4 + h) * 4096;
      if (si != ti) {
#pragma unroll
        for (int i = 0; i < 4; ++i) { const int tau = ti * 4 + i;
          uint2 o; o.x = pack2(a[i][0], a[i][1]); o.y = pack2(a[i][2], a[i][3]);
          *(uint2*)(ATT + tau * 64 + si * 4) = o; }
      }
      {
        const int dtile = tid >> 4, i = (tid >> 2) & 3, j = tid & 3, tau = dtile * 4 + i, sg = dtile * 4 + j, t = dir ? 63 - tau : tau;
        float s = 0.f;
        if (sg <= tau) {
#pragma unroll 4
          for (int dd = 0; dd < 64; ++dd) s += sQ[t * 65 + dd] * sK[sg * 65 + dd] * __builtin_amdgcn_exp2f(fminf(sC[tau * 65 + dd] - sC[sg * 65 + dd], 0.f));
        }
        ATT[tau * 64 + sg] = f2bf(s);
      }
    }
    __syncthreads();
  }
}

DEV void rope_rows(const Params& p, int rb) {
  bf16_t* P = (bf16_t*)(p.ws + OFF_P);
  const int tid = tid_opaque(), r = rb * 16 + (tid >> 4), v = tid & 15;
  const int tpos = r & 16383, grow = tpos >> 6, gcol = tpos & 63;
  bf16_t* ptr = P + (size_t)r * PN_ + (v < 8 ? C_DFQ : C_DFK) + (v & 7) * 32;
  uint4 u[4];
#pragma unroll
  for (int i = 0; i < 4; ++i) u[i] = *(const uint4*)(ptr + i * 8);
  float xv[32];
#pragma unroll
  for (int i = 0; i < 4; ++i) { xv[i * 8 + 0] = lo_bf(u[i].x); xv[i * 8 + 1] = hi_bf(u[i].x); xv[i * 8 + 2] = lo_bf(u[i].y); xv[i * 8 + 3] = hi_bf(u[i].y);
    xv[i * 8 + 4] = lo_bf(u[i].z); xv[i * 8 + 5] = hi_bf(u[i].z); xv[i * 8 + 6] = lo_bf(u[i].w); xv[i * 8 + 7] = hi_bf(u[i].w); }
  const float inv[8] = {1.0f, 0.31622776601683794f, 0.1f, 0.031622776601683794f, 0.01f, 0.0031622776601683794f, 0.001f, 0.00031622776601683794f};
  float yv[32];
#pragma unroll
  for (int i = 0; i < 8; ++i) {
    float ar = (float)grow * inv[i] * 0.15915494309189535f, ac = (float)gcol * inv[i] * 0.15915494309189535f;
    ar -= floorf(ar); ac -= floorf(ac);
    const float cr = __builtin_amdgcn_cosf(ar), sr = __builtin_amdgcn_sinf(ar), cc = __builtin_amdgcn_cosf(ac), sc = __builtin_amdgcn_sinf(ac);
    yv[i] = xv[i] * cr - xv[i + 8] * sr; yv[i + 8] = xv[i + 8] * cr + xv[i] * sr;
    yv[16 + i] = xv[16 + i] * cc - xv[24 + i] * sc; yv[24 + i] = xv[24 + i] * cc + xv[16 + i] * sc;
  }
#pragma unroll
  for (int i = 0; i < 4; ++i) { uint4 o; o.x = pack2(yv[i * 8], yv[i * 8 + 1]); o.y = pack2(yv[i * 8 + 2], yv[i * 8 + 3]); o.z = pack2(yv[i * 8 + 4], yv[i * 8 + 5]); o.w = pack2(yv[i * 8 + 6], yv[i * 8 + 7]);
    *(uint4*)(ptr + i * 8) = o; }
}

DEV void vt_prep_item(const Params& p, int bh, int t, char* ldsc);
DEV void prep_phase(const Params& p, int l, char* lds) {
  __shared__ int s_pq;
  unsigned* ctr = (unsigned*)(p.ws + OFF_CTRL) + 4 + l;
  const int nitems = 4160 + 2048 + 2080;
  for (;;) {
    if (tid_opaque() == 0) s_pq = (int)atomicAdd(ctr, 1u);
    __syncthreads();
    const int it = s_pq;
    __syncthreads();
    if (it >= nitems) break;
    const int lo = l;
    if (it < 2080) dn_prep_item(p, lo, it >> 2, it & 3, lds);
    else if (it < 4160) hg_prep_item(p, lo, (it - 2080) >> 2, (it - 2080) & 3, lds);
    else if (it < 6208) rope_rows(p, it - 4160);
    else vt_prep_item(p, (it - 6208) / 260, (it - 6208) % 260, lds);
  }
}

DEV void post_phase(const Params& p, int l) {
  const int lane = tid_opaque() & 63, gw = bid_opaque() * 4 + (tid_opaque() >> 6), nw = gridDim.x * 4;
  bf16_t* P = (bf16_t*)(p.ws + OFF_P); bf16_t* Y = (bf16_t*)(p.ws + OFF_XY);
  for (int it = gw; it < 2 * R_; it += nw) {
    const int r = it >> 1, mix = it & 1;
    const int c = lane * 4;
    uint2 uf, ub, ug;
    if (mix == 0) { uf = *(const uint2*)(P + (size_t)r * PN_ + C_DNQ + c); ub = *(const uint2*)(P + (size_t)r * PN_ + C_DNK + c); ug = *(const uint2*)(P + (size_t)r * PN_ + C_DNG + c); }
    else { uf = *(const uint2*)(P + (size_t)r * PN_ + C_HGQ + c); ub = *(const uint2*)(Y + (size_t)r * 1024 + 768 + c); ug = *(const uint2*)(P + (size_t)r * PN_ + C_HGG + c); }
    float o[4] = {lo_bf(uf.x) + lo_bf(ub.x), hi_bf(uf.x) + hi_bf(ub.x), lo_bf(uf.y) + lo_bf(ub.y), hi_bf(uf.y) + hi_bf(ub.y)};
    const float g[4] = {lo_bf(ug.x), hi_bf(ug.x), lo_bf(ug.y), hi_bf(ug.y)};
    float ss = o[0] * o[0] + o[1] * o[1] + o[2] * o[2] + o[3] * o[3];
#pragma unroll
    for (int s = 8; s > 0; s >>= 1) ss += __shfl_xor(ss, s);
    const float rs = rsqrtf(ss * (1.0f / 64.0f) + EPS_);
    const float* nw_ = (mix == 0 ? p.dn_norm_w : p.hg_norm_w) + l * 64 + (c & 63);
    float y[4];
#pragma unroll
    for (int i = 0; i < 4; ++i) y[i] = o[i] * rs * nw_[i] * siluf_(g[i]);
    uint2 ov; ov.x = pack2(y[0], y[1]); ov.y = pack2(y[2], y[3]);
    *(uint2*)(Y + (size_t)r * 1024 + (mix == 0 ? 0 : 768) + c) = ov;
  }
}

DEV bf16x8 pack8(const f32x4& a, const f32x4& b) {
  union { bf16x8 v; unsigned u[4]; } r;
  r.u[0] = pack2(a[0], a[1]); r.u[1] = pack2(a[2], a[3]); r.u[2] = pack2(b[0], b[1]); r.u[3] = pack2(b[2], b[3]);
  return r.v;
}
DEV void vt_tr_store(bf16_t* vt, int off, int key, const uint4& v) {
  vt[(off + 0) * LDT + key] = (bf16_t)(v.x & 0xffffu); vt[(off + 1) * LDT + key] = (bf16_t)(v.x >> 16);
  vt[(off + 2) * LDT + key] = (bf16_t)(v.y & 0xffffu); vt[(off + 3) * LDT + key] = (bf16_t)(v.y >> 16);
  vt[(off + 4) * LDT + key] = (bf16_t)(v.z & 0xffffu); vt[(off + 5) * LDT + key] = (bf16_t)(v.z >> 16);
  vt[(off + 6) * LDT + key] = (bf16_t)(v.w & 0xffffu); vt[(off + 7) * LDT + key] = (bf16_t)(v.w >> 16);
}
DEV void vt_prep_item(const Params& p, int bh, int t, char* ldsc) {
  bf16_t* sT = (bf16_t*)ldsc;
  const int tid = tid_opaque(), b = bh >> 2, h = bh & 3;
  const bf16_t* P = (const bf16_t*)(p.ws + OFF_P);
  const int trow = t < 4 ? LAT_ + b * 256 + t * 64 : b * 16384 + (t - 4) * 64;
  const int lkey = tid >> 3, loff = (tid & 7) * 8;
  const int lkp = lkey < 16 ? ((lkey >> 2) * 8 + (lkey & 3)) : (((lkey - 16) >> 2) * 8 + 4 + (lkey & 3));
  const uint4 v0 = *(const uint4*)(P + (size_t)(trow + lkey) * PN_ + C_DFV + h * 64 + loff);
  const uint4 v1 = *(const uint4*)(P + (size_t)(trow + lkey + 32) * PN_ + C_DFV + h * 64 + loff);
  vt_tr_store(sT, loff, lkp, v0); vt_tr_store(sT, loff, lkp + 32, v1);
  __syncthreads();
  bf16_t* dst = (bf16_t*)(p.ws + OFF_VTG) + ((size_t)bh * 64) * 16640 + (size_t)t * 64;
#pragma unroll
  for (int i = 0; i < 2; ++i) { const int dv = (tid >> 3) + 32 * i; *(uint4*)(dst + (size_t)dv * 16640 + loff) = *(const uint4*)&sT[dv * LDT + loff]; }
  __syncthreads();
}

template <int MODE>
DEV void attn_item(const Params& p, int l, int kind, int b, int h, int qt, char* ldsc) {
  bf16_t* Ks = (bf16_t*)ldsc;
  bf16_t* VT = Ks + 2 * 64 * LDT;
  float* sRpb = (float*)(ldsc + 4 * 64 * LDT * 2);
  const int tid = tid_opaque(), lane = tid & 63, wid = tid >> 6, fr = lane & 15, fq = lane >> 4;
  const bf16_t* P = (const bf16_t*)(p.ws + OFF_P);
  bf16_t* Y = (bf16_t*)(p.ws + OFF_XY);
  const int qcol = (MODE == 0 ? C_DFQ : C_NAQ) + h * 64, kcol = (MODE == 0 ? C_DFK : C_NAK) + h * 64, vcol = (MODE == 0 ? C_DFV : C_NAV) + h * 64;
  const int qrow0 = kind == 0 ? b * 16384 + qt * 64 : LAT_ + b * 256 + qt * 64;
  int nprim = 0, prim_row0 = 0, r_start = 0;
  if (kind == 0) { if (MODE == 0) { nprim = 256; prim_row0 = b * 16384; } else { r_start = qt - 4; r_start = r_start < 0 ? 0 : (r_start > 248 ? 248 : r_start); nprim = 8; prim_row0 = b * 16384 + r_start * 64; } }
  const int ntiles = nprim + 4, ctx_row0 = LAT_ + b * 256;
  float lam = 0.f;
  if (MODE == 0) {
    const float* lp = p.df_lambda + l * 128;
    float a = lane < 32 ? lp[lane] * lp[32 + lane] : 0.f, c = lane < 32 ? lp[64 + lane] * lp[96 + lane] : 0.f;
#pragma unroll
    for (int o = 32; o > 0; o >>= 1) { a += __shfl_xor(a, o); c += __shfl_xor(c, o); }
    lam = __expf(a) - __expf(c) + p.lam_init[l];
  } else {
    for (int i = tid; i < 465; i += 256) sRpb[i] = p.na_rpb[(size_t)(l * 4 + h) * 465 + i];
  }
  const int qrow = qrow0 + wid * 16 + fr;
  const bf16x8 q0 = *(const bf16x8*)(P + (size_t)qrow * PN_ + qcol + fq * 8);
  const bf16x8 q1 = *(const bf16x8*)(P + (size_t)qrow * PN_ + qcol + 32 + fq * 8);
  f32x4 O1[4], O2[4];
#pragma unroll
  for (int i = 0; i < 4; ++i) { O1[i] = (f32x4){0.f, 0.f, 0.f, 0.f}; O2[i] = (f32x4){0.f, 0.f, 0.f, 0.f}; }
  float m1 = -INFINITY, m2 = -INFINITY;
  f32x4 L1 = {0.f, 0.f, 0.f, 0.f}, L2 = {0.f, 0.f, 0.f, 0.f};
  const float sc = (MODE == 0 ? 0.17677669529663687f : 0.125f) * LOG2E;
  const int lkey = tid >> 3, loff = (tid & 7) * 8;
  const bf16_t* vtg = (const bf16_t*)(p.ws + OFF_VTG) + (size_t)(b * 4 + h) * 64 * 16640;
  const int lkp = lkey < 16 ? ((lkey >> 2) * 8 + (lkey & 3)) : (((lkey - 16) >> 2) * 8 + 4 + (lkey & 3));
  uint4 rk0A, rk1A, rv0A, rv1A, rk0B, rk1B, rv0B, rv1B;
#define ATT_GLOAD(it_, S) do { const int trow_ = (it_) < nprim ? prim_row0 + (it_) * 64 : ctx_row0 + ((it_) - nprim) * 64; \
    const bf16_t* s0_ = P + (size_t)(trow_ + lkey) * PN_; const bf16_t* s1_ = P + (size_t)(trow_ + lkey + 32) * PN_; \
    rk0##S = *(const uint4*)(s0_ + kcol + loff); rk1##S = *(const uint4*)(s1_ + kcol + loff); \
    if (MODE == 0) { const int kt_ = (it_) < nprim ? 4 + (it_) : (it_) - nprim; const bf16_t* v_ = vtg + (size_t)lkey * 16640 + kt_ * 64 + loff; \
      rv0##S = *(const uint4*)(v_); rv1##S = *(const uint4*)(v_ + (size_t)32 * 16640); } \
    else { rv0##S = *(const uint4*)(s0_ + vcol + loff); rv1##S = *(const uint4*)(s1_ + vcol + loff); } } while (0)
#define ATT_LSTORE(buf_, S) do { bf16_t* ks_ = Ks + (buf_) * 64 * LDT; bf16_t* vt_ = VT + (buf_) * 64 * LDT; \
    *(uint4*)&ks_[lkey * LDT + loff] = rk0##S; *(uint4*)&ks_[(lkey + 32) * LDT + loff] = rk1##S; \
    if (MODE == 0) { *(uint4*)&vt_[lkey * LDT + loff] = rv0##S; *(uint4*)&vt_[(lkey + 32) * LDT + loff] = rv1##S; } \
    else { vt_tr_store(vt_, loff, lkp, rv0##S); vt_tr_store(vt_, loff, lkp + 32, rv1##S); } } while (0)
  ATT_GLOAD(0, A); __builtin_amdgcn_sched_barrier(0); ATT_GLOAD(1, B); __builtin_amdgcn_sched_barrier(0);
  for (int it0 = 0; it0 < ntiles; it0 += 2) {
#pragma unroll
   for (int half = 0; half < 2; ++half) {
    const int it = it0 + half, buf = half;
    if (half == 0) ATT_LSTORE(0, A); else ATT_LSTORE(1, B);
    __syncthreads();
    { const int itn = (it + 2 < ntiles) ? it + 2 : ntiles - 1; if (half == 0) ATT_GLOAD(itn, A); else ATT_GLOAD(itn, B); }
    __builtin_amdgcn_sched_barrier(0);
    const bf16_t* ks = Ks + buf * 64 * LDT; const bf16_t* vt = VT + buf * 64 * LDT;
    f32x4 s1[4], s2[4];
#pragma unroll
    for (int kt = 0; kt < 4; ++kt) {
      const bf16x8 k0 = *(const bf16x8*)&ks[(kt * 16 + fr) * LDT + fq * 8], k1 = *(const bf16x8*)&ks[(kt * 16 + fr) * LDT + 32 + fq * 8];
      const f32x4 z = {0.f, 0.f, 0.f, 0.f};
      if (MODE == 0) { s1[kt] = mfma16(k0, q0, z); s2[kt] = mfma16(k1, q1, z); }
      else { s1[kt] = mfma16(k1, q1, mfma16(k0, q0, z)); }
    }
    float pre = sc;
    if (MODE == 1 && kind == 0 && it < nprim) {
      const int w = wid * 16 + fr; int cs = w - 8; cs = cs < 0 ? 0 : (cs > 48 ? 48 : cs);
      const float* rp = sRpb + (r_start + it - qt + 7) * 31 + 15 - w;
#pragma unroll
      for (int kt = 0; kt < 4; ++kt)
#pragma unroll
        for (int r = 0; r < 4; ++r) { const int kj = kt * 16 + fq * 4 + r; const bool ok = (kj >= cs) && (kj < cs + 16);
          s1[kt][r] = ok ? s1[kt][r] * sc + rp[ok ? kj : w] * LOG2E : -INFINITY; }
      pre = 1.0f;
    }
    {
      float lm = fmaxf(fmaxf(s1[0][0], s1[0][1]), s1[0][2]);
      lm = fmaxf(fmaxf(lm, s1[0][3]), s1[1][0]); lm = fmaxf(fmaxf(lm, s1[1][1]), s1[1][2]); lm = fmaxf(fmaxf(lm, s1[1][3]), s1[2][0]); lm = fmaxf(fmaxf(lm, s1[2][1]), s1[2][2]);
      lm = fmaxf(fmaxf(lm, s1[2][3]), s1[3][0]); lm = fmaxf(fmaxf(lm, s1[3][1]), s1[3][2]); lm = fmaxf(lm, s1[3][3]);
      lm *= pre;
      if (__any(lm > m1 + 8.0f)) {
        float mx = fmaxf(lm, __shfl_xor(lm, 16)); mx = fmaxf(mx, __shfl_xor(mx, 32));
        const float mn = fmaxf(m1, mx), al = __builtin_amdgcn_exp2f(m1 - mn); m1 = mn;
#pragma unroll
        for (int dt = 0; dt < 4; ++dt) O1[dt] = O1[dt] * al;
        L1 = L1 * al;
      }
      { const f32x2_t pv = {pre, pre}, nm = {-m1, -m1};
#pragma unroll
        for (int kt = 0; kt < 4; ++kt) {
          const f32x2_t a = __builtin_elementwise_fma((f32x2_t){s1[kt][0], s1[kt][1]}, pv, nm), b = __builtin_elementwise_fma((f32x2_t){s1[kt][2], s1[kt][3]}, pv, nm);
          s1[kt][0] = __builtin_amdgcn_exp2f(a.x); s1[kt][1] = __builtin_amdgcn_exp2f(a.y); s1[kt][2] = __builtin_amdgcn_exp2f(b.x); s1[kt][3] = __builtin_amdgcn_exp2f(b.y); } }
    }
    if (MODE == 0) {
      float lm = fmaxf(fmaxf(s2[0][0], s2[0][1]), s2[0][2]);
      lm = fmaxf(fmaxf(lm, s2[0][3]), s2[1][0]); lm = fmaxf(fmaxf(lm, s2[1][1]), s2[1][2]); lm = fmaxf(fmaxf(lm, s2[1][3]), s2[2][0]); lm = fmaxf(fmaxf(lm, s2[2][1]), s2[2][2]);
      lm = fmaxf(fmaxf(lm, s2[2][3]), s2[3][0]); lm = fmaxf(fmaxf(lm, s2[3][1]), s2[3][2]); lm = fmaxf(lm, s2[3][3]);
      lm *= sc;
      if (__any(lm > m2 + 8.0f)) {
        float mx = fmaxf(lm, __shfl_xor(lm, 16)); mx = fmaxf(mx, __shfl_xor(mx, 32));
        const float mn = fmaxf(m2, mx), al = __builtin_amdgcn_exp2f(m2 - mn); m2 = mn;
#pragma unroll
        for (int dt = 0; dt < 4; ++dt) O2[dt] = O2[dt] * al;
        L2 = L2 * al;
      }
      { const f32x2_t pv = {sc, sc}, nm = {-m2, -m2};
#pragma unroll
        for (int kt = 0; kt < 4; ++kt) {
          const f32x2_t a = __builtin_elementwise_fma((f32x2_t){s2[kt][0], s2[kt][1]}, pv, nm), b = __builtin_elementwise_fma((f32x2_t){s2[kt][2], s2[kt][3]}, pv, nm);
          s2[kt][0] = __builtin_amdgcn_exp2f(a.x); s2[kt][1] = __builtin_amdgcn_exp2f(a.y); s2[kt][2] = __builtin_amdgcn_exp2f(b.x); s2[kt][3] = __builtin_amdgcn_exp2f(b.y); } }
    }
    union { bf16x8 v; unsigned u[4]; } ones; ones.u[0] = ones.u[1] = ones.u[2] = ones.u[3] = 0x3f803f80u;
#pragma unroll
    for (int kk = 0; kk < 2; ++kk) {
      const bf16x8 pb1 = pack8(s1[2 * kk], s1[2 * kk + 1]);
      bf16x8 pb2 = pb1; if (MODE == 0) pb2 = pack8(s2[2 * kk], s2[2 * kk + 1]);
      L1 = mfma16(ones.v, pb1, L1);
      if (MODE == 0) L2 = mfma16(ones.v, pb2, L2);
#pragma unroll
      for (int dt = 0; dt < 4; ++dt) {
        const bf16x8 vfv = *(const bf16x8*)&vt[(dt * 16 + fr) * LDT + 32 * kk + fq * 8];
        O1[dt] = mfma16(vfv, pb1, O1[dt]);
        if (MODE == 0) O2[dt] = mfma16(vfv, pb2, O2[dt]);
      }
    }
   }
  }
  const float i1 = 1.0f / L1[0];
  float o[4][4];
  if (MODE == 0) {
    const float i2 = lam / L2[0];
    float ss = 0.f;
#pragma unroll
    for (int dt = 0; dt < 4; ++dt)
#pragma unroll
      for (int r = 0; r < 4; ++r) { o[dt][r] = O1[dt][r] * i1 - O2[dt][r] * i2; ss += o[dt][r] * o[dt][r]; }
    ss += __shfl_xor(ss, 16); ss += __shfl_xor(ss, 32);
    const float rs = rsqrtf(ss * (1.0f / 64.0f) + EPS_) * (1.0f - p.lam_init[l]);
#pragma unroll
    for (int dt = 0; dt < 4; ++dt)
#pragma unroll
      for (int r = 0; r < 4; ++r) o[dt][r] *= rs * p.df_norm_w[l * 64 + dt * 16 + fq * 4 + r];
  } else {
#pragma unroll
    for (int dt = 0; dt < 4; ++dt)
#pragma unroll
      for (int r = 0; r < 4; ++r) o[dt][r] = O1[dt][r] * i1;
  }
  bf16_t* yr = Y + (size_t)qrow * 1024 + (MODE == 0 ? 512 : 256) + h * 64 + fq * 4;
#pragma unroll
  for (int dt = 0; dt < 4; ++dt) { uint2 ov; ov.x = pack2(o[dt][0], o[dt][1]); ov.y = pack2(o[dt][2], o[dt][3]); *(uint2*)(yr + dt * 16) = ov; }
  __syncthreads();
}

struct DnIn { bf16x8 qa[2], ka[2], wa[2], qb[4][2]; uint2 ut[4]; f32x4 gr; float gc[4]; float gl; };
DEV int chain_cg(int b, int dir, int step) {
  if (step < 4) return 512 + b * 4 + (dir ? 3 - step : step);
  const int ci = step - 4; return b * 256 + (dir ? 255 - ci : ci);
}
DEV void dn_load(const Params& p, DnIn& in, int cg, int h, int dir, int wid, int fr, int fq) {
  const bf16_t* Yq = (const bf16_t*)(p.ws + OFF_XY); const bf16_t* DK = (const bf16_t*)(p.ws + OFF_DNK);
  const size_t base = ((size_t)(dir * 520 + cg) * 4 + h);
  const bf16_t* W = (const bf16_t*)(p.ws + OFF_DNW) + base * 4096; const bf16_t* UT = (const bf16_t*)(p.ws + OFF_DNUT) + base * 4096;
  const float* G = (const float*)(p.ws + OFF_DNG) + base * 64;
  const int tau = wid * 16 + fr, row = cg * 64 + (dir ? 63 - tau : tau);
#pragma unroll
  for (int ks = 0; ks < 2; ++ks) {
    in.qa[ks] = *(const bf16x8*)(Yq + (size_t)row * 1024 + h * 64 + ks * 32 + fq * 8);
    in.ka[ks] = *(const bf16x8*)(DK + (size_t)row * 256 + h * 64 + ks * 32 + fq * 8);
    in.wa[ks] = *(const bf16x8*)(W + tau * 64 + ks * 32 + fq * 8);
  }
#pragma unroll
  for (int n = 0; n < 4; ++n) {
    const int t2 = n * 16 + fr, row2 = cg * 64 + (dir ? 63 - t2 : t2);
#pragma unroll
    for (int ks = 0; ks < 2; ++ks) in.qb[n][ks] = *(const bf16x8*)(Yq + (size_t)row2 * 1024 + h * 64 + ks * 32 + fq * 8);
    in.ut[n] = *(const uint2*)(UT + (n * 16 + fr) * 64 + wid * 16 + fq * 4);
    in.gc[n] = G[n * 16 + fr];
  }
  in.gr = *(const f32x4*)(G + wid * 16 + fq * 4);
  in.gl = G[63];
}
DEV void dn_scan_chain(const Params& p, int l, int chain, char* ldsc) {
  bf16_t* ST = (bf16_t*)ldsc; bf16_t* sAt = ST + 64 * LDT; bf16_t* sVT = sAt + 64 * LDT; bf16_t* sVT2 = sVT + 64 * LDT; bf16_t* sKT = sVT2 + 64 * LDT;
  const int tid = tid_opaque(), lane = tid & 63, wid = tid >> 6, fr = lane & 15, fq = lane >> 4;
  const int b = chain >> 3, h = (chain >> 1) & 3, dir = chain & 1;
  bf16_t* P = (bf16_t*)(p.ws + OFF_P);
  const int ocol = (dir ? C_DNK : C_DNQ) + h * 64;
  f32x4 S[4];
#pragma unroll
  for (int n = 0; n < 4; ++n) { S[n] = (f32x4){0.f, 0.f, 0.f, 0.f}; *(uint2*)&ST[(n * 16 + fr) * LDT + wid * 16 + fq * 4] = (uint2){0u, 0u}; }
  DnIn cur; dn_load(p, cur, chain_cg(b, dir, 0), h, dir, wid, fr, fq);
  __syncthreads();
  for (int step = 0; step < 260; ++step) {
    const int cg = chain_cg(b, dir, step);
    DnIn nxt; dn_load(p, nxt, chain_cg(b, dir, step + 1 < 260 ? step + 1 : step), h, dir, wid, fr, fq);
    __builtin_amdgcn_sched_barrier(0);
    const f32x4 z = {0.f, 0.f, 0.f, 0.f};
#pragma unroll
    for (int n = 0; n < 4; ++n) {
      f32x4 a = mfma16(cur.ka[0], cur.qb[n][0], z); a = mfma16(cur.ka[1], cur.qb[n][1], a);
      float v[4];
#pragma unroll
      for (int r = 0; r < 4; ++r) { const int s = wid * 16 + fq * 4 + r, t = n * 16 + fr; v[r] = (s <= t) ? a[r] * __expf(cur.gc[n] - cur.gr[r]) : 0.f; }
      uint2 o; o.x = pack2(v[0], v[1]); o.y = pack2(v[2], v[3]);
      *(uint2*)&sAt[(n * 16 + fr) * LDT + wid * 16 + fq * 4] = o;
    }
    f32x4 o1[4];
#pragma unroll
    for (int n = 0; n < 4; ++n) {
      f32x4 ws = z, qs = z;
#pragma unroll
      for (int ks = 0; ks < 2; ++ks) { const bf16x8 bst = *(const bf16x8*)&ST[(n * 16 + fr) * LDT + ks * 32 + fq * 8]; ws = mfma16(cur.wa[ks], bst, ws); qs = mfma16(cur.qa[ks], bst, qs); }
      const float u[4] = {lo_bf(cur.ut[n].x), hi_bf(cur.ut[n].x), lo_bf(cur.ut[n].y), hi_bf(cur.ut[n].y)};
      float vn[4], vn2[4];
#pragma unroll
      for (int r = 0; r < 4; ++r) { vn[r] = u[r] - ws[r]; vn2[r] = vn[r] * __expf(cur.gl - cur.gr[r]); o1[n][r] = qs[r] * __expf(cur.gr[r]); }
      uint2 a, c; a.x = pack2(vn[0], vn[1]); a.y = pack2(vn[2], vn[3]); c.x = pack2(vn2[0], vn2[1]); c.y = pack2(vn2[2], vn2[3]);
      *(uint2*)&sVT[(n * 16 + fr) * LDT + wid * 16 + fq * 4] = a;
      *(uint2*)&sVT2[(n * 16 + fr) * LDT + wid * 16 + fq * 4] = c;
    }
#pragma unroll
    for (int ks = 0; ks < 2; ++ks)
#pragma unroll
      for (int e = 0; e < 8; ++e) sKT[(ks * 32 + fq * 8 + e) * LDT + wid * 16 + fr] = (bf16_t)cur.ka[ks][e];
    __syncthreads();
    const float egl = __expf(cur.gl);
#pragma unroll
    for (int n = 0; n < 4; ++n) {
      f32x4 av = o1[n], kv = z;
#pragma unroll
      for (int ks = 0; ks < 2; ++ks) {
        const bf16x8 aa = *(const bf16x8*)&sAt[(wid * 16 + fr) * LDT + ks * 32 + fq * 8];
        const bf16x8 ak = *(const bf16x8*)&sKT[(wid * 16 + fr) * LDT + ks * 32 + fq * 8];
        const bf16x8 b1 = *(const bf16x8*)&sVT[(n * 16 + fr) * LDT + ks * 32 + fq * 8];
        const bf16x8 b2 = *(const bf16x8*)&sVT2[(n * 16 + fr) * LDT + ks * 32 + fq * 8];
        av = mfma16(aa, b1, av); kv = mfma16(ak, b2, kv);
      }
#pragma unroll
      for (int r = 0; r < 4; ++r) { const int tau = wid * 16 + fq * 4 + r, row = cg * 64 + (dir ? 63 - tau : tau);
        P[(size_t)row * PN_ + ocol + n * 16 + fr] = f2bf(av[r]); S[n][r] = S[n][r] * egl + kv[r]; }
    }
    __syncthreads();
#pragma unroll
    for (int n = 0; n < 4; ++n) { uint2 o; o.x = pack2(S[n][0], S[n][1]); o.y = pack2(S[n][2], S[n][3]); *(uint2*)&ST[(n * 16 + fr) * LDT + wid * 16 + fq * 4] = o; }
    __syncthreads();
    __builtin_amdgcn_sched_barrier(0);
    cur = nxt;
  }
}

struct HgIn { bf16x8 qa[2], aa[2], ka[2]; uint4 v[2]; f32x4 de; };
DEV void hg_load(const Params& p, HgIn& in, int cg, int h, int dir, int tid) {
  const int lane = tid & 63, wid = tid >> 6, fr = lane & 15, fq = lane >> 4;
  const bf16_t* P = (const bf16_t*)(p.ws + OFF_P); const bf16_t* Y = (const bf16_t*)(p.ws + OFF_XY);
  const size_t base = ((size_t)(dir * 520 + cg) * 4 + h);
  const bf16_t* ATT = (const bf16_t*)(p.ws + OFF_HGATT) + base * 4096;
  const float* DE = (const float*)(p.ws + OFF_HGDE) + base * 64;
  const int tau = wid * 16 + fr, row = cg * 64 + (dir ? 63 - tau : tau);
#pragma unroll
  for (int ks = 0; ks < 2; ++ks) {
    in.qa[ks] = dir ? *(const bf16x8*)(Y + (size_t)row * 1024 + 768 + h * 64 + ks * 32 + fq * 8) : *(const bf16x8*)(P + (size_t)row * PN_ + C_HGQ + h * 64 + ks * 32 + fq * 8);
    in.aa[ks] = *(const bf16x8*)(ATT + tau * 64 + ks * 32 + fq * 8);
    in.ka[ks] = *(const bf16x8*)(P + (size_t)row * PN_ + (dir ? C_HGFB : C_HGFF) + h * 64 + ks * 32 + fq * 8);
  }
#pragma unroll
  for (int i = 0; i < 2; ++i) { const int t2 = (tid >> 3) + 32 * i, row2 = cg * 64 + (dir ? 63 - t2 : t2); in.v[i] = *(const uint4*)(P + (size_t)row2 * PN_ + C_HGI + h * 64 + (tid & 7) * 8); }
  in.de = *(const f32x4*)(DE + wid * 16 + fq * 4);
}
DEV void hg_stage(const HgIn& in, bf16_t* kt, bf16_t* vt, int tid) {
  const int lane = tid & 63, wid = tid >> 6, fr = lane & 15, fq = lane >> 4;
#pragma unroll
  for (int ks = 0; ks < 2; ++ks)
#pragma unroll
    for (int e = 0; e < 8; ++e) kt[(ks * 32 + fq * 8 + e) * LDT + wid * 16 + fr] = (bf16_t)in.ka[ks][e];
  vt_tr_store(vt, (tid & 7) * 8, (tid >> 3), in.v[0]); vt_tr_store(vt, (tid & 7) * 8, (tid >> 3) + 32, in.v[1]);
}
DEV void hg_scan_chain(const Params& p, int l, int chain, char* ldsc) {
  bf16_t* ST = (bf16_t*)ldsc; bf16_t* sVT = ST + 2 * 64 * LDT; bf16_t* sKT = sVT + 2 * 64 * LDT;
  const int tid = tid_opaque(), lane = tid & 63, wid = tid >> 6, fr = lane & 15, fq = lane >> 4;
  const int b = chain >> 3, h = (chain >> 1) & 3, dir = chain & 1;
  bf16_t* P = (bf16_t*)(p.ws + OFF_P); bf16_t* Y = (bf16_t*)(p.ws + OFF_XY);
  f32x4 S[4];
#pragma unroll
  for (int n = 0; n < 4; ++n) { S[n] = (f32x4){0.f, 0.f, 0.f, 0.f}; *(uint2*)&ST[(n * 16 + fr) * LDT + wid * 16 + fq * 4] = (uint2){0u, 0u}; }
  HgIn cur; hg_load(p, cur, chain_cg(b, dir, 0), h, dir, tid);
  hg_stage(cur, sKT, sVT, tid);
  __syncthreads();
  for (int step = 0; step < 260; ++step) {
    const int cg = chain_cg(b, dir, step), bufc = step & 1;
    HgIn nxt; hg_load(p, nxt, chain_cg(b, dir, step + 1 < 260 ? step + 1 : step), h, dir, tid);
    __builtin_amdgcn_sched_barrier(0);
    const bf16_t* st = ST + bufc * 64 * LDT; const bf16_t* vt = sVT + bufc * 64 * LDT; const bf16_t* kt = sKT + bufc * 64 * LDT;
    bf16_t* st2 = ST + (bufc ^ 1) * 64 * LDT;
    const f32x4 z = {0.f, 0.f, 0.f, 0.f};
#pragma unroll
    for (int n = 0; n < 4; ++n) {
      f32x4 o = z, kv = z;
#pragma unroll
      for (int ks = 0; ks < 2; ++ks) {
        const bf16x8 bs = *(const bf16x8*)&st[(n * 16 + fr) * LDT + ks * 32 + fq * 8];
        const bf16x8 bv = *(const bf16x8*)&vt[(n * 16 + fr) * LDT + ks * 32 + fq * 8];
        const bf16x8 ak = *(const bf16x8*)&kt[(wid * 16 + fr) * LDT + ks * 32 + fq * 8];
        o = mfma16(cur.qa[ks], bs, o); o = mfma16(cur.aa[ks], bv, o); kv = mfma16(ak, bv, kv);
      }
#pragma unroll
      for (int r = 0; r < 4; ++r) { const int tau = wid * 16 + fq * 4 + r, row = cg * 64 + (dir ? 63 - tau : tau);
        if (dir) Y[(size_t)row * 1024 + 768 + h * 64 + n * 16 + fr] = f2bf(o[r]); else P[(size_t)row * PN_ + C_HGQ + h * 64 + n * 16 + fr] = f2bf(o[r]);
        S[n][r] = S[n][r] * cur.de[r] + kv[r]; }
      uint2 ov; ov.x = pack2(S[n][0], S[n][1]); ov.y = pack2(S[n][2], S[n][3]);
      *(uint2*)&st2[(n * 16 + fr) * LDT + wid * 16 + fq * 4] = ov;
    }
    hg_stage(nxt, sKT + (bufc ^ 1) * 64 * LDT, sVT + (bufc ^ 1) * 64 * LDT, tid);
    __syncthreads();
    __builtin_amdgcn_sched_barrier(0);
    cur = nxt;
  }
}

DEV void mixer_phase(const Params& p, int l, char* lds) {
  __shared__ int s_item;
  unsigned* ctr = (unsigned*)(p.ws + OFF_CTRL) + l;
  const int n_scan = 32, n_df = 2048 * (1 + EXP_DF2), n_na = 2048, n_ctx = (l == 0) ? 64 : 0;
  const int total = n_scan + n_df + n_na + n_ctx;
  for (;;) {
    if (tid_opaque() == 0) s_item = (int)atomicAdd(ctr, 1u);
    __syncthreads();
    const int it = s_item;
    __syncthreads();
    if (it >= total) break;
    const int lo = l;
    if (it < 16) { dn_scan_chain(p, lo, it, lds);
#if EXP_SCAN2
      __syncthreads(); dn_scan_chain(p, lo, it, lds);
#endif
    }
    else if (it < 32) hg_scan_chain(p, lo, it - 16, lds);
    else if (it < 32 + n_df) { const int a = (it - 32) & 2047; attn_item<0>(p, lo, 0, a >> 10, (a >> 8) & 3, a & 255, lds); }
    else if (it < 32 + n_df + n_na) { const int a = it - 32 - n_df; attn_item<1>(p, lo, 0, a >> 10, (a >> 8) & 3, a & 255, lds); }
    else { const int a = it - 32 - n_df - n_na; const int md = a >> 5, bb = (a >> 4) & 1, hh = (a >> 2) & 3, qt = a & 3;
      if (md == 0) attn_item<0>(p, lo, 1, bb, hh, qt, lds); else attn_item<1>(p, lo, 1, bb, hh, qt, lds); }
  }
}

DEV void final_phase(const Params& p) {
  const int lane = tid_opaque() & 63, gw = bid_opaque() * 4 + (tid_opaque() >> 6), nw = gridDim.x * 4;
  for (int r = gw; r < LAT_; r += nw) {
    float4* xr = (float4*)(p.out + (size_t)r * 1024);
    float4 v[4]; float ss = 0.f;
#pragma unroll
    for (int i = 0; i < 4; ++i) { v[i] = xr[lane + 64 * i]; ss += v[i].x * v[i].x + v[i].y * v[i].y + v[i].z * v[i].z + v[i].w * v[i].w; }
#pragma unroll
    for (int o = 32; o > 0; o >>= 1) ss += __shfl_xor(ss, o);
    const float rs = rsqrtf(ss * (1.0f / 1024.0f) + EPS_);
#pragma unroll
    for (int i = 0; i < 4; ++i) { const float4 w4 = *(const float4*)(p.final_norm_w + (lane + 64 * i) * 4);
      float4 o4 = {v[i].x * rs * w4.x, v[i].y * rs * w4.y, v[i].z * rs * w4.z, v[i].w * rs * w4.w}; xr[lane + 64 * i] = o4; }
  }
}


#define XB_TMO      128
#define XB_XCNT(j)  (256  + 64 * (j))
#define XB_XSUB(j)  (1280 + 64 * (j))
#define XB_XGEN(j)  (2304 + 64 * (j))
#define XB_TOP      3328
#define XB_TOPGEN   3392
#define XB_SPIN_CAP (1u << 22)
#define LAS __attribute__((address_space(3)))
DEV unsigned xb_ld(unsigned* p)              { return __hip_atomic_load(p, __ATOMIC_RELAXED, __HIP_MEMORY_SCOPE_AGENT); }
DEV unsigned xb_add(unsigned* p, unsigned v) { return __hip_atomic_fetch_add(p, v, __ATOMIC_RELAXED, __HIP_MEMORY_SCOPE_AGENT); }
DEV unsigned xb_xcc_id() { return (unsigned)__builtin_amdgcn_s_getreg((3 << 11) | 20) & 0xFu; }
#define XB_SPIN(cond, bar) do { unsigned _sp = 0; while (cond) { __builtin_amdgcn_s_sleep(1); \
    if ((++_sp & 255u) == 0u) { if (xb_ld(&(bar)[XB_TMO])) break; if (_sp > XB_SPIN_CAP) { atomicAdd(&(bar)[XB_TMO], 1u); break; } } } } while (0)
struct XcdBarrier { unsigned* bar; unsigned x; volatile LAS unsigned* st; };
DEV XcdBarrier xcd_barrier_post(unsigned* bar, volatile LAS unsigned* st) {
  XcdBarrier b; b.bar = bar; b.x = xb_xcc_id(); b.st = st;
  if (threadIdx.x == 0) (void)xb_add(&bar[XB_XCNT(b.x)], 1u);
  return b;
}
DEV void xcd_barrier_complete(unsigned* bar, unsigned x, unsigned& nloc, unsigned& nx) {
  const unsigned G = gridDim.x * gridDim.y * gridDim.z;
  unsigned sum, cnt, mine, sp = 0u;
  for (;;) {
    sum = 0u; cnt = 0u; mine = 0u;
#pragma unroll
    for (unsigned j = 0; j < 16; ++j) { const unsigned c = xb_ld(&bar[XB_XCNT(j)]); sum += c; cnt += (c > 0u) ? 1u : 0u; mine = (j == x) ? c : mine; }
    if (sum == G) break;
    __builtin_amdgcn_s_sleep(1);
    if ((++sp & 255u) == 0u) { if (xb_ld(&bar[XB_TMO])) break; if (sp > XB_SPIN_CAP) { atomicAdd(&bar[XB_TMO], 1u); break; } }
  }
  nloc = mine > 0u ? mine : 1u; nx = cnt > 0u ? cnt : 1u;
}
DEV void xcd_barrier(const XcdBarrier& b) {
  asm volatile("s_waitcnt vmcnt(0)" ::: "memory");
  __syncthreads();
  if (threadIdx.x == 0) {
    unsigned* bar = b.bar;
    __builtin_amdgcn_s_waitcnt(0);
    unsigned nloc = b.st[0], nx = b.st[1];
    if (nloc == 0u) { xcd_barrier_complete(bar, b.x, nloc, nx); b.st[0] = nloc; b.st[1] = nx; }
    const unsigned old = xb_add(&bar[XB_XSUB(b.x)], 1u);
    const unsigned gen = old / nloc;
    if (old + 1u == (gen + 1u) * nloc) {
      __builtin_amdgcn_fence(__ATOMIC_RELEASE, "agent");
      asm volatile("s_waitcnt vmcnt(0)" ::: "memory");
      const unsigned og = xb_add(&bar[XB_TOP], 1u);
      const unsigned tg = og / nx;
      if (og + 1u == (tg + 1u) * nx) xb_add(&bar[XB_TOPGEN], 1u);
      else XB_SPIN(xb_ld(&bar[XB_TOPGEN]) == tg, bar);
      __builtin_amdgcn_fence(__ATOMIC_ACQUIRE, "agent");
      xb_add(&bar[XB_XGEN(b.x)], 1u);
      asm volatile("s_waitcnt vmcnt(0)" ::: "memory");
    } else {
      XB_SPIN(xb_ld(&bar[XB_XGEN(b.x)]) == gen, bar);
      __builtin_amdgcn_fence(__ATOMIC_ACQUIRE, "agent");
      asm volatile("s_waitcnt vmcnt(0)" ::: "memory");
    }
  }
  __syncthreads();
}

constexpr int LDS_BYTES = 76800;
__global__ void __launch_bounds__(256, 2) mega(Params p) {
  extern __shared__ __attribute__((aligned(16))) char lds[];
  cg::grid_group grid = cg::this_grid();
  __shared__ uint4 xb_words;
  if (threadIdx.x == 0) xb_words = make_uint4(0u, 0u, 0u, 0u);
  __syncthreads();
  const XcdBarrier xb = xcd_barrier_post((unsigned*)(p.ws + OFF_BAR), (volatile LAS unsigned*)&xb_words);
  phase0(p, lds);
  grid.sync();
  for (int l = 0; l < 2; ++l) {
    const char* wb = p.ws + OFF_WB + (size_t)l * WB_LAYER;
    const bf16_t* XY = (const bf16_t*)(p.ws + OFF_XY);
    norm_phase(p, l, 0);
    xcd_barrier(xb);
    { EpiArgs e{l, 0, false}; gemm_phase<0>(p, XY, (const bf16_t*)(wb + WB_IN), 1024, 260, 31, e, lds, l * 4 + 0); }
    xcd_barrier(xb);
#if EXP_IN2
    { EpiArgs e{l, 0, false}; gemm_phase<0>(p, XY, (const bf16_t*)(wb + WB_IN), 1024, 260, 31, e, lds, 8 + l); }
    xcd_barrier(xb);
#endif
    prep_phase(p, l, lds);
    xcd_barrier(xb);
    mixer_phase(p, l, lds);
    xcd_barrier(xb);
    post_phase(p, l);
    xcd_barrier(xb);
    { EpiArgs e{l, 2, l == 0}; gemm_phase<1>(p, XY, (const bf16_t*)(wb + WB_OUT), 1024, 260, 8, e, lds, l * 4 + 1); }
    xcd_barrier(xb);
    norm_phase(p, l, 1);
    xcd_barrier(xb);
    { EpiArgs e{l, 0, false}; gemm_phase<2>(p, XY, (const bf16_t*)(wb + WB_UP), 1024, 265, 44, e, lds, l * 4 + 2); }
    xcd_barrier(xb);
#if EXP_UP2
    { EpiArgs e{l, 0, false}; gemm_phase<2>(p, XY, (const bf16_t*)(wb + WB_UP), 1024, 265, 44, e, lds, l * 4 + 2); }
    xcd_barrier(xb);
#endif
    { EpiArgs e{l, 5, false}; gemm_phase<1>(p, (const bf16_t*)(p.ws + OFF_P), (const bf16_t*)(wb + WB_DOWN), 2816, 260, 8, e, lds, l * 4 + 3); }
    xcd_barrier(xb);
  }
  final_phase(p);
}

extern "C" void kernel_launch(void* const* d_in, const int* in_sizes, int n_in, void* d_out, int out_size, void* d_ws, size_t ws_size, hipStream_t stream) {
  static int grid_blocks = 0;
  if (!grid_blocks) {
    int dev = 0, cus = 0, per_cu = 0;
    hipGetDevice(&dev);
    hipDeviceGetAttribute(&cus, hipDeviceAttributeMultiprocessorCount, dev);
    hipFuncSetAttribute((const void*)mega, hipFuncAttributeMaxDynamicSharedMemorySize, LDS_BYTES);
    hipOccupancyMaxActiveBlocksPerMultiprocessor(&per_cu, mega, 256, LDS_BYTES);
    if (per_cu > 2) per_cu = 2;
    if (per_cu < 1) per_cu = 1;
    grid_blocks = cus * per_cu;
  }
  Params p{};
  const float** f = (const float**)&p;
  for (int i = 0; i < 23; ++i) f[i] = (const float*)d_in[i];
  p.out = (float*)d_out; p.ws = (char*)d_ws;
  p.lam_init[0] = (float)(0.8 - 0.6 * exp(-0.3 * 0.0)); p.lam_init[1] = (float)(0.8 - 0.6 * exp(-0.3 * 1.0));
  p.debug = 0; p.pad = 0;
  if (ws_size < WS_NEED) fprintf(stderr, "workspace too small: %zu < %zu\n", ws_size, (size_t)WS_NEED);
  (void)hipMemsetAsync((char*)d_ws + OFF_BAR, 0, 16384, stream);
  void* args[] = {&p};
  hipError_t e = hipLaunchCooperativeKernel((void*)mega, dim3(grid_blocks), dim3(256), args, LDS_BYTES, stream);
  if (e != hipSuccess) fprintf(stderr, "cooperative launch failed: %s (grid %d)\n", hipGetErrorString(e), grid_blocks);
}
```

```cpp
#include <hip/hip_runtime.h>
#include <hip/hip_cooperative_groups.h>
#include <cstdio>
#include <cstdint>
#include <cmath>
namespace cg = cooperative_groups;
#define EXP_UP2 0
#define EXP_IN2 0
#define EXP_SCAN2 0
#define EXP_DF2 0

typedef unsigned short bf16_t;
typedef short bf16x8 __attribute__((ext_vector_type(8)));
typedef float f32x4 __attribute__((ext_vector_type(4)));
#define DEV __device__ __forceinline__

constexpr int R_ = 33280, LAT_ = 32768, D_ = 1024, PN_ = 3968, PIN_ = 3856, DFF_ = 2816;
constexpr int C_DNQ = 0, C_DNK = 256, C_DNV = 512, C_DNG = 768, C_DNBA = 1024, C_NAQ = 1040, C_NAK = 1296, C_NAV = 1552,
              C_DFQ = 1808, C_DFK = 2064, C_DFV = 2320, C_HGQ = 2576, C_HGI = 2832, C_HGFF = 3088, C_HGFB = 3344, C_HGG = 3600;
constexpr int LDT = 72;
constexpr float EPS_ = 1e-6f;
constexpr float LOG2E = 1.4426950408889634f;

constexpr size_t OFF_CTRL = 0;
constexpr size_t OFF_MOD = 4096;
constexpr size_t OFF_HCTX = OFF_MOD + 2 * 3 * 6144 * 4;
constexpr size_t OFF_WB = OFF_HCTX + 512 * 1024 * 4;
constexpr size_t WB_IN = 0, WB_OUT = (size_t)PN_ * 1024 * 2, WB_UP = WB_OUT + 1024 * 1024 * 2, WB_DOWN = WB_UP + (size_t)5632 * 1024 * 2,
                 WB_LAYER = WB_DOWN + (size_t)1024 * 2816 * 2;
constexpr size_t OFF_XY = OFF_WB + 2 * WB_LAYER;
constexpr size_t OFF_P = OFF_XY + (size_t)R_ * 1024 * 2;
constexpr size_t OFF_DNK = OFF_P + (size_t)R_ * PN_ * 2;
constexpr size_t SZ_CH = (size_t)2 * 520 * 4 * 64 * 64 * 2;
constexpr size_t OFF_DNW = OFF_DNK + (size_t)R_ * 256 * 2;
constexpr size_t OFF_DNUT = OFF_DNW + SZ_CH;
constexpr size_t OFF_HGATT = OFF_DNUT + SZ_CH;
constexpr size_t OFF_DNG = OFF_HGATT + SZ_CH;
constexpr size_t OFF_HGDE = OFF_DNG + (size_t)2 * 520 * 4 * 64 * 4;
constexpr size_t OFF_BAR = OFF_HGDE + (size_t)2 * 520 * 4 * 64 * 4;
constexpr size_t OFF_VTG = OFF_BAR + 16384;
constexpr size_t WS_NEED = OFF_VTG + (size_t)8 * 64 * 16640 * 2;

struct Params {
  const float *x, *c, *ctx, *c_ctx, *w_ada, *b_ada, *norm1_w, *norm2_w, *w_in, *dn_conv_w, *dn_a_log, *dn_dt_bias, *dn_norm_w, *na_rpb,
      *df_lambda, *df_norm_w, *hg_lb_raw, *hg_norm_w, *w_out, *w_up, *ffn_conv_w, *w_down, *final_norm_w;
  float* out; char* ws;
  float lam_init[2]; int debug; int pad;
};

DEV float bf2f(bf16_t h) { return __uint_as_float((unsigned)h << 16); }
typedef __bf16 bf16x2_t __attribute__((ext_vector_type(2)));
typedef float f32x2_t __attribute__((ext_vector_type(2)));
DEV unsigned pack2(float lo, float hi) { f32x2_t f = {lo, hi}; bf16x2_t b = __builtin_convertvector(f, bf16x2_t); return __builtin_bit_cast(unsigned, b); }
DEV bf16_t f2bf(float f) { return (bf16_t)(pack2(f, f) & 0xffffu); }
DEV float lo_bf(unsigned u) { return __uint_as_float(u << 16); }
DEV float hi_bf(unsigned u) { return __uint_as_float(u & 0xffff0000u); }
DEV float sigmoidf_(float x) { return __builtin_amdgcn_rcpf(1.0f + __builtin_amdgcn_exp2f(-LOG2E * x)); }
DEV float siluf_(float x) { return x * __builtin_amdgcn_rcpf(1.0f + __builtin_amdgcn_exp2f(-LOG2E * x)); }
DEV f32x4 mfma16(bf16x8 a, bf16x8 b, f32x4 c) { return __builtin_amdgcn_mfma_f32_16x16x32_bf16(a, b, c, 0, 0, 0); }

DEV int tid_opaque() { int t = threadIdx.x; asm volatile("" : "+v"(t)); return t; }
DEV int bid_opaque() { int t = blockIdx.x; asm volatile("" : "+s"(t)); return t; }
DEV int grp_of(int r) { return r < LAT_ ? (r >> 14) : 2; }
DEV bool seq_first(int r) { return r < LAT_ ? ((r & 16383) == 0) : (((r - LAT_) & 255) == 0); }
DEV bool seq_last(int r) { return r < LAT_ ? ((r & 16383) == 16383) : (((r - LAT_) & 255) == 255); }

DEV void transpose_tile(const float* __restrict__ src, bf16_t* __restrict__ dst, int K, int N, int k0, int n0, int drow0, float* lds) {
  const int tx = tid_opaque() & 63, ty = tid_opaque() >> 6;
#pragma unroll 4
  for (int i = 0; i < 16; ++i) { const int k = ty + 4 * i; lds[k * 65 + tx] = (n0 + tx < N) ? src[(size_t)(k0 + k) * N + n0 + tx] : 0.f; }
  __syncthreads();
  {
    const int t = tid_opaque(), kc = (t & 7) * 8;
#pragma unroll
    for (int i = 0; i < 2; ++i) { const int n = (t >> 3) + 32 * i;
      uint4 o; o.x = pack2(lds[(kc + 0) * 65 + n], lds[(kc + 1) * 65 + n]); o.y = pack2(lds[(kc + 2) * 65 + n], lds[(kc + 3) * 65 + n]);
      o.z = pack2(lds[(kc + 4) * 65 + n], lds[(kc + 5) * 65 + n]); o.w = pack2(lds[(kc + 6) * 65 + n], lds[(kc + 7) * 65 + n]);
      *(uint4*)(dst + (size_t)(drow0 + n) * K + k0 + kc) = o; }
  }
  __syncthreads();
}

DEV void phase0(const Params& p, char* ldsc) {
  float* lds = (float*)ldsc;
  const int tid = tid_opaque();
  if (bid_opaque() == 0) ((unsigned*)(p.ws + OFF_CTRL))[tid] = 0u;
  constexpr int T_IN = 16 * 62, T_OUT = 256, T_UP = 16 * 88, T_DOWN = 44 * 16, T_L = T_IN + T_OUT + T_UP + T_DOWN;
  const int nitems = 2 * T_L + 192;
  for (int it = bid_opaque(); it < nitems; it += gridDim.x) {
    if (it < 2 * T_L) {
      const int l = it / T_L; int t = it % T_L;
      char* wb = p.ws + OFF_WB + (size_t)l * WB_LAYER;
      if (t < T_IN) { transpose_tile(p.w_in + (size_t)l * 1024 * PIN_, (bf16_t*)(wb + WB_IN), 1024, PIN_, (t % 16) * 64, (t / 16) * 64, (t / 16) * 64, lds); continue; }
      t -= T_IN;
      if (t < T_OUT) { transpose_tile(p.w_out + (size_t)l * 1024 * 1024, (bf16_t*)(wb + WB_OUT), 1024, 1024, (t % 16) * 64, (t / 16) * 64, (t / 16) * 64, lds); continue; }
      t -= T_OUT;
      if (t < T_UP) { const int nt = t / 16; const int drow = nt < 44 ? nt * 128 : (nt - 44) * 128 + 64;
        transpose_tile(p.w_up + (size_t)l * 1024 * 5632, (bf16_t*)(wb + WB_UP), 1024, 5632, (t % 16) * 64, nt * 64, drow, lds); continue; }
      t -= T_UP;
      transpose_tile(p.w_down + (size_t)l * 2816 * 1024, (bf16_t*)(wb + WB_DOWN), 2816, 1024, (t % 44) * 64, (t / 44) * 64, (t / 44) * 64, lds);
    } else {
      const int a = it - 2 * T_L, l = a / 96, cb = a % 96;
      float* sS = lds;
      float* sP = lds + 3072;
      for (int i = tid; i < 3072; i += 256) { const int g = i >> 10, k = i & 1023; const float v = g < 2 ? p.c[g * 1024 + k] : p.c_ctx[k]; sS[i] = siluf_(v); }
      __syncthreads();
      const int col = cb * 64 + (tid & 63), kq = tid >> 6;
      const float* w = p.w_ada + (size_t)l * 1024 * 6144 + col;
      float a0 = 0.f, a1 = 0.f, a2 = 0.f;
#pragma unroll 8
      for (int k = kq * 256; k < kq * 256 + 256; ++k) { const float wv = w[(size_t)k * 6144]; a0 += sS[k] * wv; a1 += sS[1024 + k] * wv; a2 += sS[2048 + k] * wv; }
      sP[(kq * 3 + 0) * 64 + (tid & 63)] = a0; sP[(kq * 3 + 1) * 64 + (tid & 63)] = a1; sP[(kq * 3 + 2) * 64 + (tid & 63)] = a2;
      __syncthreads();
      if (tid < 192) { const int g = tid >> 6, cc = tid & 63; const float s = sP[(0 * 3 + g) * 64 + cc] + sP[(1 * 3 + g) * 64 + cc] + sP[(2 * 3 + g) * 64 + cc] + sP[(3 * 3 + g) * 64 + cc];
        ((float*)(p.ws + OFF_MOD))[(l * 3 + g) * 6144 + cb * 64 + cc] = s + p.b_ada[l * 6144 + cb * 64 + cc]; }
      __syncthreads();
    }
  }
}

DEV const float* xrow_ptr(const Params& p, int r, bool from_input) {
  if (r < LAT_) return (from_input ? p.x : p.out) + (size_t)r * 1024;
  return (from_input ? p.ctx : (const float*)(p.ws + OFF_HCTX)) + (size_t)(r - LAT_) * 1024;
}
DEV void norm_phase(const Params& p, int l, int which) {
  const int lane = tid_opaque() & 63, gw = bid_opaque() * 4 + (tid_opaque() >> 6), nw = gridDim.x * 4;
  const float* nwt = (which == 0 ? p.norm1_w : p.norm2_w) + l * 1024;
  bf16_t* xn = (bf16_t*)(p.ws + OFF_XY);
  for (int r = gw; r < R_; r += nw) {
    const float4* xr = (const float4*)xrow_ptr(p, r, l == 0 && which == 0);
    const float* mod = (const float*)(p.ws + OFF_MOD) + (l * 3 + grp_of(r)) * 6144 + which * 3 * 1024;
    float4 v[4]; float ss = 0.f;
#pragma unroll
    for (int i = 0; i < 4; ++i) { v[i] = xr[lane + 64 * i]; ss += v[i].x * v[i].x + v[i].y * v[i].y + v[i].z * v[i].z + v[i].w * v[i].w; }
#pragma unroll
    for (int o = 32; o > 0; o >>= 1) ss += __shfl_xor(ss, o);
    const float rs = rsqrtf(ss * (1.0f / 1024.0f) + EPS_);
#pragma unroll
    for (int i = 0; i < 4; ++i) {
      const int c = (lane + 64 * i) * 4;
      const float4 w4 = *(const float4*)(nwt + c), sh = *(const float4*)(mod + c), sc = *(const float4*)(mod + 1024 + c);
      const float y0 = v[i].x * rs * w4.x * (1.f + sc.x) + sh.x, y1 = v[i].y * rs * w4.y * (1.f + sc.y) + sh.y;
      const float y2 = v[i].z * rs * w4.z * (1.f + sc.z) + sh.z, y3 = v[i].w * rs * w4.w * (1.f + sc.w) + sh.w;
      uint2 o; o.x = pack2(y0, y1); o.y = pack2(y2, y3);
      *(uint2*)(xn + (size_t)r * 1024 + c) = o;
    }
  }
}

struct EpiArgs { int l; int gi; bool first; };
template <int EPI>
DEV void gemm_tile(const Params& p, const bf16_t* __restrict__ A, const bf16_t* __restrict__ Bt, int K, int arow0, int brow0, int tn, const EpiArgs& e, char* ldsc) {
  bf16_t* As = (bf16_t*)ldsc;
  bf16_t* Bs = As + 2 * 128 * 64;
  const int tid = tid_opaque(), lane = tid & 63, wid = __builtin_amdgcn_readfirstlane(tid >> 6), fr = lane & 15, fq = lane >> 4, wm = wid >> 1, wn = wid & 1;
  const int lr = tid >> 3, lc = (((tid & 7) ^ (lr & 7)) * 8);
  size_t ao0, ao1, ao2, ao3;
  { int r0 = arow0 + lr, r1 = r0 + 32, r2 = r0 + 64, r3 = r0 + 96;
    r0 = r0 < 0 ? 0 : (r0 > R_ - 1 ? R_ - 1 : r0); r1 = r1 < 0 ? 0 : (r1 > R_ - 1 ? R_ - 1 : r1); r2 = r2 < 0 ? 0 : (r2 > R_ - 1 ? R_ - 1 : r2); r3 = r3 < 0 ? 0 : (r3 > R_ - 1 ? R_ - 1 : r3);
    ao0 = (size_t)r0 * K + lc; ao1 = (size_t)r1 * K + lc; ao2 = (size_t)r2 * K + lc; ao3 = (size_t)r3 * K + lc; }
  const bf16_t* bp0 = Bt + (size_t)(brow0 + lr) * K + lc;
  const size_t bstep = (size_t)32 * K;
  f32x4 acc[4][4];
#pragma unroll
  for (int a = 0; a < 4; ++a)
#pragma unroll
    for (int b = 0; b < 4; ++b) acc[a][b] = (f32x4){0.f, 0.f, 0.f, 0.f};
  const int nk = K >> 6;
  char* ldsA = (char*)As + wid * 1024; char* ldsB = (char*)Bs + wid * 1024;
#define GEMM_GLDS(kt_, buf_) do { const int ko_ = (kt_) * 64; char* la_ = ldsA + (buf_) * 16384; char* lb_ = ldsB + (buf_) * 16384; \
    __builtin_amdgcn_global_load_lds((const unsigned*)(A + ao0 + ko_), (unsigned*)(la_), 16, 0, 0); \
    __builtin_amdgcn_global_load_lds((const unsigned*)(A + ao1 + ko_), (unsigned*)(la_ + 4096), 16, 0, 0); \
    __builtin_amdgcn_global_load_lds((const unsigned*)(A + ao2 + ko_), (unsigned*)(la_ + 8192), 16, 0, 0); \
    __builtin_amdgcn_global_load_lds((const unsigned*)(A + ao3 + ko_), (unsigned*)(la_ + 12288), 16, 0, 0); \
    __builtin_amdgcn_global_load_lds((const unsigned*)(bp0 + ko_), (unsigned*)(lb_), 16, 0, 0); \
    __builtin_amdgcn_global_load_lds((const unsigned*)(bp0 + bstep + ko_), (unsigned*)(lb_ + 4096), 16, 0, 0); \
    __builtin_amdgcn_global_load_lds((const unsigned*)(bp0 + 2 * bstep + ko_), (unsigned*)(lb_ + 8192), 16, 0, 0); \
    __builtin_amdgcn_global_load_lds((const unsigned*)(bp0 + 3 * bstep + ko_), (unsigned*)(lb_ + 12288), 16, 0, 0); } while (0)
  GEMM_GLDS(0, 0);
  for (int kt = 0; kt < nk; ++kt) {
   {
    const int buf = kt & 1;
    asm volatile("s_waitcnt vmcnt(0)" ::: "memory");
    __syncthreads();
    if (kt + 1 < nk) GEMM_GLDS(kt + 1, buf ^ 1);
    __builtin_amdgcn_sched_barrier(0);
    const bf16_t* as = As + buf * 128 * 64; const bf16_t* bs = Bs + buf * 128 * 64;
#pragma unroll
    for (int ks = 0; ks < 2; ++ks) {
      bf16x8 af[4], bfr[4];
#pragma unroll
      for (int i = 0; i < 4; ++i) { af[i] = *(const bf16x8*)&as[(wm * 64 + i * 16 + fr) * 64 + (((ks * 4 + fq) ^ (fr & 7)) * 8)]; bfr[i] = *(const bf16x8*)&bs[(wn * 64 + i * 16 + fr) * 64 + (((ks * 4 + fq) ^ (fr & 7)) * 8)]; }
#pragma unroll
      for (int ni = 0; ni < 4; ++ni)
#pragma unroll
        for (int mi = 0; mi < 4; ++mi) acc[ni][mi] = mfma16(bfr[ni], af[mi], acc[ni][mi]);
    }
   }
  }
  __syncthreads();
  if (EPI == 0) {
    bf16_t* P = (bf16_t*)(p.ws + OFF_P);
#pragma unroll
    for (int mi = 0; mi < 4; ++mi) { const size_t row = (size_t)(arow0 + wm * 64 + mi * 16 + fr);
#pragma unroll
      for (int ni = 0; ni < 4; ++ni) { uint2 o; o.x = pack2(acc[ni][mi][0], acc[ni][mi][1]); o.y = pack2(acc[ni][mi][2], acc[ni][mi][3]);
        *(uint2*)(P + row * PN_ + brow0 + wn * 64 + ni * 16 + fq * 4) = o; } }
  } else if (EPI == 1) {
#pragma unroll
    for (int mi = 0; mi < 4; ++mi) { const int row = arow0 + wm * 64 + mi * 16 + fr;
      const float* xin = xrow_ptr(p, row, e.first);
      float* xout = row < LAT_ ? p.out + (size_t)row * 1024 : (float*)(p.ws + OFF_HCTX) + (size_t)(row - LAT_) * 1024;
      const float* gate = (const float*)(p.ws + OFF_MOD) + (e.l * 3 + grp_of(row)) * 6144 + e.gi * 1024;
#pragma unroll
      for (int ni = 0; ni < 4; ++ni) { const int col = brow0 + wn * 64 + ni * 16 + fq * 4;
        const float4 xi = *(const float4*)(xin + col), g = *(const float4*)(gate + col);
        float4 o; o.x = xi.x + g.x * acc[ni][mi][0]; o.y = xi.y + g.y * acc[ni][mi][1]; o.z = xi.z + g.z * acc[ni][mi][2]; o.w = xi.w + g.w * acc[ni][mi][3];
        *(float4*)(xout + col) = o; } }
  } else {
    constexpr int GS = 68;
    float* G = (float*)ldsc;
    float* Vb = (float*)(ldsc + 128 * GS * 4);
    if (wn == 0) {
#pragma unroll
      for (int mi = 0; mi < 4; ++mi)
#pragma unroll
        for (int ni = 0; ni < 4; ++ni) *(f32x4*)&G[(wm * 64 + mi * 16 + fr) * GS + ni * 16 + fq * 4] = acc[ni][mi];
    } else {
#pragma unroll
      for (int mi = 2; mi < 4; ++mi)
#pragma unroll
        for (int ni = 0; ni < 4; ++ni) *(f32x4*)&Vb[(wm * 64 + mi * 16 + fr) * GS + ni * 16 + fq * 4] = acc[ni][mi];
    }
    __syncthreads();
    {
      bf16_t* H = (bf16_t*)(p.ws + OFF_P);
      const float* cw = p.ffn_conv_w + (size_t)e.l * 3 * DFF_ + tn * 64;
#pragma unroll
      for (int mi2 = 0; mi2 < 2; ++mi2) { const int mi = wn == 1 ? mi2 : mi2 + 2; const int m = wm * 64 + mi * 16 + fr, gr = arow0 + m;
        const bool valid = (m >= 1) && (m <= 126) && (gr >= 0) && (gr < R_);
        if (valid) { const bool hasp = !seq_first(gr), hasn = !seq_last(gr);
#pragma unroll
          for (int ni = 0; ni < 4; ++ni) { const int c0 = ni * 16 + fq * 4;
            const f32x4 w0 = *(const f32x4*)(cw + c0), w1 = *(const f32x4*)(cw + DFF_ + c0), w2 = *(const f32x4*)(cw + 2 * DFF_ + c0);
            const f32x4 z4 = {0.f, 0.f, 0.f, 0.f};
            const f32x4 g1 = *(const f32x4*)&G[m * GS + c0];
            const f32x4 g0 = hasp ? *(const f32x4*)&G[(m - 1) * GS + c0] : z4;
            const f32x4 g2 = hasn ? *(const f32x4*)&G[(m + 1) * GS + c0] : z4;
            const f32x4 cv = w1 * g1 + w0 * g0 + w2 * g2;
            f32x4 vv; if (wn == 1) vv = acc[ni][mi2]; else vv = *(const f32x4*)&Vb[m * GS + c0];
            uint2 o; o.x = pack2(siluf_(cv[0]) * vv[0], siluf_(cv[1]) * vv[1]); o.y = pack2(siluf_(cv[2]) * vv[2], siluf_(cv[3]) * vv[3]);
            *(uint2*)(H + (size_t)gr * DFF_ + tn * 64 + c0) = o; } } }
    }
    __syncthreads();
  }
}

DEV unsigned xcc_id() { return (unsigned)__builtin_amdgcn_s_getreg((3 << 11) | 20) & 7u; }
template <int EPI>
DEV void gemm_phase(const Params& p, const bf16_t* A, const bf16_t* Bt, int K, int ntm, int ntn, const EpiArgs& e, char* lds, int gidx) {
  __shared__ int s_q;
  unsigned* ctr = (unsigned*)(p.ws + OFF_CTRL) + 8 + gidx * 8;
  const int x0 = (int)xcc_id(), nig = 8 * ntn;
  for (int xo = 0; xo < 8; ++xo) {
    const int xcd = (x0 + xo) & 7, cnt = (ntm - xcd + 7) >> 3, total = cnt * ntn;
    for (;;) {
      if (tid_opaque() == 0) s_q = (int)atomicAdd(ctr + xcd, 1u);
      __syncthreads();
      const int q = s_q;
      __syncthreads();
      if (q >= total) break;
      const int grp = q / nig, rem = q - grp * nig, fm = grp * 8, gsz = (cnt - fm) < 8 ? (cnt - fm) : 8;
      const int tm = xcd + 8 * (fm + rem % gsz), tn = rem / gsz;
      const int arow0 = (EPI == 2) ? tm * 126 - 1 : tm * 128;
      gemm_tile<EPI>(p, A, Bt, K, arow0, tn * 128, tn, e, lds);
    }
  }
}

DEV float wave_incl_scan(float v, int lane) {
#pragma unroll
  for (int o = 1; o < 64; o <<= 1) { const float t = __shfl_up(v, o); if (lane >= o) v += t; }
  return v;
}
DEV void dn_prep_item(const Params& p, int l, int cg, int h, char* ldsc) {
  bf16_t* sIn = (bf16_t*)ldsc;
  float* sKK = (float*)ldsc;
  float* sQ = (float*)(ldsc + 25344);
  float* sK = (float*)(ldsc + 41984);
  float* sV = (float*)(ldsc + 58624);
  float* sBeta = (float*)(ldsc + 75264);
  float* sG = sBeta + 128;
  const int tid = tid_opaque(), lane = tid & 63, wid = tid >> 6;
  const bf16_t* P = (const bf16_t*)(p.ws + OFF_P);
  const int row0 = cg * 64;
  const bool hasp = !seq_first(row0), hasn = !seq_last(row0 + 63);
  for (int c = tid; c < 66 * 24; c += 256) {
    const int j = c / 24, cc = c % 24, part = cc >> 3, off = (cc & 7) * 8;
    uint4 v = {0u, 0u, 0u, 0u};
    const bool ok = (j == 0) ? hasp : (j == 65 ? hasn : true);
    if (ok) v = *(const uint4*)(P + (size_t)(row0 - 1 + j) * PN_ + part * 256 + h * 64 + off);
    *(uint4*)&sIn[j * 192 + part * 64 + off] = v;
  }
  __syncthreads();
  if (tid < 192) {
    const float* cw = p.dn_conv_w + (size_t)l * 3 * 768;
    const int ch = tid, part = ch >> 6, d = ch & 63, wc = part * 256 + h * 64 + d;
    const float w0 = cw[wc], w1 = cw[768 + wc], w2 = cw[1536 + wc];
    float* dst = part == 0 ? sQ : (part == 1 ? sK : sV);
    float x0 = bf2f(sIn[ch]), x1 = bf2f(sIn[192 + ch]);
#pragma unroll 4
    for (int t = 0; t < 64; ++t) {
      const float x2 = bf2f(sIn[(t + 2) * 192 + ch]);
      dst[t * 65 + d] = siluf_(w0 * x0 + w1 * x1 + w2 * x2);
      x0 = x1; x1 = x2;
    }
  }
  __syncthreads();
  {
    bf16_t* Y = (bf16_t*)(p.ws + OFF_XY); bf16_t* DK = (bf16_t*)(p.ws + OFF_DNK);
    for (int i = 0; i < 16; ++i) {
      const int t = wid * 16 + i;
      float q = sQ[t * 65 + lane], k = sK[t * 65 + lane];
      float sq = q * q, sk = k * k;
#pragma unroll
      for (int o = 32; o > 0; o >>= 1) { sq += __shfl_xor(sq, o); sk += __shfl_xor(sk, o); }
      q *= rsqrtf(sq + EPS_); k *= rsqrtf(sk + EPS_);
      sK[t * 65 + lane] = k;
      Y[(size_t)(row0 + t) * 1024 + h * 64 + lane] = f2bf(q * 0.125f);
      DK[(size_t)(row0 + t) * 256 + h * 64 + lane] = f2bf(k);
    }
    if (wid < 2) {
      const int dir = wid, t = dir ? 63 - lane : lane;
      const bf16_t* ba = P + (size_t)(row0 + t) * PN_ + C_DNBA;
      const float beta = sigmoidf_(bf2f(ba[dir * 4 + h]));
      const float xr = bf2f(ba[(2 + dir) * 4 + h]) + p.dn_dt_bias[l * 8 + dir * 4 + h];
      const float sp = fmaxf(xr, 0.f) + log1pf(__expf(-fabsf(xr)));
      const float la = -__expf(p.dn_a_log[l * 8 + dir * 4 + h]) * sp;
      const float g = wave_incl_scan(la, lane);
      sBeta[dir * 64 + lane] = beta; sG[dir * 64 + lane] = g;
      ((float*)(p.ws + OFF_DNG))[((size_t)(dir * 520 + cg) * 4 + h) * 64 + lane] = g;
    }
  }
  __syncthreads();
  const int dir = wid >> 1, role = wid & 1;
  float x[64];
  {
    const int t_l = dir ? 63 - lane : lane;
    const float bsc = sBeta[dir * 64 + lane] * (role == 0 ? __expf(sG[dir * 64 + lane]) : 1.f);
    const float* srcm = role == 0 ? sK : sV;
#pragma unroll
    for (int c = 0; c < 64; ++c) x[c] = srcm[t_l * 65 + c] * bsc;
  }
  {
    const int ti = tid >> 4, si = tid & 15;
    float a[4][4];
#pragma unroll
    for (int i = 0; i < 4; ++i)
#pragma unroll
      for (int j = 0; j < 4; ++j) a[i][j] = 0.f;
#pragma unroll 2
    for (int d = 0; d < 64; ++d) {
      float kt[4], ks[4];
#pragma unroll
      for (int i = 0; i < 4; ++i) { kt[i] = sK[(ti * 4 + i) * 65 + d]; ks[i] = sK[(si * 4 + i) * 65 + d]; }
#pragma unroll
      for (int i = 0; i < 4; ++i)
#pragma unroll
        for (int j = 0; j < 4; ++j) a[i][j] += kt[i] * ks[j];
    }
#pragma unroll
    for (int i = 0; i < 4; ++i)
#pragma unroll
      for (int j = 0; j < 4; ++j) sKK[(ti * 4 + i) * 65 + si * 4 + j] = a[i][j];
  }
  __syncthreads();
  {
    float* sA0 = sQ; float* sA1 = sK;
    for (int idx = tid; idx < 2 * 4096; idx += 256) {
      const int dd = idx >> 12, i = (idx >> 6) & 63, j = idx & 63;
      const int ti = dd ? 63 - i : i, tj = dd ? 63 - j : j;
      float v = 0.f;
      if (j < i) v = sBeta[dd * 64 + i] * sKK[ti * 65 + tj] * __expf(sG[dd * 64 + i] - sG[dd * 64 + j]);
      (dd ? sA1 : sA0)[i * 65 + j] = v;
    }
  }
  __syncthreads();
  {
    const float* sA = dir ? sK : sQ;
#pragma unroll 1
    for (int j = 0; j < 63; ++j) {
      float a = sA[lane * 65 + j]; a = lane > j ? a : 0.f;
      const f32x2_t na = {-a, -a};
#pragma unroll
      for (int c = 0; c < 64; c += 2) {
        const f32x2_t xj = {__int_as_float(__builtin_amdgcn_readlane(__float_as_int(x[c]), j)), __int_as_float(__builtin_amdgcn_readlane(__float_as_int(x[c + 1]), j))};
        const f32x2_t xv = __builtin_elementwise_fma(na, xj, (f32x2_t){x[c], x[c + 1]});
        x[c] = xv.x; x[c + 1] = xv.y;
      }
    }
    const size_t base = ((size_t)(dir * 520 + cg) * 4 + h) * 4096;
    if (role == 0) {
      bf16_t* W = (bf16_t*)(p.ws + OFF_DNW) + base + lane * 64;
#pragma unroll
      for (int i = 0; i < 8; ++i) { uint4 o; o.x = pack2(x[i * 8], x[i * 8 + 1]); o.y = pack2(x[i * 8 + 2], x[i * 8 + 3]); o.z = pack2(x[i * 8 + 4], x[i * 8 + 5]); o.w = pack2(x[i * 8 + 6], x[i * 8 + 7]);
        *(uint4*)(W + i * 8) = o; }
    } else {
      bf16_t* UT = (bf16_t*)(p.ws + OFF_DNUT) + base;
#pragma unroll
      for (int c = 0; c < 64; ++c) UT[c * 64 + lane] = f2bf(x[c]);
    }
  }
  __syncthreads();
}

DEV void hg_prep_item(const Params& p, int l, int cg, int h, char* ldsc) {
  float* sQ = (float*)ldsc;
  float* sK = (float*)(ldsc + 16640);
  float* sC = (float*)(ldsc + 33280);
  float* sT = (float*)(ldsc + 49920);
  const int tid = tid_opaque(), d = tid & 63, part = tid >> 6;
  bf16_t* P = (bf16_t*)(p.ws + OFF_P); bf16_t* Y = (bf16_t*)(p.ws + OFF_XY);
  const int row0 = cg * 64;
#pragma unroll 4
  for (int i = 0; i < 16; ++i) { const int t = part * 16 + i; sQ[t * 65 + d] = 0.125f * bf2f(P[(size_t)(row0 + t) * PN_ + C_HGQ + h * 64 + d]); }
  for (int dir = 0; dir < 2; ++dir) {
    float lbv = 0.f;
    if (l == 1) { const float r0 = p.hg_lb_raw[dir * 256 + h * 64 + d], r1 = p.hg_lb_raw[512 + dir * 256 + h * 64 + d]; lbv = 1.0f / (1.0f + __expf(r0 - r1)); }
    const int fcol = (dir ? C_HGFB : C_HGFF) + h * 64 + d;
    float kk[16], cc[16]; float run = 0.f;
#pragma unroll
    for (int i = 0; i < 16; ++i) {
      const int tau = part * 16 + i, t = dir ? 63 - tau : tau;
      const float raw = bf2f(P[(size_t)(row0 + t) * PN_ + fcol]);
      const float k = (1.f - lbv) * sigmoidf_(-raw);
      kk[i] = k; run += __logf(1.0f - k); cc[i] = run;
    }
    sT[part * 64 + d] = run;
    __syncthreads();
    float offs = 0.f;
    for (int q = 0; q < part; ++q) offs += sT[q * 64 + d];
    const float clast = sT[d] + sT[64 + d] + sT[128 + d] + sT[192 + d];
#pragma unroll
    for (int i = 0; i < 16; ++i) {
      const int tau = part * 16 + i, t = dir ? 63 - tau : tau;
      const float c = cc[i] + offs;
      sK[tau * 65 + d] = kk[i]; sC[tau * 65 + d] = c * LOG2E;
      const float qb = sQ[t * 65 + d] * __expf(c), ke = kk[i] * __expf(clast - c);
      if (dir == 0) P[(size_t)(row0 + t) * PN_ + C_HGQ + h * 64 + d] = f2bf(qb); else Y[(size_t)(row0 + t) * 1024 + 768 + h * 64 + d] = f2bf(qb);
      P[(size_t)(row0 + t) * PN_ + fcol] = f2bf(ke);
    }
    if (part == 0) ((float*)(p.ws + OFF_HGDE))[((size_t)(dir * 520 + cg) * 4 + h) * 64 + d] = __expf(clast);
    __syncthreads();
    {
      const int ti = tid >> 4, si = tid & 15;
      float a[4][4];
#pragma unroll
      for (int i = 0; i < 4; ++i)
#pragma unroll
        for (int j = 0; j < 4; ++j) a[i][j] = 0.f;
      if (si < ti) {
#pragma unroll 2
        for (int dd = 0; dd < 64; ++dd) {
          float qa[4], ca[4], kb[4], cb[4];
#pragma unroll
          for (int i = 0; i < 4; ++i) { const int tau = ti * 4 + i, t = dir ? 63 - tau : tau; qa[i] = sQ[t * 65 + dd]; ca[i] = sC[tau * 65 + dd]; kb[i] = sK[(si * 4 + i) * 65 + dd]; cb[i] = sC[(si * 4 + i) * 65 + dd]; }
          const float cr = ca[0];
          float qe[4], ke[4];
          qe[0] = qa[0];
#pragma unroll
          for (int i = 1; i < 4; ++i) qe[i] = qa[i] * __builtin_amdgcn_exp2f(ca[i] - cr);
#pragma unroll
          for (int j = 0; j < 4; ++j) ke[j] = kb[j] * __builtin_amdgcn_exp2f(cr - cb[j]);
#pragma unroll
          for (int i = 0; i < 4; ++i)
#pragma unroll
            for (int j = 0; j < 4; ++j) a[i][j] += qe[i] * ke[j];
        }
      }
      bf16_t* ATT = (bf16_t*)(p.ws + OFF_HGATT) + ((size_t)(dir * 520 + cg) * 4 + h) * 4096;
      if (si != ti) {
#pragma unroll
        for (int i = 0; i < 4; ++i) { const int tau = ti * 4 + i;
          uint2 o; o.x = pack2(a[i][0], a[i][1]); o.y = pack2(a[i][2], a[i][3]);
          *(uint2*)(ATT + tau * 64 + si * 4) = o; }
      }
      {
        const int dtile = tid >> 4, i = (tid >> 2) & 3, j = tid & 3, tau = dtile * 4 + i, sg = dtile * 4 + j, t = dir ? 63 - tau : tau;
        float s = 0.f;
        if (sg <= tau) {
#pragma unroll 4
          for (int dd = 0; dd < 64; ++dd) s += sQ[t * 65 + dd] * sK[sg * 65 + dd] * __builtin_amdgcn_exp2f(fminf(sC[tau * 65 + dd] - sC[sg * 65 + dd], 0.f));
        }
        ATT[tau * 64 + sg] = f2bf(s);
      }
    }
    __syncthreads();
  }
}

DEV void rope_rows(const Params& p, int rb) {
  bf16_t* P = (bf16_t*)(p.ws + OFF_P);
  const int tid = tid_opaque(), r = rb * 16 + (tid >> 4), v = tid & 15;
  const int tpos = r & 16383, grow = tpos >> 6, gcol = tpos & 63;
  bf16_t* ptr = P + (size_t)r * PN_ + (v < 8 ? C_DFQ : C_DFK) + (v & 7) * 32;
  uint4 u[4];
#pragma unroll
  for (int i = 0; i < 4; ++i) u[i] = *(const uint4*)(ptr + i * 8);
  float xv[32];
#pragma unroll
  for (int i = 0; i < 4; ++i) { xv[i * 8 + 0] = lo_bf(u[i].x); xv[i * 8 + 1] = hi_bf(u[i].x); xv[i * 8 + 2] = lo_bf(u[i].y); xv[i * 8 + 3] = hi_bf(u[i].y);
    xv[i * 8 + 4] = lo_bf(u[i].z); xv[i * 8 + 5] = hi_bf(u[i].z); xv[i * 8 + 6] = lo_bf(u[i].w); xv[i * 8 + 7] = hi_bf(u[i].w); }
  const float inv[8] = {1.0f, 0.31622776601683794f, 0.1f, 0.031622776601683794f, 0.01f, 0.0031622776601683794f, 0.001f, 0.00031622776601683794f};
  float yv[32];
#pragma unroll
  for (int i = 0; i < 8; ++i) {
    float ar = (float)grow * inv[i] * 0.15915494309189535f, ac = (float)gcol * inv[i] * 0.15915494309189535f;
    ar -= floorf(ar); ac -= floorf(ac);
    const float cr = __builtin_amdgcn_cosf(ar), sr = __builtin_amdgcn_sinf(ar), cc = __builtin_amdgcn_cosf(ac), sc = __builtin_amdgcn_sinf(ac);
    yv[i] = xv[i] * cr - xv[i + 8] * sr; yv[i + 8] = xv[i + 8] * cr + xv[i] * sr;
    yv[16 + i] = xv[16 + i] * cc - xv[24 + i] * sc; yv[24 + i] = xv[24 + i] * cc + xv[16 + i] * sc;
  }
#pragma unroll
  for (int i = 0; i < 4; ++i) { uint4 o; o.x = pack2(yv[i * 8], yv[i * 8 + 1]); o.y = pack2(yv[i * 8 + 2], yv[i * 8 + 3]); o.z = pack2(yv[i * 8 + 4], yv[i * 8 + 5]); o.w = pack2(yv[i * 8 + 6], yv[i * 8 + 7]);
    *(uint4*)(ptr + i * 8) = o; }
}

DEV void vt_prep_item(const Params& p, int bh, int t, char* ldsc);
DEV void prep_phase(const Params& p, int l, char* lds) {
  __shared__ int s_pq;
  unsigned* ctr = (unsigned*)(p.ws + OFF_CTRL) + 4 + l;
  const int nitems = 4160 + 2048 + 2080;
  for (;;) {
    if (tid_opaque() == 0) s_pq = (int)atomicAdd(ctr, 1u);
    __syncthreads();
    const int it = s_pq;
    __syncthreads();
    if (it >= nitems) break;
    const int lo = l;
    if (it < 2080) dn_prep_item(p, lo, it >> 2, it & 3, lds);
    else if (it < 4160) hg_prep_item(p, lo, (it - 2080) >> 2, (it - 2080) & 3, lds);
    else if (it < 6208) rope_rows(p, it - 4160);
    else vt_prep_item(p, (it - 6208) / 260, (it - 6208) % 260, lds);
  }
}

DEV void post_phase(const Params& p, int l) {
  const int lane = tid_opaque() & 63, gw = bid_opaque() * 4 + (tid_opaque() >> 6), nw = gridDim.x * 4;
  bf16_t* P = (bf16_t*)(p.ws + OFF_P); bf16_t* Y = (bf16_t*)(p.ws + OFF_XY);
  for (int it = gw; it < 2 * R_; it += nw) {
    const int r = it >> 1, mix = it & 1;
    const int c = lane * 4;
    uint2 uf, ub, ug;
    if (mix == 0) { uf = *(const uint2*)(P + (size_t)r * PN_ + C_DNQ + c); ub = *(const uint2*)(P + (size_t)r * PN_ + C_DNK + c); ug = *(const uint2*)(P + (size_t)r * PN_ + C_DNG + c); }
    else { uf = *(const uint2*)(P + (size_t)r * PN_ + C_HGQ + c); ub = *(const uint2*)(Y + (size_t)r * 1024 + 768 + c); ug = *(const uint2*)(P + (size_t)r * PN_ + C_HGG + c); }
    float o[4] = {lo_bf(uf.x) + lo_bf(ub.x), hi_bf(uf.x) + hi_bf(ub.x), lo_bf(uf.y) + lo_bf(ub.y), hi_bf(uf.y) + hi_bf(ub.y)};
    const float g[4] = {lo_bf(ug.x), hi_bf(ug.x), lo_bf(ug.y), hi_bf(ug.y)};
    float ss = o[0] * o[0] + o[1] * o[1] + o[2] * o[2] + o[3] * o[3];
#pragma unroll
    for (int s = 8; s > 0; s >>= 1) ss += __shfl_xor(ss, s);
    const float rs = rsqrtf(ss * (1.0f / 64.0f) + EPS_);
    const float* nw_ = (mix == 0 ? p.dn_norm_w : p.hg_norm_w) + l * 64 + (c & 63);
    float y[4];
#pragma unroll
    for (int i = 0; i < 4; ++i) y[i] = o[i] * rs * nw_[i] * siluf_(g[i]);
    uint2 ov; ov.x = pack2(y[0], y[1]); ov.y = pack2(y[2], y[3]);
    *(uint2*)(Y + (size_t)r * 1024 + (mix == 0 ? 0 : 768) + c) = ov;
  }
}

DEV bf16x8 pack8(const f32x4& a, const f32x4& b) {
  union { bf16x8 v; unsigned u[4]; } r;
  r.u[0] = pack2(a[0], a[1]); r.u[1] = pack2(a[2], a[3]); r.u[2] = pack2(b[0], b[1]); r.u[3] = pack2(b[2], b[3]);
  return r.v;
}
DEV void vt_tr_store(bf16_t* vt, int off, int key, const uint4& v) {
  vt[(off + 0) * LDT + key] = (bf16_t)(v.x & 0xffffu); vt[(off + 1) * LDT + key] = (bf16_t)(v.x >> 16);
  vt[(off + 2) * LDT + key] = (bf16_t)(v.y & 0xffffu); vt[(off + 3) * LDT + key] = (bf16_t)(v.y >> 16);
  vt[(off + 4) * LDT + key] = (bf16_t)(v.z & 0xffffu); vt[(off + 5) * LDT + key] = (bf16_t)(v.z >> 16);
  vt[(off + 6) * LDT + key] = (bf16_t)(v.w & 0xffffu); vt[(off + 7) * LDT + key] = (bf16_t)(v.w >> 16);
}
DEV void vt_prep_item(const Params& p, int bh, int t, char* ldsc) {
  bf16_t* sT = (bf16_t*)ldsc;
  const int tid = tid_opaque(), b = bh >> 2, h = bh & 3;
  const bf16_t* P = (const bf16_t*)(p.ws + OFF_P);
  const int trow = t < 4 ? LAT_ + b * 256 + t * 64 : b * 16384 + (t - 4) * 64;
  const int lkey = tid >> 3, loff = (tid & 7) * 8;
  const int lkp = lkey < 16 ? ((lkey >> 2) * 8 + (lkey & 3)) : (((lkey - 16) >> 2) * 8 + 4 + (lkey & 3));
  const uint4 v0 = *(const uint4*)(P + (size_t)(trow + lkey) * PN_ + C_DFV + h * 64 + loff);
  const uint4 v1 = *(const uint4*)(P + (size_t)(trow + lkey + 32) * PN_ + C_DFV + h * 64 + loff);
  vt_tr_store(sT, loff, lkp, v0); vt_tr_store(sT, loff, lkp + 32, v1);
  __syncthreads();
  bf16_t* dst = (bf16_t*)(p.ws + OFF_VTG) + ((size_t)bh * 64) * 16640 + (size_t)t * 64;
#pragma unroll
  for (int i = 0; i < 2; ++i) { const int dv = (tid >> 3) + 32 * i; *(uint4*)(dst + (size_t)dv * 16640 + loff) = *(const uint4*)&sT[dv * LDT + loff]; }
  __syncthreads();
}

template <int MODE>
DEV void attn_item(const Params& p, int l, int kind, int b, int h, int qt, char* ldsc) {
  bf16_t* Ks = (bf16_t*)ldsc;
  bf16_t* VT = Ks + 2 * 64 * LDT;
  float* sRpb = (float*)(ldsc + 4 * 64 * LDT * 2);
  const int tid = tid_opaque(), lane = tid & 63, wid = tid >> 6, fr = lane & 15, fq = lane >> 4;
  const bf16_t* P = (const bf16_t*)(p.ws + OFF_P);
  bf16_t* Y = (bf16_t*)(p.ws + OFF_XY);
  const int qcol = (MODE == 0 ? C_DFQ : C_NAQ) + h * 64, kcol = (MODE == 0 ? C_DFK : C_NAK) + h * 64, vcol = (MODE == 0 ? C_DFV : C_NAV) + h * 64;
  const int qrow0 = kind == 0 ? b * 16384 + qt * 64 : LAT_ + b * 256 + qt * 64;
  int nprim = 0, prim_row0 = 0, r_start = 0;
  if (kind == 0) { if (MODE == 0) { nprim = 256; prim_row0 = b * 16384; } else { r_start = qt - 4; r_start = r_start < 0 ? 0 : (r_start > 248 ? 248 : r_start); nprim = 8; prim_row0 = b * 16384 + r_start * 64; } }
  const int ntiles = nprim + 4, ctx_row0 = LAT_ + b * 256;
  float lam = 0.f;
  if (MODE == 0) {
    const float* lp = p.df_lambda + l * 128;
    float a = lane < 32 ? lp[lane] * lp[32 + lane] : 0.f, c = lane < 32 ? lp[64 + lane] * lp[96 + lane] : 0.f;
#pragma unroll
    for (int o = 32; o > 0; o >>= 1) { a += __shfl_xor(a, o); c += __shfl_xor(c, o); }
    lam = __expf(a) - __expf(c) + p.lam_init[l];
  } else {
    for (int i = tid; i < 465; i += 256) sRpb[i] = p.na_rpb[(size_t)(l * 4 + h) * 465 + i];
  }
  const int qrow = qrow0 + wid * 16 + fr;
  const bf16x8 q0 = *(const bf16x8*)(P + (size_t)qrow * PN_ + qcol + fq * 8);
  const bf16x8 q1 = *(const bf16x8*)(P + (size_t)qrow * PN_ + qcol + 32 + fq * 8);
  f32x4 O1[4], O2[4];
#pragma unroll
  for (int i = 0; i < 4; ++i) { O1[i] = (f32x4){0.f, 0.f, 0.f, 0.f}; O2[i] = (f32x4){0.f, 0.f, 0.f, 0.f}; }
  float m1 = -INFINITY, m2 = -INFINITY;
  f32x4 L1 = {0.f, 0.f, 0.f, 0.f}, L2 = {0.f, 0.f, 0.f, 0.f};
  const float sc = (MODE == 0 ? 0.17677669529663687f : 0.125f) * LOG2E;
  const int lkey = tid >> 3, loff = (tid & 7) * 8;
  const bf16_t* vtg = (const bf16_t*)(p.ws + OFF_VTG) + (size_t)(b * 4 + h) * 64 * 16640;
  const int lkp = lkey < 16 ? ((lkey >> 2) * 8 + (lkey & 3)) : (((lkey - 16) >> 2) * 8 + 4 + (lkey & 3));
  uint4 rk0A, rk1A, rv0A, rv1A, rk0B, rk1B, rv0B, rv1B;
#define ATT_GLOAD(it_, S) do { const int trow_ = (it_) < nprim ? prim_row0 + (it_) * 64 : ctx_row0 + ((it_) - nprim) * 64; \
    const bf16_t* s0_ = P + (size_t)(trow_ + lkey) * PN_; const bf16_t* s1_ = P + (size_t)(trow_ + lkey + 32) * PN_; \
    rk0##S = *(const uint4*)(s0_ + kcol + loff); rk1##S = *(const uint4*)(s1_ + kcol + loff); \
    if (MODE == 0) { const int kt_ = (it_) < nprim ? 4 + (it_) : (it_) - nprim; const bf16_t* v_ = vtg + (size_t)lkey * 16640 + kt_ * 64 + loff; \
      rv0##S = *(const uint4*)(v_); rv1##S = *(const uint4*)(v_ + (size_t)32 * 16640); } \
    else { rv0##S = *(const uint4*)(s0_ + vcol + loff); rv1##S = *(const uint4*)(s1_ + vcol + loff); } } while (0)
#define ATT_LSTORE(buf_, S) do { bf16_t* ks_ = Ks + (buf_) * 64 * LDT; bf16_t* vt_ = VT + (buf_) * 64 * LDT; \
    *(uint4*)&ks_[lkey * LDT + loff] = rk0##S; *(uint4*)&ks_[(lkey + 32) * LDT + loff] = rk1##S; \
    if (MODE == 0) { *(uint4*)&vt_[lkey * LDT + loff] = rv0##S; *(uint4*)&vt_[(lkey + 32) * LDT + loff] = rv1##S; } \
    else { vt_tr_store(vt_, loff, lkp, rv0##S); vt_tr_store(vt_, loff, lkp + 32, rv1##S); } } while (0)
  ATT_GLOAD(0, A); __builtin_amdgcn_sched_barrier(0); ATT_GLOAD(1, B); __builtin_amdgcn_sched_barrier(0);
  for (int it0 = 0; it0 < ntiles; it0 += 2) {
#pragma unroll
   for (int half = 0; half < 2; ++half) {
    const int it = it0 + half, buf = half;
    if (half == 0) ATT_LSTORE(0, A); else ATT_LSTORE(1, B);
    __syncthreads();
    { const int itn = (it + 2 < ntiles) ? it + 2 : ntiles - 1; if (half == 0) ATT_GLOAD(itn, A); else ATT_GLOAD(itn, B); }
    __builtin_amdgcn_sched_barrier(0);
    const bf16_t* ks = Ks + buf * 64 * LDT; const bf16_t* vt = VT + buf * 64 * LDT;
    f32x4 s1[4], s2[4];
#pragma unroll
    for (int kt = 0; kt < 4; ++kt) {
      const bf16x8 k0 = *(const bf16x8*)&ks[(kt * 16 + fr) * LDT + fq * 8], k1 = *(const bf16x8*)&ks[(kt * 16 + fr) * LDT + 32 + fq * 8];
      const f32x4 z = {0.f, 0.f, 0.f, 0.f};
      if (MODE == 0) { s1[kt] = mfma16(k0, q0, z); s2[kt] = mfma16(k1, q1, z); }
      else { s1[kt] = mfma16(k1, q1, mfma16(k0, q0, z)); }
    }
    float pre = sc;
    if (MODE == 1 && kind == 0 && it < nprim) {
      const int w = wid * 16 + fr; int cs = w - 8; cs = cs < 0 ? 0 : (cs > 48 ? 48 : cs);
      const float* rp = sRpb + (r_start + it - qt + 7) * 31 + 15 - w;
#pragma unroll
      for (int kt = 0; kt < 4; ++kt)
#pragma unroll
        for (int r = 0; r < 4; ++r) { const int kj = kt * 16 + fq * 4 + r; const bool ok = (kj >= cs) && (kj < cs + 16);
          s1[kt][r] = ok ? s1[kt][r] * sc + rp[ok ? kj : w] * LOG2E : -INFINITY; }
      pre = 1.0f;
    }
    {
      float lm = fmaxf(fmaxf(s1[0][0], s1[0][1]), s1[0][2]);
      lm = fmaxf(fmaxf(lm, s1[0][3]), s1[1][0]); lm = fmaxf(fmaxf(lm, s1[1][1]), s1[1][2]); lm = fmaxf(fmaxf(lm, s1[1][3]), s1[2][0]); lm = fmaxf(fmaxf(lm, s1[2][1]), s1[2][2]);
      lm = fmaxf(fmaxf(lm, s1[2][3]), s1[3][0]); lm = fmaxf(fmaxf(lm, s1[3][1]), s1[3][2]); lm = fmaxf(lm, s1[3][3]);
      lm *= pre;
      if (__any(lm > m1 + 8.0f)) {
        float mx = fmaxf(lm, __shfl_xor(lm, 16)); mx = fmaxf(mx, __shfl_xor(mx, 32));
        const float mn = fmaxf(m1, mx), al = __builtin_amdgcn_exp2f(m1 - mn); m1 = mn;
#pragma unroll
        for (int dt = 0; dt < 4; ++dt) O1[dt] = O1[dt] * al;
        L1 = L1 * al;
      }
      { const f32x2_t pv = {pre, pre}, nm = {-m1, -m1};
#pragma unroll
        for (int kt = 0; kt < 4; ++kt) {
          const f32x2_t a = __builtin_elementwise_fma((f32x2_t){s1[kt][0], s1[kt][1]}, pv, nm), b = __builtin_elementwise_fma((f32x2_t){s1[kt][2], s1[kt][3]}, pv, nm);
          s1[kt][0] = __builtin_amdgcn_exp2f(a.x); s1[kt][1] = __builtin_amdgcn_exp2f(a.y); s1[kt][2] = __builtin_amdgcn_exp2f(b.x); s1[kt][3] = __builtin_amdgcn_exp2f(b.y); } }
    }
    if (MODE == 0) {
      float lm = fmaxf(fmaxf(s2[0][0], s2[0][1]), s2[0][2]);
      lm = fmaxf(fmaxf(lm, s2[0][3]), s2[1][0]); lm = fmaxf(fmaxf(lm, s2[1][1]), s2[1][2]); lm = fmaxf(fmaxf(lm, s2[1][3]), s2[2][0]); lm = fmaxf(fmaxf(lm, s2[2][1]), s2[2][2]);
      lm = fmaxf(fmaxf(lm, s2[2][3]), s2[3][0]); lm = fmaxf(fmaxf(lm, s2[3][1]), s2[3][2]); lm = fmaxf(lm, s2[3][3]);
      lm *= sc;
      if (__any(lm > m2 + 8.0f)) {
        float mx = fmaxf(lm, __shfl_xor(lm, 16)); mx = fmaxf(mx, __shfl_xor(mx, 32));
        const float mn = fmaxf(m2, mx), al = __builtin_amdgcn_exp2f(m2 - mn); m2 = mn;
#pragma unroll
        for (int dt = 0; dt < 4; ++dt) O2[dt] = O2[dt] * al;
        L2 = L2 * al;
      }
      { const f32x2_t pv = {sc, sc}, nm = {-m2, -m2};
#pragma unroll
        for (int kt = 0; kt < 4; ++kt) {
          const f32x2_t a = __builtin_elementwise_fma((f32x2_t){s2[kt][0], s2[kt][1]}, pv, nm), b = __builtin_elementwise_fma((f32x2_t){s2[kt][2], s2[kt][3]}, pv, nm);
          s2[kt][0] = __builtin_amdgcn_exp2f(a.x); s2[kt][1] = __builtin_amdgcn_exp2f(a.y); s2[kt][2] = __builtin_amdgcn_exp2f(b.x); s2[kt][3] = __builtin_amdgcn_exp2f(b.y); } }
    }
    union { bf16x8 v; unsigned u[4]; } ones; ones.u[0] = ones.u[1] = ones.u[2] = ones.u[3] = 0x3f803f80u;
#pragma unroll
    for (int kk = 0; kk < 2; ++kk) {
      const bf16x8 pb1 = pack8(s1[2 * kk], s1[2 * kk + 1]);
      bf16x8 pb2 = pb1; if (MODE == 0) pb2 = pack8(s2[2 * kk], s2[2 * kk + 1]);
      L1 = mfma16(ones.v, pb1, L1);
      if (MODE == 0) L2 = mfma16(ones.v, pb2, L2);
#pragma unroll
      for (int dt = 0; dt < 4; ++dt) {
        const bf16x8 vfv = *(const bf16x8*)&vt[(dt * 16 + fr) * LDT + 32 * kk + fq * 8];
        O1[dt] = mfma16(vfv, pb1, O1[dt]);
        if (MODE == 0) O2[dt] = mfma16(vfv, pb2, O2[dt]);
      }
    }
   }
  }
  const float i1 = 1.0f / L1[0];
  float o[4][4];
  if (MODE == 0) {
    const float i2 = lam / L2[0];
    float ss = 0.f;
#pragma unroll
    for (int dt = 0; dt < 4; ++dt)
#pragma unroll
      for (int r = 0; r < 4; ++r) { o[dt][r] = O1[dt][r] * i1 - O2[dt][r] * i2; ss += o[dt][r] * o[dt][r]; }
    ss += __shfl_xor(ss, 16); ss += __shfl_xor(ss, 32);
    const float rs = rsqrtf(ss * (1.0f / 64.0f) + EPS_) * (1.0f - p.lam_init[l]);
#pragma unroll
    for (int dt = 0; dt < 4; ++dt)
#pragma unroll
      for (int r = 0; r < 4; ++r) o[dt][r] *= rs * p.df_norm_w[l * 64 + dt * 16 + fq * 4 + r];
  } else {
#pragma unroll
    for (int dt = 0; dt < 4; ++dt)
#pragma unroll
      for (int r = 0; r < 4; ++r) o[dt][r] = O1[dt][r] * i1;
  }
  bf16_t* yr = Y + (size_t)qrow * 1024 + (MODE == 0 ? 512 : 256) + h * 64 + fq * 4;
#pragma unroll
  for (int dt = 0; dt < 4; ++dt) { uint2 ov; ov.x = pack2(o[dt][0], o[dt][1]); ov.y = pack2(o[dt][2], o[dt][3]); *(uint2*)(yr + dt * 16) = ov; }
  __syncthreads();
}

struct DnIn { bf16x8 qa[2], ka[2], wa[2], qb[4][2]; uint2 ut[4]; f32x4 gr; float gc[4]; float gl; };
DEV int chain_cg(int b, int dir, int step) {
  if (step < 4) return 512 + b * 4 + (dir ? 3 - step : step);
  const int ci = step - 4; return b * 256 + (dir ? 255 - ci : ci);
}
DEV void dn_load(const Params& p, DnIn& in, int cg, int h, int dir, int wid, int fr, int fq) {
  const bf16_t* Yq = (const bf16_t*)(p.ws + OFF_XY); const bf16_t* DK = (const bf16_t*)(p.ws + OFF_DNK);
  const size_t base = ((size_t)(dir * 520 + cg) * 4 + h);
  const bf16_t* W = (const bf16_t*)(p.ws + OFF_DNW) + base * 4096; const bf16_t* UT = (const bf16_t*)(p.ws + OFF_DNUT) + base * 4096;
  const float* G = (const float*)(p.ws + OFF_DNG) + base * 64;
  const int tau = wid * 16 + fr, row = cg * 64 + (dir ? 63 - tau : tau);
#pragma unroll
  for (int ks = 0; ks < 2; ++ks) {
    in.qa[ks] = *(const bf16x8*)(Yq + (size_t)row * 1024 + h * 64 + ks * 32 + fq * 8);
    in.ka[ks] = *(const bf16x8*)(DK + (size_t)row * 256 + h * 64 + ks * 32 + fq * 8);
    in.wa[ks] = *(const bf16x8*)(W + tau * 64 + ks * 32 + fq * 8);
  }
#pragma unroll
  for (int n = 0; n < 4; ++n) {
    const int t2 = n * 16 + fr, row2 = cg * 64 + (dir ? 63 - t2 : t2);
#pragma unroll
    for (int ks = 0; ks < 2; ++ks) in.qb[n][ks] = *(const bf16x8*)(Yq + (size_t)row2 * 1024 + h * 64 + ks * 32 + fq * 8);
    in.ut[n] = *(const uint2*)(UT + (n * 16 + fr) * 64 + wid * 16 + fq * 4);
    in.gc[n] = G[n * 16 + fr];
  }
  in.gr = *(const f32x4*)(G + wid * 16 + fq * 4);
  in.gl = G[63];
}
DEV void dn_scan_chain(const Params& p, int l, int chain, char* ldsc) {
  bf16_t* ST = (bf16_t*)ldsc; bf16_t* sAt = ST + 64 * LDT; bf16_t* sVT = sAt + 64 * LDT; bf16_t* sVT2 = sVT + 64 * LDT; bf16_t* sKT = sVT2 + 64 * LDT;
  const int tid = tid_opaque(), lane = tid & 63, wid = tid >> 6, fr = lane & 15, fq = lane >> 4;
  const int b = chain >> 3, h = (chain >> 1) & 3, dir = chain & 1;
  bf16_t* P = (bf16_t*)(p.ws + OFF_P);
  const int ocol = (dir ? C_DNK : C_DNQ) + h * 64;
  f32x4 S[4];
#pragma unroll
  for (int n = 0; n < 4; ++n) { S[n] = (f32x4){0.f, 0.f, 0.f, 0.f}; *(uint2*)&ST[(n * 16 + fr) * LDT + wid * 16 + fq * 4] = (uint2){0u, 0u}; }
  DnIn cur; dn_load(p, cur, chain_cg(b, dir, 0), h, dir, wid, fr, fq);
  __syncthreads();
  for (int step = 0; step < 260; ++step) {
    const int cg = chain_cg(b, dir, step);
    DnIn nxt; dn_load(p, nxt, chain_cg(b, dir, step + 1 < 260 ? step + 1 : step), h, dir, wid, fr, fq);
    __builtin_amdgcn_sched_barrier(0);
    const f32x4 z = {0.f, 0.f, 0.f, 0.f};
#pragma unroll
    for (int n = 0; n < 4; ++n) {
      f32x4 a = mfma16(cur.ka[0], cur.qb[n][0], z); a = mfma16(cur.ka[1], cur.qb[n][1], a);
      float v[4];
#pragma unroll
      for (int r = 0; r < 4; ++r) { const int s = wid * 16 + fq * 4 + r, t = n * 16 + fr; v[r] = (s <= t) ? a[r] * __expf(cur.gc[n] - cur.gr[r]) : 0.f; }
      uint2 o; o.x = pack2(v[0], v[1]); o.y = pack2(v[2], v[3]);
      *(uint2*)&sAt[(n * 16 + fr) * LDT + wid * 16 + fq * 4] = o;
    }
    f32x4 o1[4];
#pragma unroll
    for (int n = 0; n < 4; ++n) {
      f32x4 ws = z, qs = z;
#pragma unroll
      for (int ks = 0; ks < 2; ++ks) { const bf16x8 bst = *(const bf16x8*)&ST[(n * 16 + fr) * LDT + ks * 32 + fq * 8]; ws = mfma16(cur.wa[ks], bst, ws); qs = mfma16(cur.qa[ks], bst, qs); }
      const float u[4] = {lo_bf(cur.ut[n].x), hi_bf(cur.ut[n].x), lo_bf(cur.ut[n].y), hi_bf(cur.ut[n].y)};
      float vn[4], vn2[4];
#pragma unroll
      for (int r = 0; r < 4; ++r) { vn[r] = u[r] - ws[r]; vn2[r] = vn[r] * __expf(cur.gl - cur.gr[r]); o1[n][r] = qs[r] * __expf(cur.gr[r]); }
      uint2 a, c; a.x = pack2(vn[0], vn[1]); a.y = pack2(vn[2], vn[3]); c.x = pack2(vn2[0], vn2[1]); c.y = pack2(vn2[2], vn2[3]);
      *(uint2*)&sVT[(n * 16 + fr) * LDT + wid * 16 + fq * 4] = a;
      *(uint2*)&sVT2[(n * 16 + fr) * LDT + wid * 16 + fq * 4] = c;
    }
#pragma unroll
    for (int ks = 0; ks < 2; ++ks)
#pragma unroll
      for (int e = 0; e < 8; ++e) sKT[(ks * 32 + fq * 8 + e) * LDT + wid * 16 + fr] = (bf16_t)cur.ka[ks][e];
    __syncthreads();
    const float egl = __expf(cur.gl);
#pragma unroll
    for (int n = 0; n < 4; ++n) {
      f32x4 av = o1[n], kv = z;
#pragma unroll
      for (int ks = 0; ks < 2; ++ks) {
        const bf16x8 aa = *(const bf16x8*)&sAt[(wid * 16 + fr) * LDT + ks * 32 + fq * 8];
        const bf16x8 ak = *(const bf16x8*)&sKT[(wid * 16 + fr) * LDT + ks * 32 + fq * 8];
        const bf16x8 b1 = *(const bf16x8*)&sVT[(n * 16 + fr) * LDT + ks * 32 + fq * 8];
        const bf16x8 b2 = *(const bf16x8*)&sVT2[(n * 16 + fr) * LDT + ks * 32 + fq * 8];
        av = mfma16(aa, b1, av); kv = mfma16(ak, b2, kv);
      }
#pragma unroll
      for (int r = 0; r < 4; ++r) { const int tau = wid * 16 + fq * 4 + r, row = cg * 64 + (dir ? 63 - tau : tau);
        P[(size_t)row * PN_ + ocol + n * 16 + fr] = f2bf(av[r]); S[n][r] = S[n][r] * egl + kv[r]; }
    }
    __syncthreads();
#pragma unroll
    for (int n = 0; n < 4; ++n) { uint2 o; o.x = pack2(S[n][0], S[n][1]); o.y = pack2(S[n][2], S[n][3]); *(uint2*)&ST[(n * 16 + fr) * LDT + wid * 16 + fq * 4] = o; }
    __syncthreads();
    __builtin_amdgcn_sched_barrier(0);
    cur = nxt;
  }
}

struct HgIn { bf16x8 qa[2], aa[2], ka[2]; uint4 v[2]; f32x4 de; };
DEV void hg_load(const Params& p, HgIn& in, int cg, int h, int dir, int tid) {
  const int lane = tid & 63, wid = tid >> 6, fr = lane & 15, fq = lane >> 4;
  const bf16_t* P = (const bf16_t*)(p.ws + OFF_P); const bf16_t* Y = (const bf16_t*)(p.ws + OFF_XY);
  const size_t base = ((size_t)(dir * 520 + cg) * 4 + h);
  const bf16_t* ATT = (const bf16_t*)(p.ws + OFF_HGATT) + base * 4096;
  const float* DE = (const float*)(p.ws + OFF_HGDE) + base * 64;
  const int tau = wid * 16 + fr, row = cg * 64 + (dir ? 63 - tau : tau);
#pragma unroll
  for (int ks = 0; ks < 2; ++ks) {
    in.qa[ks] = dir ? *(const bf16x8*)(Y + (size_t)row * 1024 + 768 + h * 64 + ks * 32 + fq * 8) : *(const bf16x8*)(P + (size_t)row * PN_ + C_HGQ + h * 64 + ks * 32 + fq * 8);
    in.aa[ks] = *(const bf16x8*)(ATT + tau * 64 + ks * 32 + fq * 8);
    in.ka[ks] = *(const bf16x8*)(P + (size_t)row * PN_ + (dir ? C_HGFB : C_HGFF) + h * 64 + ks * 32 + fq * 8);
  }
#pragma unroll
  for (int i = 0; i < 2; ++i) { const int t2 = (tid >> 3) + 32 * i, row2 = cg * 64 + (dir ? 63 - t2 : t2); in.v[i] = *(const uint4*)(P + (size_t)row2 * PN_ + C_HGI + h * 64 + (tid & 7) * 8); }
  in.de = *(const f32x4*)(DE + wid * 16 + fq * 4);
}
DEV void hg_stage(const HgIn& in, bf16_t* kt, bf16_t* vt, int tid) {
  const int lane = tid & 63, wid = tid >> 6, fr = lane & 15, fq = lane >> 4;
#pragma unroll
  for (int ks = 0; ks < 2; ++ks)
#pragma unroll
    for (int e = 0; e < 8; ++e) kt[(ks * 32 + fq * 8 + e) * LDT + wid * 16 + fr] = (bf16_t)in.ka[ks][e];
  vt_tr_store(vt, (tid & 7) * 8, (tid >> 3), in.v[0]); vt_tr_store(vt, (tid & 7) * 8, (tid >> 3) + 32, in.v[1]);
}
DEV void hg_scan_chain(const Params& p, int l, int chain, char* ldsc) {
  bf16_t* ST = (bf16_t*)ldsc; bf16_t* sVT = ST + 2 * 64 * LDT; bf16_t* sKT = sVT + 2 * 64 * LDT;
  const int tid = tid_opaque(), lane = tid & 63, wid = tid >> 6, fr = lane & 15, fq = lane >> 4;
  const int b = chain >> 3, h = (chain >> 1) & 3, dir = chain & 1;
  bf16_t* P = (bf16_t*)(p.ws + OFF_P); bf16_t* Y = (bf16_t*)(p.ws + OFF_XY);
  f32x4 S[4];
#pragma unroll
  for (int n = 0; n < 4; ++n) { S[n] = (f32x4){0.f, 0.f, 0.f, 0.f}; *(uint2*)&ST[(n * 16 + fr) * LDT + wid * 16 + fq * 4] = (uint2){0u, 0u}; }
  HgIn cur; hg_load(p, cur, chain_cg(b, dir, 0), h, dir, tid);
  hg_stage(cur, sKT, sVT, tid);
  __syncthreads();
  for (int step = 0; step < 260; ++step) {
    const int cg = chain_cg(b, dir, step), bufc = step & 1;
    HgIn nxt; hg_load(p, nxt, chain_cg(b, dir, step + 1 < 260 ? step + 1 : step), h, dir, tid);
    __builtin_amdgcn_sched_barrier(0);
    const bf16_t* st = ST + bufc * 64 * LDT; const bf16_t* vt = sVT + bufc * 64 * LDT; const bf16_t* kt = sKT + bufc * 64 * LDT;
    bf16_t* st2 = ST + (bufc ^ 1) * 64 * LDT;
    const f32x4 z = {0.f, 0.f, 0.f, 0.f};
#pragma unroll
    for (int n = 0; n < 4; ++n) {
      f32x4 o = z, kv = z;
#pragma unroll
      for (int ks = 0; ks < 2; ++ks) {
        const bf16x8 bs = *(const bf16x8*)&st[(n * 16 + fr) * LDT + ks * 32 + fq * 8];
        const bf16x8 bv = *(const bf16x8*)&vt[(n * 16 + fr) * LDT + ks * 32 + fq * 8];
        const bf16x8 ak = *(const bf16x8*)&kt[(wid * 16 + fr) * LDT + ks * 32 + fq * 8];
        o = mfma16(cur.qa[ks], bs, o); o = mfma16(cur.aa[ks], bv, o); kv = mfma16(ak, bv, kv);
      }
#pragma unroll
      for (int r = 0; r < 4; ++r) { const int tau = wid * 16 + fq * 4 + r, row = cg * 64 + (dir ? 63 - tau : tau);
        if (dir) Y[(size_t)row * 1024 + 768 + h * 64 + n * 16 + fr] = f2bf(o[r]); else P[(size_t)row * PN_ + C_HGQ + h * 64 + n * 16 + fr] = f2bf(o[r]);
        S[n][r] = S[n][r] * cur.de[r] + kv[r]; }
      uint2 ov; ov.x = pack2(S[n][0], S[n][1]); ov.y = pack2(S[n][2], S[n][3]);
      *(uint2*)&st2[(n * 16 + fr) * LDT + wid * 16 + fq * 4] = ov;
    }
    hg_stage(nxt, sKT + (bufc ^ 1) * 64 * LDT, sVT + (bufc ^ 1) * 64 * LDT, tid);
    __syncthreads();
    __builtin_amdgcn_sched_barrier(0);
    cur = nxt;
  }
}

DEV void mixer_phase(const Params& p, int l, char* lds) {
  __shared__ int s_item;
  unsigned* ctr = (unsigned*)(p.ws + OFF_CTRL) + l;
  const int n_scan = 32, n_df = 2048 * (1 + EXP_DF2), n_na = 2048, n_ctx = (l == 0) ? 64 : 0;
  const int total = n_scan + n_df + n_na + n_ctx;
  for (;;) {
    if (tid_opaque() == 0) s_item = (int)atomicAdd(ctr, 1u);
    __syncthreads();
    const int it = s_item;
    __syncthreads();
    if (it >= total) break;
    const int lo = l;
    if (it < 16) { dn_scan_chain(p, lo, it, lds);
#if EXP_SCAN2
      __syncthreads(); dn_scan_chain(p, lo, it, lds);
#endif
    }
    else if (it < 32) hg_scan_chain(p, lo, it - 16, lds);
    else if (it < 32 + n_df) { const int a = (it - 32) & 2047; attn_item<0>(p, lo, 0, a >> 10, (a >> 8) & 3, a & 255, lds); }
    else if (it < 32 + n_df + n_na) { const int a = it - 32 - n_df; attn_item<1>(p, lo, 0, a >> 10, (a >> 8) & 3, a & 255, lds); }
    else { const int a = it - 32 - n_df - n_na; const int md = a >> 5, bb = (a >> 4) & 1, hh = (a >> 2) & 3, qt = a & 3;
      if (md == 0) attn_item<0>(p, lo, 1, bb, hh, qt, lds); else attn_item<1>(p, lo, 1, bb, hh, qt, lds); }
  }
}

DEV void final_phase(const Params& p) {
  const int lane = tid_opaque() & 63, gw = bid_opaque() * 4 + (tid_opaque() >> 6), nw = gridDim.x * 4;
  for (int r = gw; r < LAT_; r += nw) {
    float4* xr = (float4*)(p.out + (size_t)r * 1024);
    float4 v[4]; float ss = 0.f;
#pragma unroll
    for (int i = 0; i < 4; ++i) { v[i] = xr[lane + 64 * i]; ss += v[i].x * v[i].x + v[i].y * v[i].y + v[i].z * v[i].z + v[i].w * v[i].w; }
#pragma unroll
    for (int o = 32; o > 0; o >>= 1) ss += __shfl_xor(ss, o);
    const float rs = rsqrtf(ss * (1.0f / 1024.0f) + EPS_);
#pragma unroll
    for (int i = 0; i < 4; ++i) { const float4 w4 = *(const float4*)(p.final_norm_w + (lane + 64 * i) * 4);
      float4 o4 = {v[i].x * rs * w4.x, v[i].y * rs * w4.y, v[i].z * rs * w4.z, v[i].w * rs * w4.w}; xr[lane + 64 * i] = o4; }
  }
}


#define XB_TMO      128
#define XB_XCNT(j)  (256  + 64 * (j))
#define XB_XSUB(j)  (1280 + 64 * (j))
#define XB_XGEN(j)  (2304 + 64 * (j))
#define XB_TOP      3328
#define XB_TOPGEN   3392
#define XB_SPIN_CAP (1u << 22)
#define LAS __attribute__((address_space(3)))
DEV unsigned xb_ld(unsigned* p)              { return __hip_atomic_load(p, __ATOMIC_RELAXED, __HIP_MEMORY_SCOPE_AGENT); }
DEV unsigned xb_add(unsigned* p, unsigned v) { return __hip_atomic_fetch_add(p, v, __ATOMIC_RELAXED, __HIP_MEMORY_SCOPE_AGENT); }
DEV unsigned xb_xcc_id() { return (unsigned)__builtin_amdgcn_s_getreg((3 << 11) | 20) & 0xFu; }
#define XB_SPIN(cond, bar) do { unsigned _sp = 0; while (cond) { __builtin_amdgcn_s_sleep(1); \
    if ((++_sp & 255u) == 0u) { if (xb_ld(&(bar)[XB_TMO])) break; if (_sp > XB_SPIN_CAP) { atomicAdd(&(bar)[XB_TMO], 1u); break; } } } } while (0)
struct XcdBarrier { unsigned* bar; unsigned x; volatile LAS unsigned* st; };
DEV XcdBarrier xcd_barrier_post(unsigned* bar, volatile LAS unsigned* st) {
  XcdBarrier b; b.bar = bar; b.x = xb_xcc_id(); b.st = st;
  if (threadIdx.x == 0) (void)xb_add(&bar[XB_XCNT(b.x)], 1u);
  return b;
}
DEV void xcd_barrier_complete(unsigned* bar, unsigned x, unsigned& nloc, unsigned& nx) {
  const unsigned G = gridDim.x * gridDim.y * gridDim.z;
  unsigned sum, cnt, mine, sp = 0u;
  for (;;) {
    sum = 0u; cnt = 0u; mine = 0u;
#pragma unroll
    for (unsigned j = 0; j < 16; ++j) { const unsigned c = xb_ld(&bar[XB_XCNT(j)]); sum += c; cnt += (c > 0u) ? 1u : 0u; mine = (j == x) ? c : mine; }
    if (sum == G) break;
    __builtin_amdgcn_s_sleep(1);
    if ((++sp & 255u) == 0u) { if (xb_ld(&bar[XB_TMO])) break; if (sp > XB_SPIN_CAP) { atomicAdd(&bar[XB_TMO], 1u); break; } }
  }
  nloc = mine > 0u ? mine : 1u; nx = cnt > 0u ? cnt : 1u;
}
DEV void xcd_barrier(const XcdBarrier& b) {
  asm volatile("s_waitcnt vmcnt(0)" ::: "memory");
  __syncthreads();
  if (threadIdx.x == 0) {
    unsigned* bar = b.bar;
    __builtin_amdgcn_s_waitcnt(0);
    unsigned nloc = b.st[0], nx = b.st[1];
    if (nloc == 0u) { xcd_barrier_complete(bar, b.x, nloc, nx); b.st[0] = nloc; b.st[1] = nx; }
    const unsigned old = xb_add(&bar[XB_XSUB(b.x)], 1u);
    const unsigned gen = old / nloc;
    if (old + 1u == (gen + 1u) * nloc) {
      __builtin_amdgcn_fence(__ATOMIC_RELEASE, "agent");
      asm volatile("s_waitcnt vmcnt(0)" ::: "memory");
      const unsigned og = xb_add(&bar[XB_TOP], 1u);
      const unsigned tg = og / nx;
      if (og + 1u == (tg + 1u) * nx) xb_add(&bar[XB_TOPGEN], 1u);
      else XB_SPIN(xb_ld(&bar[XB_TOPGEN]) == tg, bar);
      __builtin_amdgcn_fence(__ATOMIC_ACQUIRE, "agent");
      xb_add(&bar[XB_XGEN(b.x)], 1u);
      asm volatile("s_waitcnt vmcnt(0)" ::: "memory");
    } else {
      XB_SPIN(xb_ld(&bar[XB_XGEN(b.x)]) == gen, bar);
      __builtin_amdgcn_fence(__ATOMIC_ACQUIRE, "agent");
      asm volatile("s_waitcnt vmcnt(0)" ::: "memory");
    }
  }
  __syncthreads();
}

constexpr int LDS_BYTES = 76800;
__global__ void __launch_bounds__(256, 2) mega(Params p) {
  extern __shared__ __attribute__((aligned(16))) char lds[];
  cg::grid_group grid = cg::this_grid();
  __shared__ uint4 xb_words;
  if (threadIdx.x == 0) xb_words = make_uint4(0u, 0u, 0u, 0u);
  __syncthreads();
  const XcdBarrier xb = xcd_barrier_post((unsigned*)(p.ws + OFF_BAR), (volatile LAS unsigned*)&xb_words);
  phase0(p, lds);
  grid.sync();
  for (int l = 0; l < 2; ++l) {
    const char* wb = p.ws + OFF_WB + (size_t)l * WB_LAYER;
    const bf16_t* XY = (const bf16_t*)(p.ws + OFF_XY);
    norm_phase(p, l, 0);
    xcd_barrier(xb);
    { EpiArgs e{l, 0, false}; gemm_phase<0>(p, XY, (const bf16_t*)(wb + WB_IN), 1024, 260, 31, e, lds, l * 4 + 0); }
    xcd_barrier(xb);
#if EXP_IN2
    { EpiArgs e{l, 0, false}; gemm_phase<0>(p, XY, (const bf16_t*)(wb + WB_IN), 1024, 260, 31, e, lds, 8 + l); }
    xcd_barrier(xb);
#endif
    prep_phase(p, l, lds);
    xcd_barrier(xb);
    mixer_phase(p, l, lds);
    xcd_barrier(xb);
    post_phase(p, l);
    xcd_barrier(xb);
    { EpiArgs e{l, 2, l == 0}; gemm_phase<1>(p, XY, (const bf16_t*)(wb + WB_OUT), 1024, 260, 8, e, lds, l * 4 + 1); }
    xcd_barrier(xb);
    norm_phase(p, l, 1);
    xcd_barrier(xb);
    { EpiArgs e{l, 0, false}; gemm_phase<2>(p, XY, (const bf16_t*)(wb + WB_UP), 1024, 265, 44, e, lds, l * 4 + 2); }
    xcd_barrier(xb);
#if EXP_UP2
    { EpiArgs e{l, 0, false}; gemm_phase<2>(p, XY, (const bf16_t*)(wb + WB_UP), 1024, 265, 44, e, lds, l * 4 + 2); }
    xcd_barrier(xb);
#endif
    { EpiArgs e{l, 5, false}; gemm_phase<1>(p, (const bf16_t*)(p.ws + OFF_P), (const bf16_t*)(wb + WB_DOWN), 2816, 260, 8, e, lds, l * 4 + 3); }
    xcd_barrier(xb);
  }
  final_phase(p);
}

extern "C" void kernel_launch(void* const* d_in, const int* in_sizes, int n_in, void* d_out, int out_size, void* d_ws, size_t ws_size, hipStream_t stream) {
  static int grid_blocks = 0;
  if (!grid_blocks) {
    int dev = 0, cus = 0, per_cu = 0;
    hipGetDevice(&dev);
    hipDeviceGetAttribute(&cus, hipDeviceAttributeMultiprocessorCount, dev);
    hipFuncSetAttribute((const void*)mega, hipFuncAttributeMaxDynamicSharedMemorySize, LDS_BYTES);
    hipOccupancyMaxActiveBlocksPerMultiprocessor(&per_cu, mega, 256, LDS_BYTES);
    if (per_cu > 2) per_cu = 2;
    if (per_cu < 1) per_cu = 1;
    grid_blocks = cus * per_cu;
  }
  Params p{};
  const float** f = (const float**)&p;
  for (int i = 0; i < 23; ++i) f[i] = (const float*)d_in[i];
  p.out = (float*)d_out; p.ws = (char*)d_ws;
  p.lam_init[0] = (float)(0.8 - 0.6 * exp(-0.3 * 0.0)); p.lam_init[1] = (float)(0.8 - 0.6 * exp(-0.3 * 1.0));
  p.debug = 0; p.pad = 0;
  if (ws_size < WS_NEED) fprintf(stderr, "workspace too small: %zu < %zu\n", ws_size, (size_t)WS_NEED);
  (void)hipMemsetAsync((char*)d_ws + OFF_BAR, 0, 16384, stream);
  void* args[] = {&p};
  hipError_t e = hipLaunchCooperativeKernel((void*)mega, dim3(grid_blocks), dim3(256), args, LDS_BYTES, stream);
  if (e != hipSuccess) fprintf(stderr, "cooperative launch failed: %s (grid %d)\n", hipGetErrorString(e), grid_blocks);
}
```
